# Optimizing an MI355X kernel written in HIP

```python
import math
import jax
import jax.numpy as jnp
from jax import lax
import numpy as np

D_MODEL = 1024
BATCH = 32
SEQ = 2048
DEPTH = 2

N_AB_LAYERS = (DEPTH + 1) // 2
N_C_LAYERS = DEPTH // 2

S5_WIDTH = D_MODEL // 4
S5_GROUP = 16
S5_GROUPS = S5_WIDTH // S5_GROUP
S5_STATE = 64
GDN_HEAD_DIM = 128
GDN_HEADS = (D_MODEL - S5_WIDTH) // GDN_HEAD_DIM
GDN_WIDTH = GDN_HEADS * GDN_HEAD_DIM
GDN_CONV = 4
GDN_CHUNK = 64
AB_MIX_WIDTH = S5_WIDTH + GDN_WIDTH
AB_IN = S5_WIDTH + 4 * GDN_WIDTH + 2 * GDN_HEADS

NSA_HEADS = 16
NSA_HEAD_DIM = D_MODEL // NSA_HEADS
NSA_KV_GROUPS = 4
NSA_GROUP_SIZE = NSA_HEADS // NSA_KV_GROUPS
NSA_WIDTH = NSA_HEADS * NSA_HEAD_DIM
NSA_KV_WIDTH = NSA_KV_GROUPS * NSA_HEAD_DIM
NSA_IN = NSA_WIDTH + 6 * NSA_KV_WIDTH + 3 * NSA_HEADS
CMP_LEN = 32
CMP_STRIDE = 16
CMP_HIDDEN = 256
SLC_BLOCK = 64
N_SELECT = 4
WINDOW = 256
NSA_Q_BLOCK = 64

FFN_HIDDEN = 2816
FFN_CONV = 3

RMS_EPS = 1e-6
NEG_INF = -1e30
FORCE_SCORE = 1e9

kernel_name = 'hybrid_s5_gdn_nsa_convffn'


def rms_norm(x, g):
    x32 = x.astype(jnp.float32)
    y = x32 * lax.rsqrt(jnp.mean(x32 * x32, axis=-1, keepdims=True) + RMS_EPS)
    return (y * g.astype(jnp.float32)).astype(x.dtype)


def l2_normalize(x):
    return x * lax.rsqrt(jnp.sum(x * x, axis=-1, keepdims=True) + 1e-6)


def causal_dwconv(x, w):
    k_width = w.shape[0]
    seq = x.shape[1]
    xp = jnp.pad(x, ((0, 0), (k_width - 1, 0), (0, 0)))
    return sum(xp[:, k:k + seq] * w[k] for k in range(k_width))


def alibi_slopes(n):
    return np.asarray([2.0 ** (-8.0 * (h + 1) / n) for h in range(n)], dtype=np.float32)


def masked_softmax(s, mask):
    p = jax.nn.softmax(jnp.where(mask, s, NEG_INF), axis=-1)
    return jnp.where(mask, p, 0.0)


def s5_mixer(u, lam_re, lam_im, log_step, b_re, b_im, c_re, c_im, d, w_glu, b_glu):
    bsz, seq, _ = u.shape
    f32 = jnp.float32
    u32 = u.astype(f32).reshape(bsz, seq, S5_GROUPS, S5_GROUP)
    step = jnp.exp(log_step.astype(f32))[:, None]
    lr, li = lam_re.astype(f32), lam_im.astype(f32)
    mag = jnp.exp(lr * step)
    a_re = mag * jnp.cos(li * step)
    a_im = mag * jnp.sin(li * step)
    den = lr * lr + li * li
    n_re, n_im = a_re - 1.0, a_im
    z_re = (n_re * lr + n_im * li) / den
    z_im = (n_im * lr - n_re * li) / den
    b_re, b_im = b_re.astype(f32), b_im.astype(f32)
    bb_re = z_re[..., None] * b_re - z_im[..., None] * b_im
    bb_im = z_re[..., None] * b_im + z_im[..., None] * b_re
    bu_re = jnp.einsum('gph,bsgh->bsgp', bb_re, u32)
    bu_im = jnp.einsum('gph,bsgh->bsgp', bb_im, u32)
    a_re_s = jnp.broadcast_to(a_re[None, None], (1, seq, S5_GROUPS, S5_STATE))
    a_im_s = jnp.broadcast_to(a_im[None, None], (1, seq, S5_GROUPS, S5_STATE))

    def combine(e1, e2):
        ar1, ai1, br1, bi1 = e1
        ar2, ai2, br2, bi2 = e2
        return (ar2 * ar1 - ai2 * ai1,
                ar2 * ai1 + ai2 * ar1,
                ar2 * br1 - ai2 * bi1 + br2,
                ar2 * bi1 + ai2 * br1 + bi2)

    _, _, h_re, h_im = lax.associative_scan(combine, (a_re_s, a_im_s, bu_re, bu_im), axis=1)
    y = (jnp.einsum('ghp,bsgp->bsgh', c_re.astype(f32), h_re)
         - jnp.einsum('ghp,bsgp->bsgh', c_im.astype(f32), h_im)
         + d.astype(f32) * u32).reshape(bsz, seq, S5_WIDTH)
    z = jax.nn.gelu(y)
    out = z * jax.nn.sigmoid(z @ w_glu.astype(f32) + b_glu.astype(f32))
    return out.astype(u.dtype)


def chunk_gated_delta_rule(q, k, v, g, beta):
    bsz, seq, n_heads, dk = q.shape
    dv = v.shape[-1]
    c = GDN_CHUNK
    n_chunks = seq // c

    def to_chunks(t):
        return jnp.moveaxis(t.reshape((bsz, n_chunks, c, n_heads) + t.shape[3:]), 3, 1)

    q, k, v, g, beta = map(to_chunks, (q, k, v, g, beta))
    g = jnp.cumsum(g, axis=-1)
    incl = jnp.tril(jnp.ones((c, c), dtype=bool))
    strict = jnp.tril(jnp.ones((c, c), dtype=bool), -1)
    decay = jnp.exp(jnp.where(incl, g[..., :, None] - g[..., None, :], NEG_INF))
    kb = k * beta[..., None]
    vb = v * beta[..., None]
    lower = jnp.where(strict, jnp.einsum('bhncd,bhnsd->bhncs', kb, k) * decay, 0.0)
    rhs = jnp.concatenate([vb, kb * jnp.exp(g)[..., None]], axis=-1)
    sol = lax.linalg.triangular_solve(lower, rhs, left_side=True, lower=True, unit_diagonal=True)
    u, w = sol[..., :dv], sol[..., dv:]
    intra = jnp.einsum('bhncd,bhnsd->bhncs', q, k) * decay
    q_dec = q * jnp.exp(g)[..., None]
    k_dec = k * jnp.exp(g[..., -1:] - g)[..., None]
    g_last = jnp.exp(g[..., -1])
    xs = tuple(jnp.moveaxis(t, 2, 0) for t in (q_dec, k_dec, u, w, intra, g_last))

    def step(state, inp):
        qd, kd, ui, wi, ai, gl = inp
        v_new = ui - jnp.einsum('bhcd,bhde->bhce', wi, state)
        o = jnp.einsum('bhcd,bhde->bhce', qd, state) + jnp.einsum('bhcs,bhse->bhce', ai, v_new)
        state = state * gl[..., None, None] + jnp.einsum('bhcd,bhce->bhde', kd, v_new)
        return state, o

    state0 = jnp.zeros((bsz, n_heads, dk, dv), jnp.float32)
    _, o = lax.scan(step, state0, xs)
    return jnp.transpose(o, (1, 0, 3, 2, 4)).reshape(bsz, seq, n_heads, dv)


def gated_deltanet(q, k, v, z, beta_logit, a_logit, conv_w, a_log, dt_bias, norm_w):
    bsz, seq, _ = q.shape
    f32 = jnp.float32
    shp = (bsz, seq, GDN_HEADS, GDN_HEAD_DIM)
    qkv = jax.nn.silu(causal_dwconv(jnp.concatenate([q, k, v], axis=-1), conv_w)).astype(f32)
    q, k, v = jnp.split(qkv, 3, axis=-1)
    q = l2_normalize(q.reshape(shp)) * (GDN_HEAD_DIM ** -0.5)
    k = l2_normalize(k.reshape(shp))
    v = v.reshape(shp)
    beta = jax.nn.sigmoid(beta_logit.astype(f32))
    g = -jnp.exp(a_log.astype(f32)) * jax.nn.softplus(a_logit.astype(f32) + dt_bias.astype(f32))
    o = chunk_gated_delta_rule(q, k, v, g, beta)
    o = rms_norm(o, norm_w) * jax.nn.silu(z.astype(f32).reshape(shp))
    return o.reshape(bsz, seq, GDN_WIDTH).astype(z.dtype)


def ab_layer(h, w_in, w_out, lam_re, lam_im, log_step, b_re, b_im, c_re, c_im, d, w_glu, b_glu,
             conv_w, a_log, dt_bias, norm_w):
    proj = h @ w_in
    cuts = np.cumsum([S5_WIDTH, GDN_WIDTH, GDN_WIDTH, GDN_WIDTH, GDN_WIDTH, GDN_HEADS])
    u, q, k, v, z, bl, al = jnp.split(proj, cuts, axis=-1)
    y_a = s5_mixer(u, lam_re, lam_im, log_step, b_re, b_im, c_re, c_im, d, w_glu, b_glu)
    y_b = gated_deltanet(q, k, v, z, bl, al, conv_w, a_log, dt_bias, norm_w)
    return jnp.concatenate([y_a, y_b], axis=-1) @ w_out


def compress_tokens(x, tok, pe, w1, b1, w2):
    bsz = x.shape[0]
    blocks = x[:, tok] + pe[:, None, :]
    flat = jnp.swapaxes(blocks, 2, 3).reshape(bsz, tok.shape[0], NSA_KV_GROUPS, CMP_LEN * NSA_HEAD_DIM)
    return jax.nn.gelu(flat @ w1 + b1) @ w2


def nsa_layer(h, w_in, w_out, pe_k, pe_v, k_w1, k_b1, k_w2, v_w1, v_b1, v_w2):
    bsz, seq, _ = h.shape
    G, R, dh, QB = NSA_KV_GROUPS, NSA_GROUP_SIZE, NSA_HEAD_DIM, NSA_Q_BLOCK
    f32 = jnp.float32
    proj = (h @ w_in).astype(f32)
    cuts = np.cumsum([NSA_WIDTH] + [NSA_KV_WIDTH] * 6)
    q, kc, vc, ks, vs, kw, vw, gl = jnp.split(proj, cuts, axis=-1)
    q = q.reshape(bsz, seq, G, R, dh) * (dh ** -0.5)
    kc, vc, ks, vs, kw, vw = (t.reshape(bsz, seq, G, dh) for t in (kc, vc, ks, vs, kw, vw))
    gates = jax.nn.sigmoid(gl).reshape(bsz, seq, G, R, 3)

    n_cmp = (seq - CMP_LEN) // CMP_STRIDE + 1
    tok = (np.arange(n_cmp, dtype=np.int32)[:, None] * CMP_STRIDE
           + np.arange(CMP_LEN, dtype=np.int32)[None, :])
    k_cmp = compress_tokens(kc, tok, pe_k, k_w1, k_b1, k_w2).astype(f32)
    v_cmp = compress_tokens(vc, tok, pe_v, v_w1, v_b1, v_w2).astype(f32)
    cmp_end = jnp.asarray(tok[:, -1])
    cmp_center = jnp.asarray(tok.mean(axis=1).astype(np.float32))

    n_slc = seq // SLC_BLOCK
    n_sel = min(N_SELECT, n_slc)
    blk_ids = np.arange(n_slc, dtype=np.int32)
    overlap = jnp.asarray(((tok // SLC_BLOCK)[:, :, None] == blk_ids[None, None, :])
                          .mean(axis=1).astype(np.float32))
    k_blocks = ks.reshape(bsz, n_slc, SLC_BLOCK, G, dh).transpose(0, 3, 1, 2, 4)
    v_blocks = vs.reshape(bsz, n_slc, SLC_BLOCK, G, dh).transpose(0, 3, 1, 2, 4)
    kw_pad = jnp.pad(kw, ((0, 0), (WINDOW, 0), (0, 0), (0, 0)))
    vw_pad = jnp.pad(vw, ((0, 0), (WINDOW, 0), (0, 0), (0, 0)))
    slopes = jnp.asarray(alibi_slopes(NSA_HEADS).reshape(G, R))
    b_idx = jnp.arange(bsz)[:, None, None, None]
    g_idx = jnp.arange(G)[None, :, None, None]
    in_blk = jnp.arange(SLC_BLOCK)
    win_off = jnp.arange(WINDOW + QB)
    m_sel = n_sel * SLC_BLOCK

    def query_block(i):
        start = i * QB
        t = start + jnp.arange(QB)
        tf = t.astype(f32)
        qb = lax.dynamic_slice_in_dim(q, start, QB, axis=1)
        gb = lax.dynamic_slice_in_dim(gates, start, QB, axis=1)
        s_c = (jnp.einsum('bqgrd,bjgd->bgrqj', qb, k_cmp)
               - slopes[:, :, None, None] * (tf[:, None] - cmp_center[None, :]))
        p_c = masked_softmax(s_c, cmp_end[None, :] <= t[:, None])
        o_c = jnp.einsum('bgrqj,bjgd->bqgrd', p_c, v_cmp)
        imp = jnp.einsum('bgrqj,jn->bgqn', p_c, overlap)
        blk_valid = (blk_ids * SLC_BLOCK)[None, :] <= t[:, None]
        forced = (blk_ids[None, :] == (t // SLC_BLOCK)[:, None]) | (blk_ids[None, :] == 0)
        score = jnp.where(blk_valid, jnp.where(forced, FORCE_SCORE, imp), NEG_INF)
        _, sel = lax.top_k(score, n_sel)
        k_sel = k_blocks[b_idx, g_idx, sel].reshape(bsz, G, QB, m_sel, dh)
        v_sel = v_blocks[b_idx, g_idx, sel].reshape(bsz, G, QB, m_sel, dh)
        pos = (sel[..., None] * SLC_BLOCK + in_blk).reshape(bsz, G, QB, m_sel)
        s_s = (jnp.einsum('bqgrd,bgqmd->bgrqm', qb, k_sel)
               - slopes[None, :, :, None, None] * (tf[None, None, :, None] - pos.astype(f32))[:, :, None])
        p_s = masked_softmax(s_s, (pos <= t[None, None, :, None])[:, :, None])
        o_s = jnp.einsum('bgrqm,bgqmd->bqgrd', p_s, v_sel)
        kwb = lax.dynamic_slice_in_dim(kw_pad, start, WINDOW + QB, axis=1)
        vwb = lax.dynamic_slice_in_dim(vw_pad, start, WINDOW + QB, axis=1)
        kpos = start - WINDOW + win_off
        mask_w = ((kpos[None, :] <= t[:, None]) & (kpos[None, :] > t[:, None] - WINDOW)
                  & (kpos[None, :] >= 0))
        s_w = (jnp.einsum('bqgrd,bkgd->bgrqk', qb, kwb)
               - slopes[:, :, None, None] * (tf[:, None] - kpos.astype(f32)[None, :]))
        p_w = masked_softmax(s_w, mask_w)
        o_w = jnp.einsum('bgrqk,bkgd->bqgrd', p_w, vwb)
        return gb[..., 0:1] * o_c + gb[..., 1:2] * o_s + gb[..., 2:3] * o_w

    o = lax.map(query_block, jnp.arange(seq // QB))
    o = jnp.moveaxis(o, 0, 1).reshape(bsz, seq, NSA_WIDTH)
    return o.astype(h.dtype) @ w_out


def conv_ffn(h, w_in, conv_w, conv_b, w_out):
    up = causal_dwconv(h @ w_in, conv_w) + conv_b
    a, b = jnp.split(up, 2, axis=-1)
    return (jax.nn.silu(a) * b) @ w_out


def setup_inputs(seed: int = 0) -> dict:
    key = jax.random.key(seed)
    keys = iter(jax.random.split(key, 48))
    f32 = jnp.float32

    def nrm(shape, scale):
        return jax.random.normal(next(keys), shape, f32) * scale

    def unif(shape, lo, hi):
        return jax.random.uniform(next(keys), shape, f32, lo, hi)

    na, nc = N_AB_LAYERS, N_C_LAYERS
    dt = jnp.exp(unif((na, GDN_HEADS), math.log(1e-3), math.log(1e-1)))
    return {
        'x': nrm((BATCH, SEQ, D_MODEL), 1.0),
        'ab_w_in': nrm((na, D_MODEL, AB_IN), D_MODEL ** -0.5),
        'ab_w_out': nrm((na, AB_MIX_WIDTH, D_MODEL), AB_MIX_WIDTH ** -0.5),
        's5_lambda_re': -0.5 + nrm((na, S5_GROUPS, S5_STATE), 0.01),
        's5_lambda_im': math.pi * jnp.arange(S5_STATE, dtype=f32) + nrm((na, S5_GROUPS, S5_STATE), 0.01),
        's5_log_step': unif((na, S5_GROUPS), math.log(1e-3), math.log(1e-1)),
        's5_b_re': nrm((na, S5_GROUPS, S5_STATE, S5_GROUP), (2 * S5_GROUP) ** -0.5),
        's5_b_im': nrm((na, S5_GROUPS, S5_STATE, S5_GROUP), (2 * S5_GROUP) ** -0.5),
        's5_c_re': nrm((na, S5_GROUPS, S5_GROUP, S5_STATE), (2 * S5_STATE) ** -0.5),
        's5_c_im': nrm((na, S5_GROUPS, S5_GROUP, S5_STATE), (2 * S5_STATE) ** -0.5),
        's5_d': nrm((na, S5_GROUPS, S5_GROUP), 1.0),
        's5_w_glu': nrm((na, S5_WIDTH, S5_WIDTH), S5_WIDTH ** -0.5),
        's5_b_glu': nrm((na, S5_WIDTH), 0.01),
        'gdn_conv_w': nrm((na, GDN_CONV, 3 * GDN_WIDTH), GDN_CONV ** -0.5),
        'gdn_a_log': jnp.log(unif((na, GDN_HEADS), 1.0, 16.0)),
        'gdn_dt_bias': dt + jnp.log(-jnp.expm1(-dt)),
        'gdn_norm_w': 1.0 + nrm((na, GDN_HEAD_DIM), 0.01),
        'nsa_w_in': nrm((nc, D_MODEL, NSA_IN), D_MODEL ** -0.5),
        'nsa_w_out': nrm((nc, NSA_WIDTH, D_MODEL), NSA_WIDTH ** -0.5),
        'nsa_pe_k': nrm((nc, CMP_LEN, NSA_HEAD_DIM), 0.02),
        'nsa_pe_v': nrm((nc, CMP_LEN, NSA_HEAD_DIM), 0.02),
        'nsa_k_w1': nrm((nc, CMP_LEN * NSA_HEAD_DIM, CMP_HIDDEN), (CMP_LEN * NSA_HEAD_DIM) ** -0.5),
        'nsa_k_b1': nrm((nc, CMP_HIDDEN), 0.01),
        'nsa_k_w2': nrm((nc, CMP_HIDDEN, NSA_HEAD_DIM), CMP_HIDDEN ** -0.5),
        'nsa_v_w1': nrm((nc, CMP_LEN * NSA_HEAD_DIM, CMP_HIDDEN), (CMP_LEN * NSA_HEAD_DIM) ** -0.5),
        'nsa_v_b1': nrm((nc, CMP_HIDDEN), 0.01),
        'nsa_v_w2': nrm((nc, CMP_HIDDEN, NSA_HEAD_DIM), CMP_HIDDEN ** -0.5),
        'ffn_w_in': nrm((DEPTH, D_MODEL, 2 * FFN_HIDDEN), D_MODEL ** -0.5),
        'ffn_conv_w': nrm((DEPTH, FFN_CONV, 2 * FFN_HIDDEN), FFN_CONV ** -0.5),
        'ffn_conv_b': nrm((DEPTH, 2 * FFN_HIDDEN), 0.01),
        'ffn_w_out': nrm((DEPTH, FFN_HIDDEN, D_MODEL), FFN_HIDDEN ** -0.5),
        'norm_mix': 1.0 + nrm((DEPTH, D_MODEL), 0.01),
        'norm_ffn': 1.0 + nrm((DEPTH, D_MODEL), 0.01),
        'norm_final': 1.0 + nrm((D_MODEL,), 0.01),
    }


def reference(x, ab_w_in, ab_w_out, s5_lambda_re, s5_lambda_im, s5_log_step, s5_b_re, s5_b_im,
              s5_c_re, s5_c_im, s5_d, s5_w_glu, s5_b_glu, gdn_conv_w, gdn_a_log, gdn_dt_bias,
              gdn_norm_w, nsa_w_in, nsa_w_out, nsa_pe_k, nsa_pe_v, nsa_k_w1, nsa_k_b1, nsa_k_w2,
              nsa_v_w1, nsa_v_b1, nsa_v_w2, ffn_w_in, ffn_conv_w, ffn_conv_b, ffn_w_out,
              norm_mix, norm_ffn, norm_final):
    h = x
    for layer in range(DEPTH):
        hn = rms_norm(h, norm_mix[layer])
        i = layer // 2
        if layer % 2 == 0:
            mix = ab_layer(hn, ab_w_in[i], ab_w_out[i], s5_lambda_re[i], s5_lambda_im[i],
                           s5_log_step[i], s5_b_re[i], s5_b_im[i], s5_c_re[i], s5_c_im[i],
                           s5_d[i], s5_w_glu[i], s5_b_glu[i], gdn_conv_w[i], gdn_a_log[i],
                           gdn_dt_bias[i], gdn_norm_w[i])
        else:
            mix = nsa_layer(hn, nsa_w_in[i], nsa_w_out[i], nsa_pe_k[i], nsa_pe_v[i],
                            nsa_k_w1[i], nsa_k_b1[i], nsa_k_w2[i],
                            nsa_v_w1[i], nsa_v_b1[i], nsa_v_w2[i])
        h = h + mix
        h = h + conv_ffn(rms_norm(h, norm_ffn[layer]), ffn_w_in[layer], ffn_conv_w[layer],
                         ffn_conv_b[layer], ffn_w_out[layer])
    return rms_norm(h, norm_final)
```

```cpp
#include <hip/hip_runtime.h>
#include <hip/hip_cooperative_groups.h>
#include <cstdio>
namespace cg = cooperative_groups;

#define LAS __attribute__((address_space(3)))
#define DI __device__ __forceinline__
typedef unsigned short bf16_t;
typedef short bf16x8 __attribute__((ext_vector_type(8)));
typedef short bf16x4 __attribute__((ext_vector_type(4)));
typedef float f32x4 __attribute__((ext_vector_type(4)));
typedef float f32x2 __attribute__((ext_vector_type(2)));
typedef unsigned u32x4 __attribute__((ext_vector_type(4)));
typedef unsigned u32x2 __attribute__((ext_vector_type(2)));

constexpr int MTOK = 65536, DM = 1024, SEQ = 2048, NB = 32;
constexpr int AB_IN = 3340, AB_IN_P = 3584, NSA_IN = 2608, NSA_IN_P = 2816, FF2 = 5632, FFH = 2816;
constexpr int LDS_BYTES = 147456;

constexpr size_t MiB = 1048576;
constexpr size_t W_AB_IN = 0;
constexpr size_t W_AB_OUT = W_AB_IN + (size_t)AB_IN_P * 1024 * 2;
constexpr size_t W_GLU = W_AB_OUT + 2 * MiB;
constexpr size_t W_NSA_IN = W_GLU + 131072;
constexpr size_t W_NSA_OUT = W_NSA_IN + (size_t)NSA_IN_P * 1024 * 2;
constexpr size_t W_KW1 = W_NSA_OUT + 2 * MiB;
constexpr size_t W_VW1 = W_KW1 + MiB;
constexpr size_t W_KW2 = W_VW1 + MiB;
constexpr size_t W_VW2 = W_KW2 + 131072;
constexpr size_t W_FFN_IN = W_VW2 + 131072;
constexpr size_t W_FFN_OUT = W_FFN_IN + 2 * (size_t)FF2 * 1024 * 2;
constexpr size_t W_S5AB = W_FFN_OUT + 2 * (size_t)1024 * FFH * 2;
constexpr size_t W_S5BB = W_S5AB + 8192;
constexpr size_t W_S5CC = W_S5BB + 131072;
constexpr size_t W_B1P = W_S5CC + 65536;
constexpr size_t W_B1PART = W_B1P + 2048;
constexpr size_t W_CTR = W_B1PART + 65536;
constexpr size_t W_BAR = W_CTR + 4096;
constexpr size_t W_END = W_BAR + 16384;
static_assert(W_END <= 64 * MiB, "weights region");
constexpr size_t ACT = 64 * MiB;
constexpr size_t A_QKV = ACT;
constexpr size_t A_YCAT = ACT;
constexpr size_t A_Z = A_QKV + 288 * MiB;
constexpr size_t A_US5 = A_Z + 96 * MiB;
constexpr size_t A_ZS5 = A_US5 + 32 * MiB;
constexpr size_t A_BLAL = A_ZS5 + 32 * MiB;
constexpr size_t A_S5END = A_BLAL + 4 * MiB;
constexpr size_t A_CHUNK = A_S5END + 2 * MiB;
constexpr size_t A_HN = A_CHUNK;
constexpr size_t CH_U = A_CHUNK, CH_W = CH_U + 96 * MiB, CH_QD = CH_W + 96 * MiB, CH_KDT = CH_QD + 96 * MiB, CH_INTRA = CH_KDT + 96 * MiB, CH_GL = CH_INTRA + 48 * MiB;
static_assert(CH_GL + MiB <= 1024 * MiB, "ws");
constexpr size_t F_HN = ACT;
constexpr size_t F_UP = F_HN + 128 * MiB;
constexpr size_t F_HB = F_UP;
constexpr size_t F_ACT = F_UP + 352 * MiB;
static_assert(F_ACT + 352 * MiB <= 1024 * MiB, "ws");
constexpr size_t N_HN = ACT;
constexpr size_t N_Q = N_HN + 128 * MiB;
constexpr size_t N_KC = N_Q + 128 * MiB;
constexpr size_t N_VC = N_KC + 32 * MiB;
constexpr size_t N_KS = N_VC + 32 * MiB;
constexpr size_t N_VST = N_KS + 32 * MiB;
constexpr size_t N_KW = N_VST + 32 * MiB;
constexpr size_t N_VWT = N_KW + 32 * MiB;
constexpr size_t N_GATES = N_VWT + 32 * MiB;
constexpr size_t N_H1K = N_GATES + 12 * MiB;
constexpr size_t N_H1V = N_H1K + 8 * MiB;
constexpr size_t N_KCMP = N_H1V + 8 * MiB;
constexpr size_t N_VCMPT = N_KCMP + 2 * MiB;
constexpr size_t N_AO = N_VCMPT + 2 * MiB;

struct P { const float* in[34]; float* out; unsigned char* ws; };

DI float bf2f(bf16_t b) { return __uint_as_float(((unsigned)b) << 16); }
DI bf16_t f2bf(float f) { return __builtin_bit_cast(bf16_t, (__bf16)f); }
typedef __bf16 bf16v2_t __attribute__((ext_vector_type(2)));
DI unsigned pk2(float lo, float hi) { bf16v2_t v; v.x = (__bf16)lo; v.y = (__bf16)hi; return __builtin_bit_cast(unsigned, v); }
DI float lo16(unsigned u) { return __uint_as_float(u << 16); }
DI float hi16(unsigned u) { return __uint_as_float(u & 0xffff0000u); }
DI float sigmoidf_(float x) { return 1.f / (1.f + __expf(-x)); }
DI float siluf_(float x) { return x / (1.f + __expf(-x)); }
DI float silu_fast(float x) { return x * __builtin_amdgcn_rcpf(1.f + __expf(-x)); }
DI float gelu_tanh(float x) { float u = 0.7978845608028654f * (x + 0.044715f * x * x * x); float e = __expf(2.f * u); float th = 1.f - 2.f / (e + 1.f); return 0.5f * x * (1.f + th); }
DI float wave_sum(float v) { for (int o = 32; o > 0; o >>= 1) v += __shfl_xor(v, o); return v; }
DI f32x4 mfma16(bf16x8 a, bf16x8 b, f32x4 c) { return __builtin_amdgcn_mfma_f32_16x16x32_bf16(a, b, c, 0, 0, 0); }
DI void lds_wait() { asm volatile("s_waitcnt lgkmcnt(0)" ::: "memory"); }

DI void st8bf(bf16_t* dst, f32x4 v0, f32x4 v1);
namespace pg8 {
constexpr int BM = 256, BK = 64, HALF = 128, HTB = HALF * BK * 2, STAGE_BYTES = 8 * HTB, NXCD = 8, WGM = 8;
DI int lds_byte(int r, int c) { const int st = (r >> 4) * 2 + (c >> 5), rr = r & 15, cc = c & 31, ob = rr * 64 + cc * 2; return st * 1024 + (ob ^ (((ob >> 9) & 1) << 5)); }
DI void stage_rc(int b, int& R, int& C) { const int st = b / 1024, sb = b % 1024, swz = sb ^ (((sb >> 9) & 1) << 5); R = (st >> 1) * 16 + swz / 64; C = (st & 1) * 32 + (swz % 64) / 2; }
DI int perm32(int rho) { const int n = rho >> 4, i = rho & 15; return 8 * (i >> 2) + 4 * n + (i & 3); }
struct Unit { int pm, pn; };
struct Order {
    int nM, nN, nwg, G, c; bool direct;
    DI void init(int M, int N, int G_, int c_, bool d_) { nM = M / BM; nN = N / BM; nwg = nM * nN; G = G_; c = c_; direct = d_; }
    DI bool next(int i, Unit& u) const {
        if (direct) { const int pm = c + (i / nN) * G; if (pm >= nM) return false; u.pm = pm; u.pn = i % nN; return true; }
        const long L = (long)i * G + c; if (L >= nwg) return false;
        int wgid = (int)L; { const int q = nwg / NXCD, r = nwg % NXCD, xcd = wgid % NXCD, off = wgid / NXCD; wgid = (xcd < r ? xcd * (q + 1) : r * (q + 1) + (xcd - r) * q) + off; }
        const int nig = WGM * nN, gid = wgid / nig, fm = gid * WGM, gsz = (nM - fm) < WGM ? (nM - fm) : WGM;
        u.pm = fm + ((wgid % nig) % gsz); u.pn = (wgid % nig) / gsz; return true;
    }
};
template <class F>
DI void gemm_phase(const int tid, LAS unsigned char* lds, const bf16_t* Ap, int lda, const bf16_t* Bp, int ldb, int M, int N, int K, int G, int c, bool direct, const F& E) {
    const int wid = __builtin_amdgcn_readfirstlane(tid >> 6), lane = tid & 63, wr = wid >> 2, wc = wid & 3, fr = lane & 15, fq = lane >> 4;
    const int nt = K / BK;
    Order S; S.init(M, N, G, c, direct);
    unsigned voffA[2], voffB[2];
#pragma unroll
    for (int i = 0; i < 2; ++i) { int R, C; stage_rc(tid * 16 + i * 8192, R, C); const int Rb = (R & ~31) + perm32(R & 31);
        voffA[i] = (unsigned)(R * lda + C) * 2u; voffB[i] = (unsigned)(Rb * ldb + C) * 2u; }
    const size_t kstep = (size_t)(BK * 2);
    const size_t hsA = (size_t)HALF * lda * 2, hsB = (size_t)HALF * ldb * 2;
    const size_t tsA = 2 * hsA, tsB = 2 * hsB;
    const unsigned ldsw = (unsigned)wid * 1024u;
    const int aoff = lds_byte(wr * 64 + fr, fq * 8), boff = lds_byte(wc * 32 + fr, fq * 8);
#define PG8_SA(b, h) (((b) * 2 + (h)) * HTB)
#define PG8_SB(b, h) ((4 + (b) * 2 + (h)) * HTB)
#define PG8_STAGE(bufoff, gbase, voff) do { _Pragma("unroll") for (int _i = 0; _i < 2; ++_i) \
        __builtin_amdgcn_global_load_lds((const unsigned*)((const char*)(gbase) + (voff)[_i]), (LAS unsigned*)(lds + (bufoff) + ldsw + _i * 8192), 16, 0, 0); } while (0)
#define PG8_LDA(dst, b, h) do { _Pragma("unroll") for (int m = 0; m < 4; ++m) _Pragma("unroll") for (int k = 0; k < 2; ++k) dst[m][k] = *(const LAS bf16x8*)(lds + PG8_SA(b, h) + aoff + m * 2048 + k * 1024); } while (0)
#define PG8_LDB(dst, b, h) do { _Pragma("unroll") for (int n = 0; n < 2; ++n) _Pragma("unroll") for (int k = 0; k < 2; ++k) dst[n][k] = *(const LAS bf16x8*)(lds + PG8_SB(b, h) + boff + n * 2048 + k * 1024); } while (0)
#define PG8_MMA(ai, bj, At, Bt) do { __builtin_amdgcn_s_setprio(1); _Pragma("unroll") for (int m = 0; m < 4; ++m) _Pragma("unroll") for (int n = 0; n < 2; ++n) _Pragma("unroll") for (int k = 0; k < 2; ++k) \
        acc[ai][bj][m][n] = __builtin_amdgcn_mfma_f32_16x16x32_bf16(Bt[n][k], At[m][k], acc[ai][bj][m][n], 0, 0, 0); __builtin_amdgcn_s_setprio(0); } while (0)
#define PG8_WAIT_V(n) asm volatile("s_waitcnt vmcnt(" #n ")" ::: "memory")
#define PG8_WAIT_L(n) asm volatile("s_waitcnt lgkmcnt(" #n ")" ::: "memory")
#define PG8_BAR __builtin_amdgcn_s_barrier()
#define PG8_SCHED __builtin_amdgcn_sched_barrier(0)
    Unit cur, nxt; int ui = 0;
    if (!S.next(0, cur)) return;
    f32x4 acc[2][2][4][2];
#pragma unroll
    for (int a = 0; a < 2; ++a)
#pragma unroll
        for (int b = 0; b < 2; ++b)
#pragma unroll
            for (int m = 0; m < 4; ++m)
#pragma unroll
                for (int n = 0; n < 2; ++n) acc[a][b][m][n] = (f32x4){0.f, 0.f, 0.f, 0.f};
    bf16x8 At[4][2], B0[2][2], B1[2][2];
    const char* cA = (const char*)Ap + (size_t)cur.pm * tsA; const char* cB = (const char*)Bp + (size_t)cur.pn * tsB;
    PG8_STAGE(PG8_SB(0, 0), cB, voffB); PG8_STAGE(PG8_SA(0, 0), cA, voffA); PG8_STAGE(PG8_SB(0, 1), cB + hsB, voffB); PG8_STAGE(PG8_SA(0, 1), cA + hsA, voffA);
    if (wr == 1) PG8_BAR;
    PG8_WAIT_V(4); PG8_BAR;
    PG8_STAGE(PG8_SB(1, 0), cB + kstep, voffB); PG8_STAGE(PG8_SA(1, 0), cA + kstep, voffA); PG8_STAGE(PG8_SB(1, 1), cB + hsB + kstep, voffB);
    PG8_WAIT_V(6); PG8_BAR;
    for (;;) {
        const bool has_next = S.next(ui + 1, nxt);
        const char* nA = has_next ? (const char*)Ap + (size_t)nxt.pm * tsA : cA; const char* nB = has_next ? (const char*)Bp + (size_t)nxt.pn * tsB : cB;
        for (int t = 0; t < nt; t += 2) {
            const bool last = (t == nt - 2);
            const char* a1 = cA + (size_t)(t + 1) * kstep;
            const char* a2 = last ? nA : cA + (size_t)(t + 2) * kstep; const char* b2 = last ? nB : cB + (size_t)(t + 2) * kstep;
            const char* a3 = a2 + kstep; const char* b3 = b2 + kstep;
            PG8_LDB(B0, 0, 0); PG8_SCHED; PG8_LDA(At, 0, 0); PG8_STAGE(PG8_SA(1, 1), a1 + hsA, voffA);
            PG8_WAIT_L(8); PG8_BAR; PG8_WAIT_L(0); PG8_MMA(0, 0, At, B0); PG8_BAR; PG8_SCHED;
            PG8_LDB(B1, 0, 1); PG8_STAGE(PG8_SB(0, 0), b2, voffB);
            PG8_BAR; PG8_WAIT_L(0); PG8_MMA(0, 1, At, B1); PG8_BAR;
            PG8_LDA(At, 0, 1); PG8_STAGE(PG8_SA(0, 0), a2, voffA);
            PG8_BAR; PG8_WAIT_L(0); PG8_MMA(1, 0, At, B0); PG8_BAR; PG8_SCHED;
            PG8_STAGE(PG8_SB(0, 1), b2 + hsB, voffB);
            PG8_WAIT_V(6); PG8_BAR; PG8_MMA(1, 1, At, B1); PG8_BAR;
            PG8_LDB(B0, 1, 0); PG8_SCHED; PG8_LDA(At, 1, 0); PG8_STAGE(PG8_SA(0, 1), a2 + hsA, voffA);
            PG8_WAIT_L(8); PG8_BAR; PG8_WAIT_L(0); PG8_MMA(0, 0, At, B0); PG8_BAR; PG8_SCHED;
            PG8_LDB(B1, 1, 1); PG8_STAGE(PG8_SB(1, 0), b3, voffB);
            PG8_BAR; PG8_WAIT_L(0); PG8_MMA(0, 1, At, B1); PG8_BAR;
            PG8_LDA(At, 1, 1); PG8_STAGE(PG8_SA(1, 0), a3, voffA);
            PG8_BAR; PG8_WAIT_L(0); PG8_MMA(1, 0, At, B0); PG8_BAR; PG8_SCHED;
            PG8_STAGE(PG8_SB(1, 1), b3 + hsB, voffB);
            PG8_WAIT_V(6); PG8_BAR; PG8_MMA(1, 1, At, B1); PG8_BAR;
        }
        if (E.kind == 7  ) E.fused(acc, cur.pm, cur.pn, wr, wc, fr, fq);
        else if (E.kind == 3  ) {
            const int row0 = cur.pm * BM + wr * 64 + fr, col0 = cur.pn * BM + wc * 32 + 8 * fq;
            f32x4 b0[2], b1[2];
#pragma unroll
            for (int bj = 0; bj < 2; ++bj) { b0[bj] = *(const f32x4*)(E.cf0 + col0 + bj * HALF); b1[bj] = *(const f32x4*)(E.cf0 + col0 + bj * HALF + 4); }
#pragma unroll
            for (int ai = 0; ai < 2; ++ai) {
                u32x4 zz[4][2];
#pragma unroll
                for (int m = 0; m < 4; ++m)
#pragma unroll
                    for (int bj = 0; bj < 2; ++bj) zz[m][bj] = *(const u32x4*)(E.cb0 + (size_t)(row0 + ai * HALF + m * 16) * 256 + col0 + bj * HALF);
#pragma unroll
                for (int m = 0; m < 4; ++m)
#pragma unroll
                    for (int bj = 0; bj < 2; ++bj) { const f32x4 v0 = acc[ai][bj][m][0], v1 = acc[ai][bj][m][1]; const u32x4 z = zz[m][bj]; f32x4 o0, o1;
                        o0[0] = lo16(z.x) * sigmoidf_(v0[0] + b0[bj][0]); o0[1] = hi16(z.x) * sigmoidf_(v0[1] + b0[bj][1]); o0[2] = lo16(z.y) * sigmoidf_(v0[2] + b0[bj][2]); o0[3] = hi16(z.y) * sigmoidf_(v0[3] + b0[bj][3]);
                        o1[0] = lo16(z.z) * sigmoidf_(v1[0] + b1[bj][0]); o1[1] = hi16(z.z) * sigmoidf_(v1[1] + b1[bj][1]); o1[2] = lo16(z.w) * sigmoidf_(v1[2] + b1[bj][2]); o1[3] = hi16(z.w) * sigmoidf_(v1[3] + b1[bj][3]);
                        st8bf(E.d0 + (size_t)(row0 + ai * HALF + m * 16) * 1024 + col0 + bj * HALF, o0, o1); }
            }
        }
        else if (E.kind == 1  ) {
            const int row0 = cur.pm * BM + wr * 64 + fr, col0 = cur.pn * BM + wc * 32 + 8 * fq;
#pragma unroll
            for (int ai = 0; ai < 2; ++ai) {
                f32x4 r[4][2][2];
#pragma unroll
                for (int m = 0; m < 4; ++m)
#pragma unroll
                    for (int bj = 0; bj < 2; ++bj) { const size_t o = (size_t)(row0 + ai * HALF + m * 16) * 1024 + col0 + bj * HALF;
                        r[m][bj][0] = *(const f32x4*)(E.cf0 + o); r[m][bj][1] = *(const f32x4*)(E.cf0 + o + 4); }
#pragma unroll
                for (int m = 0; m < 4; ++m)
#pragma unroll
                    for (int bj = 0; bj < 2; ++bj) { const size_t o = (size_t)(row0 + ai * HALF + m * 16) * 1024 + col0 + bj * HALF;
                        *(f32x4*)(E.f0 + o) = r[m][bj][0] + acc[ai][bj][m][0]; *(f32x4*)(E.f0 + o + 4) = r[m][bj][1] + acc[ai][bj][m][1]; }
            }
        }
        else {
            const int row0 = cur.pm * BM + wr * 64 + fr, col0 = cur.pn * BM + wc * 32 + 8 * fq;
#pragma unroll
            for (int ai = 0; ai < 2; ++ai)
#pragma unroll
                for (int m = 0; m < 4; ++m)
#pragma unroll
                    for (int bj = 0; bj < 2; ++bj) E.st(row0 + ai * HALF + m * 16, col0 + bj * HALF, acc[ai][bj][m][0], acc[ai][bj][m][1]);
        }
        if (!has_next) break;
#pragma unroll
        for (int a = 0; a < 2; ++a)
#pragma unroll
            for (int b = 0; b < 2; ++b)
#pragma unroll
                for (int m = 0; m < 4; ++m)
#pragma unroll
                    for (int n = 0; n < 2; ++n) acc[a][b][m][n] = (f32x4){0.f, 0.f, 0.f, 0.f};
        cur = nxt; cA = nA; cB = nB; ++ui;
    }
    PG8_WAIT_V(0);
    if (wr == 0) PG8_BAR;
    PG8_BAR;
#undef PG8_SA
#undef PG8_SB
#undef PG8_STAGE
#undef PG8_LDA
#undef PG8_LDB
#undef PG8_MMA
#undef PG8_WAIT_V
#undef PG8_WAIT_L
#undef PG8_BAR
#undef PG8_SCHED
}
}

DI void st8bf(bf16_t* dst, f32x4 v0, f32x4 v1) { u32x4 w; w.x = pk2(v0[0], v0[1]); w.y = pk2(v0[2], v0[3]); w.z = pk2(v1[0], v1[1]); w.w = pk2(v1[2], v1[3]); *(u32x4*)dst = w; }

enum { EK_ABIN = 0, EK_RESID, EK_BF, EK_GLU, EK_NSAIN, EK_CMP1, EK_CMP2, EK_FFNUP };
struct Epi { int kind, ldc, flag, pad; bf16_t *d0, *d1, *d2; float* f0; const float* cf0; const float* cf1; const bf16_t* cb0;
    DI void st(int row, int col, f32x4 v0, f32x4 v1) const {
        switch (kind) {
        case EK_ABIN: {
            if (col < 256) st8bf(d0 + (size_t)row * 256 + col, v0, v1);
            else if (col < 2560) st8bf(d1 + (size_t)row * 2304 + (col - 256), v0, v1);
            else if (col < 3328) st8bf(d2 + (size_t)row * 768 + (col - 2560), v0, v1);
            else { const int cc = col - 3328; if (cc < 16) { float* d = f0 + (size_t)row * 16 + cc; *(f32x4*)d = v0; *(f32x4*)(d + 4) = v1; } } } break;
        case EK_RESID: {
            const size_t o = (size_t)row * 1024 + col; const f32x4 r0 = *(const f32x4*)(cf0 + o), r1 = *(const f32x4*)(cf0 + o + 4);
            *(f32x4*)(f0 + o) = r0 + v0; *(f32x4*)(f0 + o + 4) = r1 + v1; } break;
        case EK_BF: st8bf(d0 + (size_t)row * ldc + col, v0, v1); break;
        case EK_GLU: {
            const u32x4 zz = *(const u32x4*)(cb0 + (size_t)row * 256 + col); const f32x4 b0 = *(const f32x4*)(cf0 + col), b1 = *(const f32x4*)(cf0 + col + 4);
            f32x4 o0, o1;
            o0[0] = lo16(zz.x) * sigmoidf_(v0[0] + b0[0]); o0[1] = hi16(zz.x) * sigmoidf_(v0[1] + b0[1]); o0[2] = lo16(zz.y) * sigmoidf_(v0[2] + b0[2]); o0[3] = hi16(zz.y) * sigmoidf_(v0[3] + b0[3]);
            o1[0] = lo16(zz.z) * sigmoidf_(v1[0] + b1[0]); o1[1] = hi16(zz.z) * sigmoidf_(v1[1] + b1[1]); o1[2] = lo16(zz.w) * sigmoidf_(v1[2] + b1[2]); o1[3] = hi16(zz.w) * sigmoidf_(v1[3] + b1[3]);
            st8bf(d0 + (size_t)row * 1024 + col, o0, o1); } break;
        case EK_NSAIN: {
            if (col < 1024) { st8bf(d0 + (size_t)row * 1024 + col, v0 * 0.18033688011112042f, v1 * 0.18033688011112042f);   }
            else if (col < 2560) {
                const int cc0 = col - 1024, ts = cc0 >> 8, cc = cc0 & 255, g = cc >> 6, dd = cc & 63, b = row >> 11, t = row & 2047;
                bf16_t* base = d1 + (size_t)ts * (16 * MiB);
                if (ts == 3 || ts == 5) { bf16_t* d = base + ((size_t)(b * 4 + g) * 64 + dd) * 2048 + t;
#pragma unroll
                    for (int e = 0; e < 4; ++e) { d[(size_t)e * 2048] = f2bf(v0[e]); d[(size_t)(e + 4) * 2048] = f2bf(v1[e]); } }
                else st8bf(base + ((size_t)(b * 4 + g) * 2048 + t) * 64 + dd, v0, v1);
            } else { const int cc = col - 2560; if (cc < 48) { float* d = f0 + (size_t)row * 48 + cc;
#pragma unroll
                    for (int e = 0; e < 4; ++e) { d[e] = sigmoidf_(v0[e]); d[e + 4] = sigmoidf_(v1[e]); } } } } break;
        case EK_CMP1: {
            const f32x4 b0 = *(const f32x4*)(cf0 + col), b1 = *(const f32x4*)(cf0 + col + 4); f32x4 o0, o1;
#pragma unroll
            for (int e = 0; e < 4; ++e) { o0[e] = gelu_tanh(v0[e] + b0[e]); o1[e] = gelu_tanh(v1[e] + b1[e]); }
            st8bf(d0 + (size_t)row * 256 + col, o0, o1); } break;
        case EK_CMP2: {
            if (col < 64) {
                if (!flag) st8bf(d0 + (size_t)row * 64 + col, v0, v1);
                else { bf16_t* d = d0 + ((size_t)(row >> 7) * 64 + col) * 128 + (row & 127);
#pragma unroll
                    for (int e = 0; e < 4; ++e) { d[e * 128] = f2bf(v0[e]); d[(e + 4) * 128] = f2bf(v1[e]); } } } } break;
        default: break;
        }
    }
    DI void fused(const f32x4 (&acc)[2][2][4][2], int pm, int pn, int wr, int wc, int fr, int fq) const;
};

template <int CTRL> DI float dppf(float v) { return __builtin_bit_cast(float, __builtin_amdgcn_update_dpp(0, __builtin_bit_cast(int, v), CTRL, 0xf, 0xf, true)); }
DI void Epi::fused(const f32x4 (&acc)[2][2][4][2], int pm, int pn, int wr, int wc, int fr, int fq) const {
    const Epi& E = *this;
#pragma unroll
    for (int bj = 0; bj < 2; ++bj) {
        const int ncol = pn * 256 + bj * 128 + wc * 32 + 8 * fq, j0 = (ncol >> 3) * 4;
        const f32x4 wa0 = *(const f32x4*)(E.cf0 + j0), wa1 = *(const f32x4*)(E.cf0 + FF2 + j0), wa2 = *(const f32x4*)(E.cf0 + 2 * FF2 + j0);
        const f32x4 wb0 = *(const f32x4*)(E.cf0 + FFH + j0), wb1 = *(const f32x4*)(E.cf0 + FF2 + FFH + j0), wb2 = *(const f32x4*)(E.cf0 + 2 * FF2 + FFH + j0);
        const f32x4 ba = *(const f32x4*)(E.cf1 + j0), bb = *(const f32x4*)(E.cf1 + FFH + j0);
#pragma unroll
        for (int ai = 0; ai < 2; ++ai) {
            f32x4 pa = (f32x4){0.f, 0.f, 0.f, 0.f}, pb = pa;
#pragma unroll
            for (int m = 0; m < 4; ++m) {
                const f32x4 ca = acc[ai][bj][m][0], cb = acc[ai][bj][m][1];
                const int row = pm * 256 + ai * 128 + wr * 64 + m * 16 + fr;
                float o[4];
#pragma unroll
                for (int e = 0; e < 4; ++e) {
                    const float a1 = dppf<0x111>(ca[e]) + dppf<0x10F>(pa[e]), a2 = dppf<0x112>(ca[e]) + dppf<0x10E>(pa[e]);
                    const float b1 = dppf<0x111>(cb[e]) + dppf<0x10F>(pb[e]), b2 = dppf<0x112>(cb[e]) + dppf<0x10E>(pb[e]);
                    const float ya = fmaf(wa0[e], a2, fmaf(wa1[e], a1, fmaf(wa2[e], ca[e], ba[e])));
                    const float yb = fmaf(wb0[e], b2, fmaf(wb1[e], b1, fmaf(wb2[e], cb[e], bb[e])));
                    o[e] = silu_fast(ya) * yb; }
                if (m > 0 || fr >= 2) { u32x2 w; w.x = pk2(o[0], o[1]); w.y = pk2(o[2], o[3]); *(u32x2*)(E.d0 + (size_t)row * FFH + j0) = w; }
                if ((m == 0 && fr < 2) || (m == 3 && fr >= 14)) { float* hb = E.f0 + ((size_t)(row >> 6) * 4 + (m == 0 ? fr : fr - 12)) * FF2 + ncol; *(f32x4*)hb = ca; *(f32x4*)(hb + 4) = cb; }
                pa = ca; pb = cb;
            }
        }
    }
}
DI void ffn_fix_phase(const int tid, const P& p, int layer, int G, int c) {
    const float* hb = (const float*)(p.ws + F_HB); bf16_t* act = (bf16_t*)(p.ws + F_ACT);
    const float* cw = p.in[28] + (size_t)layer * 3 * FF2; const float* cbv = p.in[29] + (size_t)layer * FF2;
    const int nitems = 1024 * 2 * 704;
    for (int it = c * 512 + tid; it < nitems; it += G * 512) {
        const int q = it % 704, t = (it / 704) & 1, kb = it / 1408, j0 = q * 4, nc = q * 8;
        const bool first = (kb & 31) == 0;
        const float* r0 = hb + ((size_t)kb * 4 + t) * FF2 + nc;
        const float* r1 = (t == 1) ? hb + ((size_t)kb * 4 + 0) * FF2 + nc : hb + ((size_t)(kb - 1) * 4 + 3) * FF2 + nc;
        const float* r2 = (t == 1) ? hb + ((size_t)(kb - 1) * 4 + 3) * FF2 + nc : hb + ((size_t)(kb - 1) * 4 + 2) * FF2 + nc;
        const f32x4 z4 = (f32x4){0.f, 0.f, 0.f, 0.f};
        const f32x4 a0 = *(const f32x4*)r0, b0 = *(const f32x4*)(r0 + 4);
        const bool have1 = (t == 1) || !first, have2 = !first;
        const f32x4 a1 = have1 ? *(const f32x4*)r1 : z4, b1 = have1 ? *(const f32x4*)(r1 + 4) : z4;
        const f32x4 a2 = have2 ? *(const f32x4*)r2 : z4, b2 = have2 ? *(const f32x4*)(r2 + 4) : z4;
        const f32x4 wa0 = *(const f32x4*)(cw + j0), wa1 = *(const f32x4*)(cw + FF2 + j0), wa2 = *(const f32x4*)(cw + 2 * FF2 + j0);
        const f32x4 wb0 = *(const f32x4*)(cw + FFH + j0), wb1 = *(const f32x4*)(cw + FF2 + FFH + j0), wb2 = *(const f32x4*)(cw + 2 * FF2 + FFH + j0);
        const f32x4 ba = *(const f32x4*)(cbv + j0), bb = *(const f32x4*)(cbv + FFH + j0);
        float o[4];
#pragma unroll
        for (int e = 0; e < 4; ++e) { const float ya = fmaf(wa0[e], a2[e], fmaf(wa1[e], a1[e], fmaf(wa2[e], a0[e], ba[e]))), yb = fmaf(wb0[e], b2[e], fmaf(wb1[e], b1[e], fmaf(wb2[e], b0[e], bb[e]))); o[e] = silu_fast(ya) * yb; }
        u32x2 w; w.x = pk2(o[0], o[1]); w.y = pk2(o[2], o[3]);
        *(u32x2*)(act + ((size_t)kb * 64 + t) * FFH + j0) = w;
    }
}

DI void prep_unit(const int tid, LAS unsigned char* lds, const float* src, bf16_t* dst, int K, int N, int u, bool perm) {
    LAS float* tile = (LAS float*)lds;
    const int ntk = K / 64, tk = u % ntk, tn = u / ntk;
    { const int c4 = tid & 63, kb = tid >> 6, n = tn * 256 + c4 * 4, ns = perm ? (((n & 4) ? FFH : 0) + (n >> 3) * 4) : n;
      f32x4 v[8];
#pragma unroll
      for (int kk = 0; kk < 8; ++kk) { const int k = kb + kk * 8; v[kk] = (n < N) ? *(const f32x4*)(src + (size_t)(tk * 64 + k) * N + ns) : (f32x4){0.f, 0.f, 0.f, 0.f}; }
#pragma unroll
      for (int kk = 0; kk < 8; ++kk) *(LAS f32x4*)(tile + (kb + kk * 8) * 260 + c4 * 4) = v[kk]; }
    __syncthreads();
#pragma unroll
    for (int i = 0; i < 4; ++i) { const int pc = tid + i * 512, nl = pc & 255, k8 = pc >> 8;
        float t[8];
#pragma unroll
        for (int e = 0; e < 8; ++e) t[e] = tile[(k8 * 8 + e) * 260 + nl];
        u32x4 w; w.x = pk2(t[0], t[1]); w.y = pk2(t[2], t[3]); w.z = pk2(t[4], t[5]); w.w = pk2(t[6], t[7]);
        *(u32x4*)(dst + (size_t)(tn * 256 + nl) * K + tk * 64 + k8 * 8) = w; }
    __syncthreads();
}

template <bool TO_BF16>
DI void rms_rows(const int tid, const float* src, const float* gam, bf16_t* dst, float* fdst, int G, int c) {
    constexpr int NR = 8;
    const int wave = tid >> 6, lane = tid & 63;
    f32x4 g4[4];
#pragma unroll
    for (int k = 0; k < 4; ++k) g4[k] = *(const f32x4*)(gam + k * 256 + lane * 4);
    for (int r = (c * 8 + wave) * NR; r < MTOK; r += G * 8 * NR) {
        f32x4 v[NR][4]; float s[NR];
#pragma unroll
        for (int q = 0; q < NR; ++q)
#pragma unroll
            for (int k = 0; k < 4; ++k) v[q][k] = *(const f32x4*)(src + (size_t)(r + q) * 1024 + k * 256 + lane * 4);
#pragma unroll
        for (int q = 0; q < NR; ++q) { s[q] = 0.f;
#pragma unroll
            for (int k = 0; k < 4; ++k) s[q] += v[q][k][0] * v[q][k][0] + v[q][k][1] * v[q][k][1] + v[q][k][2] * v[q][k][2] + v[q][k][3] * v[q][k][3]; }
#pragma unroll
        for (int o = 32; o > 0; o >>= 1)
#pragma unroll
            for (int q = 0; q < NR; ++q) s[q] += __shfl_xor(s[q], o);
#pragma unroll
        for (int q = 0; q < NR; ++q) { const float sc = rsqrtf(s[q] * (1.f / 1024.f) + 1e-6f);
#pragma unroll
            for (int k = 0; k < 4; ++k) {
                if (TO_BF16) { u32x2 o; o.x = pk2(v[q][k][0] * sc * g4[k][0], v[q][k][1] * sc * g4[k][1]); o.y = pk2(v[q][k][2] * sc * g4[k][2], v[q][k][3] * sc * g4[k][3]);
                    *(u32x2*)(dst + (size_t)(r + q) * 1024 + k * 256 + lane * 4) = o; }
                else *(f32x4*)(fdst + (size_t)(r + q) * 1024 + k * 256 + lane * 4) = v[q][k] * sc * g4[k]; } }
    }
}
DI void rms_phase(const int tid, const float* src, const float* gam, bf16_t* dst, int G, int c) { rms_rows<true>(tid, src, gam, dst, nullptr, G, c); }
DI void rms_final(const int tid, float* io, const float* gam, int G, int c) { rms_rows<false>(tid, io, gam, nullptr, io, G, c); }
DI void rms_owned(const int tid, float* h, const float* gam, bf16_t* dst, int G, int c) {
    const int wave = tid >> 6, lane = tid & 63;
    for (int pm = c; pm < MTOK / 256; pm += G)
        for (int rr = 0; rr < 32; ++rr) {
            const int r = pm * 256 + wave * 32 + rr;
            float* p = h + (size_t)r * 1024; f32x4 v[4]; float ss = 0.f;
#pragma unroll
            for (int k = 0; k < 4; ++k) { v[k] = *(const f32x4*)(p + k * 256 + lane * 4); ss += v[k][0] * v[k][0] + v[k][1] * v[k][1] + v[k][2] * v[k][2] + v[k][3] * v[k][3]; }
            ss = wave_sum(ss); const float sc = rsqrtf(ss * (1.f / 1024.f) + 1e-6f);
#pragma unroll
            for (int k = 0; k < 4; ++k) { const f32x4 g4 = *(const f32x4*)(gam + k * 256 + lane * 4);
                if (dst) { u32x2 o; o.x = pk2(v[k][0] * sc * g4[0], v[k][1] * sc * g4[1]); o.y = pk2(v[k][2] * sc * g4[2], v[k][3] * sc * g4[3]); *(u32x2*)(dst + (size_t)r * 1024 + k * 256 + lane * 4) = o; }
                else *(f32x4*)(p + k * 256 + lane * 4) = v[k] * sc * g4; }
        }
}

template <bool PASSB>
DI void s5_pass(const int tid, LAS unsigned char* lds, const P& p, int G, int c0) {
    const int wave = tid >> 6, lane = tid & 63, fr = lane & 15, fq = lane >> 4;
    LAS float* ubuf = (LAS float*)(lds + wave * 8192);
    LAS bf16_t* hbuf = (LAS bf16_t*)(lds + wave * 8192 + 1024);
    const float* abar = (const float*)(p.ws + W_S5AB); const float* bbar = (const float*)(p.ws + W_S5BB); const bf16_t* ccat = (const bf16_t*)(p.ws + W_S5CC);
    const bf16_t* us5 = (const bf16_t*)(p.ws + A_US5); bf16_t* zs5 = (bf16_t*)(p.ws + A_ZS5); float* hend = (float*)(p.ws + A_S5END);
    const float* dskip = p.in[10];
    for (int bu = c0; bu < 512; bu += G) {
        const int g = bu >> 5, wu = (bu & 31) * 8 + wave, b = wu >> 3, seg = wu & 7;
        float bre[16], bim[16];
        { const f32x4* bp = (const f32x4*)(bbar + ((size_t)(g * 64 + lane)) * 32);
#pragma unroll
          for (int k = 0; k < 4; ++k) { f32x4 v = bp[k]; bre[4 * k] = v[0]; bre[4 * k + 1] = v[1]; bre[4 * k + 2] = v[2]; bre[4 * k + 3] = v[3]; }
#pragma unroll
          for (int k = 0; k < 4; ++k) { f32x4 v = bp[4 + k]; bim[4 * k] = v[0]; bim[4 * k + 1] = v[1]; bim[4 * k + 2] = v[2]; bim[4 * k + 3] = v[3]; } }
        const float are = abar[(g * 64 + lane) * 2], aim = abar[(g * 64 + lane) * 2 + 1];
        float hre = 0.f, him = 0.f;
        bf16x8 cf[4]; float dsk = 0.f;
        if (PASSB) {
#pragma unroll
            for (int ks = 0; ks < 4; ++ks) cf[ks] = *(const bf16x8*)(ccat + ((size_t)(g * 16 + fr)) * 128 + ks * 32 + fq * 8);
            dsk = dskip[g * 16 + fr];
            float pr = are, pi = aim;
#pragma unroll
            for (int s = 0; s < 8; ++s) { const float nr = pr * pr - pi * pi, ni = 2.f * pr * pi; pr = nr; pi = ni; }
            for (int s = 0; s < seg; ++s) { const float* he = hend + (((size_t)(b * 16 + g) * 8 + s) * 64 + lane) * 2; const float er = he[0], ei = he[1];
                const float nr = pr * hre - pi * him + er, ni = pr * him + pi * hre + ei; hre = nr; him = ni; }
        }
        const size_t tokbase = (size_t)b * SEQ + seg * 256;
        for (int tile = 0; tile < 16; ++tile) {
            if (lane < 32) { const int tk = lane >> 1, hf = lane & 1;
                const u32x4 raw = *(const u32x4*)(us5 + (tokbase + tile * 16 + tk) * 256 + g * 16 + hf * 8);
                LAS float* d = ubuf + tk * 16 + hf * 8;
                *(LAS f32x4*)d = (f32x4){lo16(raw.x), hi16(raw.x), lo16(raw.y), hi16(raw.y)}; *(LAS f32x4*)(d + 4) = (f32x4){lo16(raw.z), hi16(raw.z), lo16(raw.w), hi16(raw.w)}; }
            lds_wait();
#pragma unroll 4
            for (int t = 0; t < 16; ++t) {
                float bur = 0.f, bui = 0.f;
#pragma unroll
                for (int k = 0; k < 4; ++k) { const f32x4 u = *(const LAS f32x4*)(ubuf + t * 16 + k * 4);
#pragma unroll
                    for (int e = 0; e < 4; ++e) { bur += bre[4 * k + e] * u[e]; bui += bim[4 * k + e] * u[e]; } }
                const float nr = are * hre - aim * him + bur, ni = are * him + aim * hre + bui; hre = nr; him = ni;
                if (PASSB) { hbuf[t * 136 + lane] = f2bf(hre); hbuf[t * 136 + 64 + lane] = f2bf(-him); }
            }
            if (PASSB) {
                lds_wait();
                f32x4 acc = (f32x4){0.f, 0.f, 0.f, 0.f};
#pragma unroll
                for (int ks = 0; ks < 4; ++ks) { const bf16x8 a = *(const LAS bf16x8*)(hbuf + fr * 136 + ks * 32 + fq * 8); acc = mfma16(a, cf[ks], acc); }
#pragma unroll
                for (int j = 0; j < 4; ++j) { const int tk = fq * 4 + j; const float y = acc[j] + dsk * ubuf[tk * 16 + fr];
                    zs5[(tokbase + tile * 16 + tk) * 256 + g * 16 + fr] = f2bf(gelu_tanh(y)); }
            }
            lds_wait();
        }
        if (!PASSB) { float* he = hend + (((size_t)(b * 16 + g) * 8 + seg) * 64 + lane) * 2; he[0] = hre; he[1] = him; }
    }
}

DI void gdn_prep_phase(const int tid, LAS unsigned char* lds, const P& p, int G, int c) {
    const int hb = tid >> 8, ht = tid & 255, lane = tid & 63, wv = __builtin_amdgcn_readfirstlane(ht >> 6), fr = lane & 15, fq = lane >> 4;
    LAS unsigned char* base = lds + hb * 65536;
    LAS bf16_t* Qs = (LAS bf16_t*)base; LAS bf16_t* Ks = Qs + 64 * 136;
    LAS float* Ls = (LAS float*)(base + 2 * 17408); LAS float* tb = (LAS float*)(base + 3 * 17408);
    const bf16_t* qkv = (const bf16_t*)(p.ws + A_QKV); const float* blal = (const float*)(p.ws + A_BLAL);
    const float* convw = p.in[13]; const float* a_log = p.in[14]; const float* dt_bias = p.in[15];
    bf16_t* Uc = (bf16_t*)(p.ws + CH_U); bf16_t* Wc = (bf16_t*)(p.ws + CH_W); bf16_t* QDc = (bf16_t*)(p.ws + CH_QD); bf16_t* KDTc = (bf16_t*)(p.ws + CH_KDT); bf16_t* INc = (bf16_t*)(p.ws + CH_INTRA); float* GLc = (float*)(p.ws + CH_GL);
    for (int u = c * 2 + hb; u < 6144; u += 2 * G) {
        const int n = u & 31, bh = u >> 5, h = bh % 6, b = bh / 6; const size_t cid = (size_t)u;
        const long tok0 = (long)b * SEQ + n * 64;
        float xs[64];
        {
            const int ch = ht & 127, th = ht >> 7, isv = th, colq = h * 128 + ch, colkv = 768 + isv * 768 + h * 128 + ch, t0 = th * 32;
            bf16_t qraw[35], kvraw[67];
            const bool haloq = (n > 0) || (t0 > 0), halokv = (n > 0);
#pragma unroll
            for (int e = 0; e < 3; ++e) { qraw[e] = haloq ? qkv[(tok0 + t0 - 3 + e) * 2304 + colq] : (bf16_t)0; kvraw[e] = halokv ? qkv[(tok0 - 3 + e) * 2304 + colkv] : (bf16_t)0; }
#pragma unroll
            for (int e = 0; e < 32; ++e) qraw[3 + e] = qkv[(tok0 + t0 + e) * 2304 + colq];
#pragma unroll
            for (int e = 0; e < 64; ++e) kvraw[3 + e] = qkv[(tok0 + e) * 2304 + colkv];
            { const float w0 = convw[colq], w1 = convw[2304 + colq], w2 = convw[4608 + colq], w3 = convw[6912 + colq];
#pragma unroll
              for (int e = 0; e < 32; ++e) { const float y = w0 * bf2f(qraw[e]) + w1 * bf2f(qraw[e + 1]) + w2 * bf2f(qraw[e + 2]) + w3 * bf2f(qraw[e + 3]); Qs[(t0 + e) * 136 + ch] = f2bf(silu_fast(y)); } }
            { const float w0 = convw[colkv], w1 = convw[2304 + colkv], w2 = convw[4608 + colkv], w3 = convw[6912 + colkv];
#pragma unroll
              for (int e = 0; e < 64; ++e) { const float y = w0 * bf2f(kvraw[e]) + w1 * bf2f(kvraw[e + 1]) + w2 * bf2f(kvraw[e + 2]) + w3 * bf2f(kvraw[e + 3]); xs[e] = silu_fast(y); }
              if (!isv) {
#pragma unroll
                  for (int tt = 0; tt < 64; ++tt) Ks[tt * 136 + ch] = f2bf(xs[tt]); } }
        }
        if (ht < 64) { const float bl = blal[(tok0 + ht) * 16 + h], al = blal[(tok0 + ht) * 16 + 6 + h];
            const float x = al + dt_bias[h]; const float sp = fmaxf(x, 0.f) + log1pf(expf(-fabsf(x))); float gsum = -expf(a_log[h]) * sp;
#pragma unroll
            for (int off = 1; off < 64; off <<= 1) { const float v = __shfl_up(gsum, off); if (lane >= off) gsum += v; }
            tb[ht] = 1.f / (1.f + expf(-bl)); tb[64 + ht] = gsum; }
        __syncthreads();
        f32x4 kk[4], qk[4];
        { bf16x8 aK[4], aQ[4];
#pragma unroll
          for (int ks = 0; ks < 4; ++ks) { aK[ks] = *(const LAS bf16x8*)(Ks + (wv * 16 + fr) * 136 + ks * 32 + fq * 8); aQ[ks] = *(const LAS bf16x8*)(Qs + (wv * 16 + fr) * 136 + ks * 32 + fq * 8); }
          f32x4 qq = (f32x4){0.f, 0.f, 0.f, 0.f};
#pragma unroll
          for (int ks = 0; ks < 4; ++ks) qq = mfma16(aQ[ks], aQ[ks], qq);
#pragma unroll
          for (int ct = 0; ct < 4; ++ct) { kk[ct] = (f32x4){0.f, 0.f, 0.f, 0.f}; qk[ct] = (f32x4){0.f, 0.f, 0.f, 0.f};
              if (ct <= wv) {
#pragma unroll
                  for (int ks = 0; ks < 4; ++ks) { const bf16x8 bK = *(const LAS bf16x8*)(Ks + (ct * 16 + fr) * 136 + ks * 32 + fq * 8); kk[ct] = mfma16(aK[ks], bK, kk[ct]); qk[ct] = mfma16(aQ[ks], bK, qk[ct]); } }
              if (ct == wv && (fr >> 2) == fq) { const int j = fr & 3; const float dk = j == 0 ? kk[ct][0] : j == 1 ? kk[ct][1] : j == 2 ? kk[ct][2] : kk[ct][3];
                  const float dq = j == 0 ? qq[0] : j == 1 ? qq[1] : j == 2 ? qq[2] : qq[3]; tb[128 + wv * 16 + fr] = dq; tb[192 + wv * 16 + fr] = dk; } } }
        __syncthreads();
        {
            float rkc[4], rqc[4], gcc[4], btc[4], rks[4], gcs[4];
#pragma unroll
            for (int j = 0; j < 4; ++j) { const int cr = wv * 16 + fq * 4 + j; rkc[j] = rsqrtf(tb[192 + cr] + 1e-6f); rqc[j] = rsqrtf(tb[128 + cr] + 1e-6f) * 0.08838834764831845f; gcc[j] = tb[64 + cr]; btc[j] = tb[cr]; }
#pragma unroll
            for (int ct = 0; ct < 4; ++ct) { const int sc = ct * 16 + fr; rks[ct] = rsqrtf(tb[192 + sc] + 1e-6f); gcs[ct] = tb[64 + sc]; }
#pragma unroll
            for (int ct = 0; ct < 4; ++ct)
#pragma unroll
                for (int j = 0; j < 4; ++j) { const int cr = wv * 16 + fq * 4 + j, sc = ct * 16 + fr;
                    const float e = (sc <= cr) ? __expf(gcc[j] - gcs[ct]) : 0.f;
                    Ls[(cr >> 1) * 136 + sc * 2 + (cr & 1)] = (sc < cr) ? btc[j] * rkc[j] * rks[ct] * kk[ct][j] * e : 0.f;
                    INc[cid * 4096 + cr * 64 + sc] = f2bf(rqc[j] * rks[ct] * qk[ct][j] * e); }
            if (ht < 64) { const float rk = rsqrtf(tb[192 + ht] + 1e-6f), gch = tb[64 + ht];
                tb[256 + ht] = rk * __expf(tb[64 + 63] - gch); tb[320 + ht] = rk * tb[ht] * __expf(gch); }
        }
        __syncthreads();
        { const int ch = ht & 127, isv = ht >> 7; const float gl = tb[64 + 63];
          if (!isv) {
#pragma unroll
              for (int i8 = 0; i8 < 8; ++i8) { float kd[8];
#pragma unroll
                  for (int e = 0; e < 8; ++e) { const int tt = i8 * 8 + e; kd[e] = xs[tt] * tb[256 + tt]; xs[tt] = xs[tt] * tb[320 + tt]; }
                  u32x4 w; w.x = pk2(kd[0], kd[1]); w.y = pk2(kd[2], kd[3]); w.z = pk2(kd[4], kd[5]); w.w = pk2(kd[6], kd[7]);
                  *(u32x4*)(KDTc + cid * 8192 + ch * 64 + i8 * 8) = w; }
          } else {
#pragma unroll
              for (int tt = 0; tt < 64; ++tt) xs[tt] *= tb[tt]; }
#pragma unroll
          for (int kb = 0; kb < 8; ++kb) {
#pragma unroll
              for (int pp = 0; pp < 4; ++pp) { const int pr = 4 * kb + pp;
                  f32x2 s = (f32x2){xs[2 * pr], xs[2 * pr + 1]};
#pragma unroll
                  for (int j = 8 * kb; j < 2 * pr; j += 2) { const f32x4 l = *(const LAS f32x4*)(Ls + pr * 136 + j * 2);
                      s -= (f32x2){l[0], l[1]} * (f32x2){xs[j], xs[j]}; s -= (f32x2){l[2], l[3]} * (f32x2){xs[j + 1], xs[j + 1]}; }
                  xs[2 * pr] = s[0];
                  xs[2 * pr + 1] = s[1] - Ls[pr * 136 + 4 * pr + 1] * s[0]; }
#pragma unroll
              for (int pr = 4 * kb + 4; pr < 32; ++pr) {
                  f32x2 s0 = (f32x2){xs[2 * pr], xs[2 * pr + 1]}, s1 = (f32x2){0.f, 0.f};
#pragma unroll
                  for (int q = 0; q < 4; ++q) { const int j = 8 * kb + 2 * q; const f32x4 l = *(const LAS f32x4*)(Ls + pr * 136 + j * 2);
                      s0 -= (f32x2){l[0], l[1]} * (f32x2){xs[j], xs[j]}; s1 -= (f32x2){l[2], l[3]} * (f32x2){xs[j + 1], xs[j + 1]}; }
                  const f32x2 s = s0 + s1; xs[2 * pr] = s[0]; xs[2 * pr + 1] = s[1]; }
          }
          if (isv) {
#pragma unroll
              for (int i8 = 0; i8 < 8; ++i8) { u32x4 w; w.x = pk2(xs[i8 * 8], xs[i8 * 8 + 1]); w.y = pk2(xs[i8 * 8 + 2], xs[i8 * 8 + 3]); w.z = pk2(xs[i8 * 8 + 4], xs[i8 * 8 + 5]); w.w = pk2(xs[i8 * 8 + 6], xs[i8 * 8 + 7]);
                  *(u32x4*)(Uc + cid * 8192 + ch * 64 + i8 * 8) = w; }
          } else { bf16_t* dst = Wc + cid * 8192 + ch;
#pragma unroll
              for (int tt = 0; tt < 64; ++tt) dst[tt * 128] = f2bf(xs[tt]); }
          { const int tt = ht >> 2, d0 = (ht & 3) * 32; const float fac = rsqrtf(tb[128 + tt] + 1e-6f) * 0.08838834764831845f * __expf(tb[64 + tt]);
#pragma unroll
            for (int i = 0; i < 4; ++i) { const u32x4 r = *(const LAS u32x4*)(Qs + tt * 136 + d0 + i * 8); u32x4 w;
                w.x = pk2(lo16(r.x) * fac, hi16(r.x) * fac); w.y = pk2(lo16(r.y) * fac, hi16(r.y) * fac); w.z = pk2(lo16(r.z) * fac, hi16(r.z) * fac); w.w = pk2(lo16(r.w) * fac, hi16(r.w) * fac);
                *(u32x4*)(QDc + cid * 8192 + tt * 128 + d0 + i * 8) = w; } }
          if (ht == 0) GLc[cid] = __expf(gl); }
        __syncthreads();
    }
}

DI void gdn_seq_phase(const int tid, LAS unsigned char* lds, const P& p, int G, int c) {
    const int w = __builtin_amdgcn_readfirstlane(tid >> 6), lane = tid & 63, fr = lane & 15, fq = lane >> 4, ct = w & 3, eh = w >> 2;
    LAS bf16_t* ST = (LAS bf16_t*)lds;
    LAS bf16_t* VT = (LAS bf16_t*)(lds + 34816);
    LAS float* OT = (LAS float*)(lds + 34816 + 18432);
    const bf16_t* Uc = (const bf16_t*)(p.ws + CH_U); const bf16_t* Wc = (const bf16_t*)(p.ws + CH_W); const bf16_t* QDc = (const bf16_t*)(p.ws + CH_QD); const bf16_t* KDTc = (const bf16_t*)(p.ws + CH_KDT); const bf16_t* INc = (const bf16_t*)(p.ws + CH_INTRA); const float* GLc = (const float*)(p.ws + CH_GL);
    const bf16_t* Z = (const bf16_t*)(p.ws + A_Z); bf16_t* ycat = (bf16_t*)(p.ws + A_YCAT); const float* normw = p.in[16];
    for (int u = c; u < 192; u += G) {
        const int h = u % 6, b = u / 6;
        for (int i = tid; i < 128 * 136 / 2; i += 512) ((LAS unsigned*)ST)[i] = 0u;
        f32x4 Sacc[8];
#pragma unroll
        for (int e = 0; e < 8; ++e) Sacc[e] = (f32x4){0.f, 0.f, 0.f, 0.f};
        __syncthreads();
        bf16x8 Wf[4], Qf[4], If[2], Kf[2]; u32x2 uvr[4]; float gl;
        const int wrow = (ct * 16 + fr) * 128 + fq * 8, irow = (ct * 16 + fr) * 64 + fq * 8, krow = (w * 16 + fr) * 64 + fq * 8;
        { const size_t cid = (size_t)u * 32;
#pragma unroll
          for (int ks = 0; ks < 4; ++ks) { Wf[ks] = *(const bf16x8*)(Wc + cid * 8192 + wrow + ks * 32); Qf[ks] = *(const bf16x8*)(QDc + cid * 8192 + wrow + ks * 32); }
#pragma unroll
          for (int ks = 0; ks < 2; ++ks) { If[ks] = *(const bf16x8*)(INc + cid * 4096 + irow + ks * 32); Kf[ks] = *(const bf16x8*)(KDTc + cid * 8192 + krow + ks * 32); }
#pragma unroll
          for (int et = 0; et < 4; ++et) uvr[et] = *(const u32x2*)(Uc + cid * 8192 + (eh * 64 + et * 16 + fr) * 64 + ct * 16 + fq * 4);
          gl = GLc[cid]; }
        for (int n = 0; n < 32; ++n) {
            const size_t cid = (size_t)u * 32 + n, cnx = (cid + 1 < 6144) ? cid + 1 : cid;
            const int tt = tid >> 3, e0 = (tid & 7) * 16; const size_t tok = (size_t)b * SEQ + n * 64 + tt;
            const u32x4 z0 = *(const u32x4*)(Z + tok * 768 + h * 128 + e0), z1 = *(const u32x4*)(Z + tok * 768 + h * 128 + e0 + 8);
            f32x4 T1[4], O1[4];
#pragma unroll
            for (int et = 0; et < 4; ++et) { T1[et] = (f32x4){0.f, 0.f, 0.f, 0.f}; O1[et] = (f32x4){0.f, 0.f, 0.f, 0.f};
#pragma unroll
                for (int ks = 0; ks < 4; ++ks) { const bf16x8 bb = *(const LAS bf16x8*)(ST + (eh * 64 + et * 16 + fr) * 136 + ks * 32 + fq * 8); T1[et] = mfma16(Wf[ks], bb, T1[et]); O1[et] = mfma16(Qf[ks], bb, O1[et]); } }
#pragma unroll
            for (int ks = 0; ks < 4; ++ks) { Wf[ks] = *(const bf16x8*)(Wc + cnx * 8192 + wrow + ks * 32); Qf[ks] = *(const bf16x8*)(QDc + cnx * 8192 + wrow + ks * 32); }
#pragma unroll
            for (int et = 0; et < 4; ++et) { u32x2 pk; pk.x = pk2(lo16(uvr[et].x) - T1[et][0], hi16(uvr[et].x) - T1[et][1]); pk.y = pk2(lo16(uvr[et].y) - T1[et][2], hi16(uvr[et].y) - T1[et][3]);
                *(LAS u32x2*)(VT + (eh * 64 + et * 16 + fr) * 72 + ct * 16 + fq * 4) = pk; }
#pragma unroll
            for (int et = 0; et < 4; ++et) uvr[et] = *(const u32x2*)(Uc + cnx * 8192 + (eh * 64 + et * 16 + fr) * 64 + ct * 16 + fq * 4);
            __syncthreads();
#pragma unroll
            for (int et = 0; et < 4; ++et) {
#pragma unroll
                for (int ks = 0; ks < 2; ++ks) { const bf16x8 bb = *(const LAS bf16x8*)(VT + (eh * 64 + et * 16 + fr) * 72 + ks * 32 + fq * 8); O1[et] = mfma16(If[ks], bb, O1[et]); }
#pragma unroll
                for (int j = 0; j < 4; ++j) OT[(ct * 16 + fq * 4 + j) * 132 + eh * 64 + et * 16 + fr] = O1[et][j]; }
#pragma unroll
            for (int ks = 0; ks < 2; ++ks) If[ks] = *(const bf16x8*)(INc + cnx * 4096 + irow + ks * 32);
#pragma unroll
            for (int e8 = 0; e8 < 8; ++e8) { Sacc[e8] = Sacc[e8] * gl;
#pragma unroll
                for (int ks = 0; ks < 2; ++ks) { const bf16x8 aa = *(const LAS bf16x8*)(VT + (e8 * 16 + fr) * 72 + ks * 32 + fq * 8); Sacc[e8] = mfma16(aa, Kf[ks], Sacc[e8]); } }
#pragma unroll
            for (int ks = 0; ks < 2; ++ks) Kf[ks] = *(const bf16x8*)(KDTc + cnx * 8192 + krow + ks * 32);
            gl = GLc[cnx];
#pragma unroll
            for (int e8 = 0; e8 < 8; ++e8)
#pragma unroll
                for (int j = 0; j < 4; ++j) ST[(e8 * 16 + fq * 4 + j) * 136 + w * 16 + fr] = f2bf(Sacc[e8][j]);
            __syncthreads();
            { float o[16]; float ss = 0.f;
#pragma unroll
              for (int i = 0; i < 4; ++i) { const f32x4 v = *(const LAS f32x4*)(OT + tt * 132 + e0 + i * 4); o[4 * i] = v[0]; o[4 * i + 1] = v[1]; o[4 * i + 2] = v[2]; o[4 * i + 3] = v[3]; ss += v[0] * v[0] + v[1] * v[1] + v[2] * v[2] + v[3] * v[3]; }
              ss += __shfl_xor(ss, 1); ss += __shfl_xor(ss, 2); ss += __shfl_xor(ss, 4);
              const float sc = rsqrtf(ss * (1.f / 128.f) + 1e-6f);
              float zz[16] = {lo16(z0.x), hi16(z0.x), lo16(z0.y), hi16(z0.y), lo16(z0.z), hi16(z0.z), lo16(z0.w), hi16(z0.w), lo16(z1.x), hi16(z1.x), lo16(z1.y), hi16(z1.y), lo16(z1.z), hi16(z1.z), lo16(z1.w), hi16(z1.w)};
              float r[16];
#pragma unroll
              for (int i = 0; i < 16; ++i) r[i] = o[i] * sc * normw[e0 + i] * silu_fast(zz[i]);
              u32x4 w0, w1; w0.x = pk2(r[0], r[1]); w0.y = pk2(r[2], r[3]); w0.z = pk2(r[4], r[5]); w0.w = pk2(r[6], r[7]); w1.x = pk2(r[8], r[9]); w1.y = pk2(r[10], r[11]); w1.z = pk2(r[12], r[13]); w1.w = pk2(r[14], r[15]);
              *(u32x4*)(ycat + tok * 1024 + 256 + h * 128 + e0) = w0; *(u32x4*)(ycat + tok * 1024 + 256 + h * 128 + e0 + 8) = w1; }
        }
        __syncthreads();
    }
}

DI void convact_phase(const int tid, const P& p, int layer, int half, int G, int c) {
    const bf16_t* up = (const bf16_t*)(p.ws + F_UP); bf16_t* act = (bf16_t*)(p.ws + F_ACT);
    const float* cw = p.in[28] + (size_t)layer * 3 * FF2; const float* cb = p.in[29] + (size_t)layer * FF2;
    const int nitems = (32768 / 8) * 352;
    for (int it = c * 512 + tid; it < nitems; it += G * 512) {
        const int ck = it % 352, run = it / 352, ch = ck * 8, r0 = run * 8, sp0 = r0 & 2047;
        float wa[3][8], wb[3][8], ba[8], bb[8];
#pragma unroll
        for (int k = 0; k < 3; ++k)
#pragma unroll
            for (int e = 0; e < 8; ++e) { wa[k][e] = cw[k * FF2 + ch + e]; wb[k][e] = cw[k * FF2 + FFH + ch + e]; }
#pragma unroll
        for (int e = 0; e < 8; ++e) { ba[e] = cb[ch + e]; bb[e] = cb[FFH + ch + e]; }
        u32x4 a0 = (u32x4){0, 0, 0, 0}, a1 = a0, b0 = a0, b1 = a0;
        if (sp0 > 0) { a0 = *(const u32x4*)(up + (size_t)(r0 - 2) * FF2 + ch); a1 = *(const u32x4*)(up + (size_t)(r0 - 1) * FF2 + ch); b0 = *(const u32x4*)(up + (size_t)(r0 - 2) * FF2 + FFH + ch); b1 = *(const u32x4*)(up + (size_t)(r0 - 1) * FF2 + FFH + ch); }
#pragma unroll
        for (int r = 0; r < 8; ++r) {
            const u32x4 a2 = *(const u32x4*)(up + (size_t)(r0 + r) * FF2 + ch), b2 = *(const u32x4*)(up + (size_t)(r0 + r) * FF2 + FFH + ch);
            const unsigned A0[4] = {a0.x, a0.y, a0.z, a0.w}, A1[4] = {a1.x, a1.y, a1.z, a1.w}, A2[4] = {a2.x, a2.y, a2.z, a2.w}, B0[4] = {b0.x, b0.y, b0.z, b0.w}, B1[4] = {b1.x, b1.y, b1.z, b1.w}, B2[4] = {b2.x, b2.y, b2.z, b2.w};
            float o[8];
#pragma unroll
            for (int q = 0; q < 4; ++q) {
                const float al = wa[0][2 * q] * lo16(A0[q]) + wa[1][2 * q] * lo16(A1[q]) + wa[2][2 * q] * lo16(A2[q]) + ba[2 * q];
                const float ah = wa[0][2 * q + 1] * hi16(A0[q]) + wa[1][2 * q + 1] * hi16(A1[q]) + wa[2][2 * q + 1] * hi16(A2[q]) + ba[2 * q + 1];
                const float bl = wb[0][2 * q] * lo16(B0[q]) + wb[1][2 * q] * lo16(B1[q]) + wb[2][2 * q] * lo16(B2[q]) + bb[2 * q];
                const float bh = wb[0][2 * q + 1] * hi16(B0[q]) + wb[1][2 * q + 1] * hi16(B1[q]) + wb[2][2 * q + 1] * hi16(B2[q]) + bb[2 * q + 1];
                o[2 * q] = siluf_(al) * bl; o[2 * q + 1] = siluf_(ah) * bh; }
            u32x4 w; w.x = pk2(o[0], o[1]); w.y = pk2(o[2], o[3]); w.z = pk2(o[4], o[5]); w.w = pk2(o[6], o[7]);
            *(u32x4*)(act + ((size_t)half * 32768 + r0 + r) * FFH + ch) = w;
            a0 = a1; a1 = a2; b0 = b1; b1 = b2; }
    }
}

DI void nsa_attn_phase(const int tid0, LAS unsigned char* lds, const P& p, int G, int c) {
    const int w = __builtin_amdgcn_readfirstlane(tid0 >> 6), r = w & 3, qh = w >> 2;
    LAS bf16_t* Qs = (LAS bf16_t*)lds;
    LAS bf16_t* Kc = (LAS bf16_t*)(lds + 36864);
    LAS bf16_t* VcT = (LAS bf16_t*)(lds + 36864 + 18432);
    LAS bf16_t* KV0 = (LAS bf16_t*)(lds + 72704);
    LAS float* imp4 = (LAS float*)(lds + 109568);
    LAS unsigned* selm = (LAS unsigned*)(lds + 109568 + 33792);
    const bf16_t* Q = (const bf16_t*)(p.ws + N_Q); const bf16_t* KS = (const bf16_t*)(p.ws + N_KS); const bf16_t* VST = (const bf16_t*)(p.ws + N_VST); const bf16_t* KW = (const bf16_t*)(p.ws + N_KW); const bf16_t* VWT = (const bf16_t*)(p.ws + N_VWT);
    const bf16_t* KCMP = (const bf16_t*)(p.ws + N_KCMP); const bf16_t* VCMPT = (const bf16_t*)(p.ws + N_VCMPT); const float* gates = (const float*)(p.ws + N_GATES); bf16_t* AO = (bf16_t*)(p.ws + N_AO);
    for (int idx = c; idx < 4096; idx += G) {
        int tid = tid0; asm volatile("" : "+v"(tid));
        const int lane = tid & 63, fr = lane & 15, fq = lane >> 4;
        const int rnd = idx >> 8, hi_half = (idx >> 7) & 1, i = 31 - 2 * rnd - (hi_half ^ (rnd & 1)), bg = idx & 127, b = bg >> 2, g = bg & 3, hd = g * 4 + r;
        const size_t tokb = (size_t)b * SEQ + i * 64;
        const int nkt = (i >> 2) + 1;
#pragma unroll
        for (int k = 0; k < 4; ++k) { const int pc = tid + k * 512, row = pc >> 3, cc = pc & 7, rr = row >> 6, ql = row & 63;
            *(LAS u32x4*)(Qs + row * 72 + cc * 8) = *(const u32x4*)(Q + (tokb + ql) * 1024 + (g * 4 + rr) * 64 + cc * 8); }
#pragma unroll
        for (int k = 0; k < 2; ++k) { const int pc = tid + k * 512; { const int row = pc >> 3, cc = pc & 7; if (row < nkt * 16) *(LAS u32x4*)(Kc + row * 72 + cc * 8) = *(const u32x4*)(KCMP + (size_t)bg * 8192 + row * 64 + cc * 8); }
            { const int row = pc >> 4, cc = pc & 15; *(LAS u32x4*)(VcT + row * 136 + cc * 8) = *(const u32x4*)(VCMPT + (size_t)bg * 8192 + row * 128 + cc * 8); } }
        __syncthreads();
        bf16x8 Qf[2][2];
#pragma unroll
        for (int qt = 0; qt < 2; ++qt)
#pragma unroll
            for (int ks = 0; ks < 2; ++ks) Qf[qt][ks] = *(const LAS bf16x8*)(Qs + (r * 64 + qh * 32 + qt * 16 + fr) * 72 + ks * 32 + fq * 8);
        const float slope2 = exp2f(-0.5f * (float)(hd + 1)) * 1.4426950408889634f;
        float sc16[16];
#pragma unroll
        for (int e = 0; e < 16; ++e) sc16[e] = slope2 * (float)((e >> 2) * 16 + (e & 3));
        int tq[2]; float g0[2], g1[2], g2[2];
#pragma unroll
        for (int qt = 0; qt < 2; ++qt) { const int ql = qh * 32 + qt * 16 + fr; tq[qt] = i * 64 + ql; const float* gp = gates + (tokb + ql) * 48 + hd * 3; g0[qt] = gp[0]; g1[qt] = gp[1]; g2[qt] = gp[2]; }
        f32x4 outacc[4][2];
#pragma unroll
        for (int qt = 0; qt < 2; ++qt) {
            const int jmax = tq[qt] >= 31 ? ((tq[qt] - 31) >> 4) : -1;
            const float sl16 = slope2 * 16.f, jb = (float)(fq * 4);
            f32x4 S[8];
#pragma unroll
            for (int kt = 0; kt < 8; ++kt) { S[kt] = (f32x4){0.f, 0.f, 0.f, 0.f};
                if (kt < nkt) {
#pragma unroll
                    for (int ks = 0; ks < 2; ++ks) { const bf16x8 kf = *(const LAS bf16x8*)(Kc + (kt * 16 + fr) * 72 + ks * 32 + fq * 8); S[kt] = mfma16(kf, Qf[qt][ks], S[kt]); } } }
            float m = -1e30f;
#pragma unroll
            for (int kt = 0; kt < 8; ++kt) if (kt < nkt) {
#pragma unroll
                for (int j = 0; j < 4; ++j) { const int jc = kt * 16 + fq * 4 + j; const float s = fmaf(sl16, jb + (float)(kt * 16 + j), S[kt][j]); S[kt][j] = (jc <= jmax) ? s : -1e30f; m = fmaxf(m, S[kt][j]); } }
            m = fmaxf(m, __shfl_xor(m, 16)); m = fmaxf(m, __shfl_xor(m, 32));
            float l = 0.f;
#pragma unroll
            for (int kt = 0; kt < 8; ++kt) if (kt < nkt) {
#pragma unroll
                for (int j = 0; j < 4; ++j) { const float pv = (S[kt][j] > -1e29f) ? __builtin_amdgcn_exp2f(S[kt][j] - m) : 0.f; S[kt][j] = pv; l += pv; } }
            l += __shfl_xor(l, 16); l += __shfl_xor(l, 32);
            const float inv = l > 0.f ? 1.f / l : 0.f;
            float prev3 = 0.f;
#pragma unroll
            for (int kt = 0; kt < 8; ++kt) if (kt < nkt) {
#pragma unroll
                for (int j = 0; j < 4; ++j) S[kt][j] *= inv;
                const float p3 = S[kt][3];
                const float x1 = __shfl(p3, (lane + 48) & 63), x2 = __shfl(prev3, (lane + 48) & 63);
                const float carry = (fq > 0) ? x1 : x2;
                imp4[(r * 64 + qh * 32 + qt * 16 + fr) * 33 + kt * 4 + fq] = S[kt][0] + S[kt][1] + S[kt][2] + 0.5f * p3 + 0.5f * carry;
                prev3 = p3; }
#pragma unroll
            for (int dt = 0; dt < 4; ++dt) outacc[dt][qt] = (f32x4){0.f, 0.f, 0.f, 0.f};
#pragma unroll
            for (int s = 0; s < 4; ++s) if (2 * s < nkt) {
                u32x4 t; t.x = pk2(S[2 * s][0], S[2 * s][1]); t.y = pk2(S[2 * s][2], S[2 * s][3]); t.z = pk2(S[2 * s + 1][0], S[2 * s + 1][1]); t.w = pk2(S[2 * s + 1][2], S[2 * s + 1][3]);
                const bf16x8 pf = __builtin_bit_cast(bf16x8, t);
#pragma unroll
                for (int dt = 0; dt < 4; ++dt) { u32x4 tv; const u32x2 v0 = *(const LAS u32x2*)(VcT + (dt * 16 + fr) * 136 + s * 32 + fq * 4), v1 = *(const LAS u32x2*)(VcT + (dt * 16 + fr) * 136 + s * 32 + 16 + fq * 4);
                    tv.x = v0.x; tv.y = v0.y; tv.z = v1.x; tv.w = v1.y; outacc[dt][qt] = mfma16(__builtin_bit_cast(bf16x8, tv), pf, outacc[dt][qt]); } }
#pragma unroll
            for (int dt = 0; dt < 4; ++dt) outacc[dt][qt] = outacc[dt][qt] * g0[qt];
        }
        __syncthreads();
        if (tid < 64) { unsigned mask;
            if (i <= 3) mask = (1u << (i + 1)) - 1u;
            else { float v1 = -1.f, v2 = -1.f; int n1 = 0, n2 = 0;
                for (int n = 1; n < i; ++n) { const float v = ((imp4[(0 * 64 + tid) * 33 + n] + imp4[(1 * 64 + tid) * 33 + n]) + imp4[(2 * 64 + tid) * 33 + n]) + imp4[(3 * 64 + tid) * 33 + n];
                    if (v > v1) { v2 = v1; n2 = n1; v1 = v; n1 = n; } else if (v > v2) { v2 = v; n2 = n; } }
                mask = 1u | (1u << i) | (1u << n1) | (1u << n2); }
            selm[tid] = mask; }
        __syncthreads();
        unsigned sm[2];
#pragma unroll
        for (int qt = 0; qt < 2; ++qt) sm[qt] = selm[qh * 32 + qt * 16 + fr];
#pragma unroll 1
        for (int br = 0; br < 2; ++br) {
            const bf16_t* Kg = (br == 0 ? KS : KW) + (size_t)bg * 131072; const bf16_t* Vg = (br == 0 ? VST : VWT) + (size_t)bg * 131072;
            const int n0 = (br == 0) ? 0 : (i >= 4 ? i - 4 : 0), npair = (i - n0 + 2) >> 1;
            f32x4 O[4][2]; float lrun[2] = {0.f, 0.f};
#pragma unroll
            for (int dt = 0; dt < 4; ++dt)
#pragma unroll
                for (int qt = 0; qt < 2; ++qt) O[dt][qt] = (f32x4){0.f, 0.f, 0.f, 0.f};
            const int lrow = tid >> 3, lcc = tid & 7;
            u32x4 kx[2], vx[2];
#pragma unroll
            for (int h = 0; h < 2; ++h) { const int nn = (n0 + h <= i) ? n0 + h : i; kx[h] = *(const u32x4*)(Kg + ((size_t)nn * 64 + lrow) * 64 + lcc * 8); vx[h] = *(const u32x4*)(Vg + (size_t)lrow * 2048 + nn * 64 + lcc * 8); }
            __syncthreads();
#pragma unroll
            for (int h = 0; h < 2; ++h) { *(LAS u32x4*)(KV0 + h * 9216 + lrow * 72 + lcc * 8) = kx[h]; *(LAS u32x4*)(KV0 + h * 9216 + 4608 + lrow * 72 + lcc * 8) = vx[h]; }
            __syncthreads();
#pragma unroll 1
            for (int pi = 0; pi < npair; ++pi) {
                LAS bf16_t* Tc = (pi & 1) ? Qs : KV0; LAS bf16_t* Tn = (pi & 1) ? KV0 : Qs;
                const int na = n0 + 2 * pi;
                if (pi + 1 < npair) {
#pragma unroll
                    for (int h = 0; h < 2; ++h) { const int nn = (na + 2 + h <= i) ? na + 2 + h : i; kx[h] = *(const u32x4*)(Kg + ((size_t)nn * 64 + lrow) * 64 + lcc * 8); vx[h] = *(const u32x4*)(Vg + (size_t)lrow * 2048 + nn * 64 + lcc * 8); } }
                bf16x8 pf[2][2][2]; bool act[2][2];
#pragma unroll
                for (int h = 0; h < 2; ++h) {
                    const int n = na + h; const bool nvalid = (n <= i);
                    const bool edge = (n == i) || (br == 1 && n == i - 4);
                    LAS bf16_t* Kt = Tc + h * 9216;
#pragma unroll
                    for (int qt = 0; qt < 2; ++qt) {
                        const bool bsel = nvalid && ((br == 1) || ((sm[qt] >> n) & 1u));
                        act[h][qt] = nvalid && ((br == 1) || (__ballot(bsel) != 0ull));
                        pf[h][0][qt] = (bf16x8){0, 0, 0, 0, 0, 0, 0, 0}; pf[h][1][qt] = pf[h][0][qt];
                        if (act[h][qt]) {
                            const float sb = bsel ? slope2 * (float)(n * 64 + fq * 4 - tq[qt]) : -1e9f;
                            f32x4 S[4];
#pragma unroll
                            for (int kt = 0; kt < 4; ++kt) { S[kt] = (f32x4){sb + sc16[kt * 4], sb + sc16[kt * 4 + 1], sb + sc16[kt * 4 + 2], sb + sc16[kt * 4 + 3]};
#pragma unroll
                                for (int ks = 0; ks < 2; ++ks) { const bf16x8 kf = *(const LAS bf16x8*)(Kt + (kt * 16 + fr) * 72 + ks * 32 + fq * 8); S[kt] = mfma16(kf, Qf[qt][ks], S[kt]); } }
                            float ls = 0.f;
                            if (edge) {
#pragma unroll
                                for (int kt = 0; kt < 4; ++kt)
#pragma unroll
                                    for (int j = 0; j < 4; ++j) { const int pos = n * 64 + kt * 16 + fq * 4 + j; const bool valid = (pos <= tq[qt]) && (br == 0 || pos > tq[qt] - 256);
                                        const float pv = valid ? __builtin_amdgcn_exp2f(S[kt][j]) : 0.f; S[kt][j] = pv; ls += pv; }
                            } else {
#pragma unroll
                                for (int kt = 0; kt < 4; ++kt)
#pragma unroll
                                    for (int j = 0; j < 4; ++j) { const float pv = __builtin_amdgcn_exp2f(S[kt][j]); S[kt][j] = pv; ls += pv; }
                            }
                            lrun[qt] += ls;
#pragma unroll
                            for (int s = 0; s < 2; ++s) { u32x4 t; t.x = pk2(S[2 * s][0], S[2 * s][1]); t.y = pk2(S[2 * s][2], S[2 * s][3]); t.z = pk2(S[2 * s + 1][0], S[2 * s + 1][1]); t.w = pk2(S[2 * s + 1][2], S[2 * s + 1][3]); pf[h][s][qt] = __builtin_bit_cast(bf16x8, t); }
                        }
                    }
                }
#pragma unroll
                for (int h = 0; h < 2; ++h) {
                    LAS bf16_t* VtT = Tc + h * 9216 + 4608;
                    if (act[h][0] || act[h][1]) {
#pragma unroll
                        for (int s = 0; s < 2; ++s)
#pragma unroll
                            for (int dt = 0; dt < 4; ++dt) { u32x4 t; const u32x2 v0 = *(const LAS u32x2*)(VtT + (dt * 16 + fr) * 72 + s * 32 + fq * 4), v1 = *(const LAS u32x2*)(VtT + (dt * 16 + fr) * 72 + s * 32 + 16 + fq * 4);
                                t.x = v0.x; t.y = v0.y; t.z = v1.x; t.w = v1.y; const bf16x8 vf = __builtin_bit_cast(bf16x8, t);
#pragma unroll
                                for (int qt = 0; qt < 2; ++qt) if (act[h][qt]) O[dt][qt] = mfma16(vf, pf[h][s][qt], O[dt][qt]); } }
                }
                if (pi + 1 < npair) {
#pragma unroll
                    for (int h = 0; h < 2; ++h) { *(LAS u32x4*)(Tn + h * 9216 + lrow * 72 + lcc * 8) = kx[h]; *(LAS u32x4*)(Tn + h * 9216 + 4608 + lrow * 72 + lcc * 8) = vx[h]; } }
                __syncthreads();
            }
#pragma unroll
            for (int qt = 0; qt < 2; ++qt) { float l = lrun[qt]; l += __shfl_xor(l, 16); l += __shfl_xor(l, 32); const float sc = (br == 0 ? g1[qt] : g2[qt]) / l;
#pragma unroll
                for (int dt = 0; dt < 4; ++dt) outacc[dt][qt] = outacc[dt][qt] + O[dt][qt] * sc; }
        }
#pragma unroll
        for (int qt = 0; qt < 2; ++qt)
#pragma unroll
            for (int dt = 0; dt < 4; ++dt) { u32x2 o; o.x = pk2(outacc[dt][qt][0], outacc[dt][qt][1]); o.y = pk2(outacc[dt][qt][2], outacc[dt][qt][3]);
                *(u32x2*)(AO + (tokb + qh * 32 + qt * 16 + fr) * 1024 + hd * 64 + dt * 16 + fq * 4) = o; }
        __syncthreads();
    }
}

DI void weight_prep(const int tid, LAS unsigned char* lds, const P& p, int G, int c, bool late) {
    unsigned char* ws = p.ws;
    {
        const int nu[13] = {224, 64, 4, 176, 64, 32, 32, 4, 4, 352, 352, 176, 176};
        int total = 0;
#pragma unroll
        for (int m = 0; m < 13; ++m) total += nu[m];
        const int u_lo = late ? nu[0] : 0, u_hi = late ? total : nu[0];
        for (int gu = u_lo + c; gu < u_hi; gu += G) {
            int m = 0, u = gu;
#pragma unroll
            for (int q = 0; q < 12; ++q) if (m == q && u >= nu[q]) { u -= nu[q]; m = q + 1; }
            const float* s; bf16_t* d; int K, N; bool perm = false;
            switch (m) {
            case 0: s = p.in[1]; d = (bf16_t*)(ws + W_AB_IN); K = 1024; N = AB_IN; break;
            case 1: s = p.in[2]; d = (bf16_t*)(ws + W_AB_OUT); K = 1024; N = 1024; break;
            case 2: s = p.in[11]; d = (bf16_t*)(ws + W_GLU); K = 256; N = 256; break;
            case 3: s = p.in[17]; d = (bf16_t*)(ws + W_NSA_IN); K = 1024; N = NSA_IN; break;
            case 4: s = p.in[18]; d = (bf16_t*)(ws + W_NSA_OUT); K = 1024; N = 1024; break;
            case 5: s = p.in[21]; d = (bf16_t*)(ws + W_KW1); K = 2048; N = 256; break;
            case 6: s = p.in[24]; d = (bf16_t*)(ws + W_VW1); K = 2048; N = 256; break;
            case 7: s = p.in[23]; d = (bf16_t*)(ws + W_KW2); K = 256; N = 64; break;
            case 8: s = p.in[26]; d = (bf16_t*)(ws + W_VW2); K = 256; N = 64; break;
            case 9: s = p.in[27]; d = (bf16_t*)(ws + W_FFN_IN); K = 1024; N = FF2; perm = true; break;
            case 10: s = p.in[27] + (size_t)1024 * FF2; d = (bf16_t*)(ws + W_FFN_IN) + (size_t)FF2 * 1024; K = 1024; N = FF2; perm = true; break;
            case 11: s = p.in[30]; d = (bf16_t*)(ws + W_FFN_OUT); K = FFH; N = 1024; break;
            default: s = p.in[30] + (size_t)FFH * 1024; d = (bf16_t*)(ws + W_FFN_OUT) + (size_t)1024 * FFH; K = FFH; N = 1024; break;
            }
            prep_unit(tid, lds, s, d, K, N, u, perm);
        }
    }
}
DI void prologue_phase(const int tid, LAS unsigned char* lds, const P& p, int G, int c) {
    unsigned char* ws = p.ws;
    weight_prep(tid, lds, p, G, c, false);
    if (c == G - 1) {
        float* abar = (float*)(ws + W_S5AB); float* bbar = (float*)(ws + W_S5BB); bf16_t* ccat = (bf16_t*)(ws + W_S5CC);
        for (int idx = tid; idx < 1024; idx += 512) { const int g = idx >> 6;
            const float step = expf(p.in[5][g]), lr = p.in[3][idx], li = p.in[4][idx];
            const float mag = expf(lr * step), are = mag * cosf(li * step), aim = mag * sinf(li * step);
            const float den = lr * lr + li * li, nre = are - 1.f, nim = aim;
            const float zre = (nre * lr + nim * li) / den, zim = (nim * lr - nre * li) / den;
            abar[idx * 2] = are; abar[idx * 2 + 1] = aim;
            for (int h = 0; h < 16; ++h) { const float br = p.in[6][idx * 16 + h], bi = p.in[7][idx * 16 + h]; bbar[idx * 32 + h] = zre * br - zim * bi; bbar[idx * 32 + 16 + h] = zre * bi + zim * br; } }
        for (int idx = tid; idx < 16 * 16 * 128; idx += 512) { const int k = idx & 127, gh = idx >> 7;
            ccat[idx] = f2bf(k < 64 ? p.in[8][gh * 64 + k] : p.in[9][gh * 64 + k - 64]); }
        if (tid < 64) ((unsigned*)(ws + W_CTR))[tid] = 0u;
    }
    if (c < 32) {
        const int kv = c >> 4, sl = c & 15, n = tid & 255, hf = tid >> 8; const float* pe = p.in[kv ? 20 : 19]; const float* w1 = p.in[kv ? 24 : 21];
        float wv[64];
#pragma unroll
        for (int k = 0; k < 64; ++k) wv[k] = w1[(size_t)(sl * 128 + hf * 64 + k) * 256 + n];
        float acc = 0.f;
#pragma unroll
        for (int k = 0; k < 64; ++k) acc += pe[sl * 128 + hf * 64 + k] * wv[k];
        ((float*)(ws + W_B1PART))[((kv * 16 + sl) * 2 + hf) * 256 + n] = acc;
    }
    rms_phase(tid, p.in[0], p.in[31], (bf16_t*)(ws + A_HN), G, c);
}

#define XB_TMO      128
#define XB_XCNT(j)  (256  + 64 * (j))
#define XB_XSUB(j)  (1280 + 64 * (j))
#define XB_XGEN(j)  (2304 + 64 * (j))
#define XB_TOP      3328
#define XB_TOPGEN   3392
#define XCD_BAR_WORDS 3456
#define XB_SPIN_CAP (1u << 20)
DI unsigned xb_ld(unsigned* p)              { return __hip_atomic_load(p, __ATOMIC_RELAXED, __HIP_MEMORY_SCOPE_AGENT); }
DI unsigned xb_add(unsigned* p, unsigned v) { return __hip_atomic_fetch_add(p, v, __ATOMIC_RELAXED, __HIP_MEMORY_SCOPE_AGENT); }
DI unsigned xb_xcc_id() { return (unsigned)__builtin_amdgcn_s_getreg((3 << 11) | 20) & 0xFu; }
#define XB_SPIN(cond, bar) do { unsigned _sp = 0; while (cond) { __builtin_amdgcn_s_sleep(1); \
    if ((++_sp & 255u) == 0u) { if (xb_ld(&(bar)[XB_TMO])) break; if (_sp > XB_SPIN_CAP) { atomicAdd(&(bar)[XB_TMO], 1u); break; } } } } while (0)
struct XcdBarrier { unsigned* bar; unsigned x; volatile LAS unsigned* st; };
DI XcdBarrier xcd_barrier_post(unsigned* bar, volatile LAS unsigned* st) {
    XcdBarrier b; b.bar = bar; b.x = xb_xcc_id(); b.st = st;
    if (threadIdx.x == 0) (void)xb_add(&bar[XB_XCNT(b.x)], 1u);
    return b;
}
DI void xcd_barrier_complete(unsigned* bar, unsigned x, unsigned& nloc, unsigned& nx) {
    const unsigned G = gridDim.x * gridDim.y * gridDim.z;
    unsigned sum, cnt, mine, sp = 0u;
    for (;;) {
        sum = 0u; cnt = 0u; mine = 0u;
#pragma unroll
        for (unsigned j = 0; j < 16; ++j) { const unsigned c = xb_ld(&bar[XB_XCNT(j)]); sum += c; cnt += (c > 0u) ? 1u : 0u; mine = (j == x) ? c : mine; }
        if (sum == G) break;
        __builtin_amdgcn_s_sleep(1);
        if ((++sp & 255u) == 0u) { if (xb_ld(&bar[XB_TMO])) break; if (sp > XB_SPIN_CAP) { atomicAdd(&bar[XB_TMO], 1u); break; } }
    }
    nloc = mine > 0u ? mine : 1u; nx = cnt > 0u ? cnt : 1u;
}
DI void xcd_barrier(const XcdBarrier& b) {
    asm volatile("s_waitcnt vmcnt(0)" ::: "memory");
    __syncthreads();
    if (threadIdx.x == 0) {
        unsigned* bar = b.bar;
        __builtin_amdgcn_s_waitcnt(0);
        unsigned nloc = b.st[0], nx = b.st[1];
        if (nloc == 0u) { xcd_barrier_complete(bar, b.x, nloc, nx); b.st[0] = nloc; b.st[1] = nx; }
        const unsigned old = xb_add(&bar[XB_XSUB(b.x)], 1u);
        const unsigned gen = old / nloc;
        if (old + 1u == (gen + 1u) * nloc) {
            __builtin_amdgcn_fence(__ATOMIC_RELEASE, "agent");
            asm volatile("s_waitcnt vmcnt(0)" ::: "memory");
            const unsigned og = xb_add(&bar[XB_TOP], 1u);
            const unsigned tg = og / nx;
            if (og + 1u == (tg + 1u) * nx) xb_add(&bar[XB_TOPGEN], 1u);
            else XB_SPIN(xb_ld(&bar[XB_TOPGEN]) == tg, bar);
            __builtin_amdgcn_fence(__ATOMIC_ACQUIRE, "agent");
            xb_add(&bar[XB_XGEN(b.x)], 1u);
            asm volatile("s_waitcnt vmcnt(0)" ::: "memory");
        } else {
            XB_SPIN(xb_ld(&bar[XB_XGEN(b.x)]) == gen, bar);
            __builtin_amdgcn_fence(__ATOMIC_ACQUIRE, "agent");
            asm volatile("s_waitcnt vmcnt(0)" ::: "memory");
        }
    }
    __syncthreads();
}

constexpr int EXTRA_SEAMS = 0;
constexpr bool DUP_BARRIER = false;
constexpr bool FUSE_RMS_TAIL = false;
constexpr int SUBDUP = 0;
constexpr unsigned DUP_MASK = 0u;
__global__ void __launch_bounds__(512, 2) mega(P p, int ph_lo, int ph_hi, unsigned ph_mask) {
    extern __shared__ __attribute__((aligned(16))) unsigned char lds_raw[];
    LAS unsigned char* lds = (LAS unsigned char*)lds_raw;
    cg::grid_group grid = cg::this_grid();
    const int G = gridDim.x, c = blockIdx.x;
    unsigned char* ws = p.ws;
    volatile LAS unsigned* xbst = (volatile LAS unsigned*)(lds + LDS_BYTES - 16);
    if (threadIdx.x < 4) xbst[threadIdx.x] = 0u;
    __syncthreads();
    const XcdBarrier xbar = xcd_barrier_post((unsigned*)(ws + W_BAR), xbst);
    if (ph_lo > 1000) grid.sync();
#pragma unroll 1
    for (int ph2 = ph_lo * 2; ph2 < ph_hi * 2; ++ph2) {
        const int ph = ph2 >> 1;
        if (ph == 9 || ph == 10 || ph == 21 || ph == 22) continue;
        if (FUSE_RMS_TAIL && (ph == 6 || ph == 12 || ph == 18 || ph == 24)) continue;
        if ((ph2 & 1) && !((DUP_MASK >> ph) & 1u)) continue;
        if (ph2 & 1) __syncthreads();
        int tid = threadIdx.x; asm volatile("" : "+v"(tid));
        int kind = ph, layer = 0, sub = 0;
        if (ph >= 6 && ph <= 11) { kind = 100; layer = 0; sub = ph - 6; }
        if (ph >= 18 && ph <= 23) { kind = 100; layer = 1; sub = ph - 18; }
        if (kind == 100) kind = (sub == 0) ? 100 : (sub == 5) ? 103 : (sub & 1) ? 101 : 102;
        const int half = (sub - 1) >> 1;
        bool gdirect = false; const float* tail_g = nullptr; bf16_t* tail_dst = nullptr; bool tail = false;
        bool is_gemm = false; const bf16_t* gA = nullptr; const bf16_t* gB = nullptr; int lda = 0, ldb = 0, gM = 0, gN = 0, gK = 0, gG = G, gc = c;
        Epi E{};
        if (!((ph_mask >> ph) & 1u)) kind = -1;
        switch (kind) {
        case 0: prologue_phase(tid, lds, p, G, c); break;
        case 1: {
            is_gemm = true; E.kind = EK_ABIN; E.d0 = (bf16_t*)(ws + A_US5); E.d1 = (bf16_t*)(ws + A_QKV); E.d2 = (bf16_t*)(ws + A_Z); E.f0 = (float*)(ws + A_BLAL);
            gA = (const bf16_t*)(ws + A_HN); lda = 1024; gB = (const bf16_t*)(ws + W_AB_IN); ldb = 1024; gM = MTOK; gN = AB_IN_P; gK = 1024; } break;
        case 2: for (int rp = 0; rp < ((SUBDUP & 1) ? 2 : 1); ++rp) { s5_pass<false>(tid, lds, p, G, c); __syncthreads(); }
                for (int rp = 0; rp < ((SUBDUP & 2) ? 2 : 1); ++rp) { gdn_prep_phase(tid, lds, p, G, c); __syncthreads(); } break;
        case 3: if (c == G - 1) { const int t = tid; const int kv = t >> 8, n = t & 255; float a = p.in[kv ? 25 : 22][n];
                    for (int s = 0; s < 32; ++s) a += ((const float*)(ws + W_B1PART))[(kv * 32 + s) * 256 + n];
                    ((float*)(ws + W_B1P))[kv * 256 + n] = a; }
                if (G > 192) { if (c >= 192) weight_prep(tid, lds, p, G - 192, c - 192, true); } else weight_prep(tid, lds, p, G, c, true);
                __syncthreads();
                for (int rp = 0; rp < ((SUBDUP & 4) ? 2 : 1); ++rp) { gdn_seq_phase(tid, lds, p, G, c); __syncthreads(); }
                for (int rp = 0; rp < ((SUBDUP & 8) ? 2 : 1); ++rp) { s5_pass<true>(tid, lds, p, G, (c + G - 192 % G) % G); __syncthreads(); } break;
        case 4: is_gemm = true; E.kind = EK_GLU; E.cb0 = (const bf16_t*)(ws + A_ZS5); E.cf0 = p.in[12]; E.d0 = (bf16_t*)(ws + A_YCAT);
            gA = (const bf16_t*)(ws + A_ZS5); lda = 256; gB = (const bf16_t*)(ws + W_GLU); ldb = 256; gM = MTOK; gN = 256; gK = 256; break;
        case 5: is_gemm = true; E.kind = EK_RESID; E.cf0 = p.in[0]; E.f0 = p.out; gdirect = FUSE_RMS_TAIL; tail = FUSE_RMS_TAIL; tail_g = p.in[32]; tail_dst = (bf16_t*)(ws + F_HN);
            gA = (const bf16_t*)(ws + A_YCAT); lda = 1024; gB = (const bf16_t*)(ws + W_AB_OUT); ldb = 1024; gM = MTOK; gN = 1024; gK = 1024; break;
        case 12: rms_phase(tid, p.out, p.in[31] + 1024, (bf16_t*)(ws + N_HN), G, c); break;
        case 13: is_gemm = true; E.kind = EK_NSAIN; E.d0 = (bf16_t*)(ws + N_Q); E.d1 = (bf16_t*)(ws + N_KC); E.f0 = (float*)(ws + N_GATES);
            gA = (const bf16_t*)(ws + N_HN); lda = 1024; gB = (const bf16_t*)(ws + W_NSA_IN); ldb = 1024; gM = MTOK; gN = NSA_IN_P; gK = 1024; break;
        case 14: { const int kv = (c >= G / 2); is_gemm = true; E.kind = EK_CMP1; E.d0 = (bf16_t*)(ws + (kv ? N_H1V : N_H1K)); E.cf0 = (const float*)(ws + W_B1P) + kv * 256;
            gA = (const bf16_t*)(ws + (kv ? N_VC : N_KC)); lda = 1024; gB = (const bf16_t*)(ws + (kv ? W_VW1 : W_KW1)); ldb = 2048; gM = 16384; gN = 256; gK = 2048; gG = G / 2; gc = kv ? c - G / 2 : c; } break;
        case 15: { const int kv = (c >= G / 2); is_gemm = true; E.kind = EK_CMP2; E.flag = kv; E.d0 = (bf16_t*)(ws + (kv ? N_VCMPT : N_KCMP));
            gA = (const bf16_t*)(ws + (kv ? N_H1V : N_H1K)); lda = 256; gB = (const bf16_t*)(ws + (kv ? W_VW2 : W_KW2)); ldb = 256; gM = 16384; gN = 256; gK = 256; gG = G / 2; gc = kv ? c - G / 2 : c; } break;
        case 16: nsa_attn_phase(tid, lds, p, G, c); break;
        case 17: is_gemm = true; E.kind = EK_RESID; E.cf0 = p.out; E.f0 = p.out; gdirect = FUSE_RMS_TAIL; tail = FUSE_RMS_TAIL; tail_g = p.in[32] + 1024; tail_dst = (bf16_t*)(ws + F_HN);
            gA = (const bf16_t*)(ws + N_AO); lda = 1024; gB = (const bf16_t*)(ws + W_NSA_OUT); ldb = 1024; gM = MTOK; gN = 1024; gK = 1024; break;
        case 100: rms_phase(tid, p.out, p.in[32] + layer * 1024, (bf16_t*)(ws + F_HN), G, c); break;
        case 101: is_gemm = true; E.kind = EK_FFNUP; E.d0 = (bf16_t*)(ws + F_ACT); E.f0 = (float*)(ws + F_HB); E.cf0 = p.in[28] + (size_t)layer * 3 * FF2; E.cf1 = p.in[29] + (size_t)layer * FF2;
            gA = (const bf16_t*)(ws + F_HN); lda = 1024; gB = (const bf16_t*)(ws + W_FFN_IN) + (size_t)layer * FF2 * 1024; ldb = 1024; gM = MTOK; gN = FF2; gK = 1024; break;
        case 102: ffn_fix_phase(tid, p, layer, G, c); break;
        case 103: is_gemm = true; E.kind = EK_RESID; E.cf0 = p.out; E.f0 = p.out; gdirect = FUSE_RMS_TAIL; tail = FUSE_RMS_TAIL; if (layer == 0) { tail_g = p.in[31] + 1024; tail_dst = (bf16_t*)(ws + N_HN); } else { tail_g = p.in[33]; tail_dst = nullptr; }
            gA = (const bf16_t*)(ws + F_ACT); lda = FFH; gB = (const bf16_t*)(ws + W_FFN_OUT) + (size_t)layer * 1024 * FFH; ldb = FFH; gM = MTOK; gN = 1024; gK = FFH; break;
        case 24: rms_final(tid, p.out, p.in[33], G, c); break;
        default: break;
        }
        if (is_gemm) pg8::gemm_phase(tid, lds, gA, lda, gB, ldb, gM, gN, gK, gG, gc, gdirect, E);
        if (tail) {
            asm volatile("s_waitcnt vmcnt(0)" ::: "memory"); __syncthreads();
            __builtin_amdgcn_fence(__ATOMIC_ACQUIRE, "agent"); asm volatile("s_waitcnt vmcnt(0)" ::: "memory");
            rms_owned(tid, p.out, tail_g, tail_dst, G, c);
        }
        if (!(ph2 & 1) && ((DUP_MASK >> ph) & 1u)) { if (DUP_BARRIER) xcd_barrier(xbar); continue; }
        for (int xs = 0; xs < ((ph == 0) ? EXTRA_SEAMS : 0); ++xs) xcd_barrier(xbar);
        if (ph + 1 < ph_hi) xcd_barrier(xbar);
    }
}
constexpr int N_PHASES = 25;

extern "C" void kernel_launch(void* const* d_in, const int* in_sizes, int n_in, void* d_out, int out_size, void* d_ws, size_t ws_size, hipStream_t stream) {
    static int grid = 0;
    if (grid == 0) {
        int dev = 0, cus = 0, per_cu = 0;
        hipGetDevice(&dev); hipDeviceGetAttribute(&cus, hipDeviceAttributeMultiprocessorCount, dev);
        if (hipFuncSetAttribute((const void*)mega, hipFuncAttributeMaxDynamicSharedMemorySize, LDS_BYTES) != hipSuccess) fprintf(stderr, "hipFuncSetAttribute failed\n");
        if (hipOccupancyMaxActiveBlocksPerMultiprocessor(&per_cu, (const void*)mega, 512, LDS_BYTES) != hipSuccess || per_cu < 1) { fprintf(stderr, "occupancy query: %d\n", per_cu); per_cu = 1; }
        (void)hipGetLastError();
        grid = cus;
        if (ws_size < 1024 * MiB) fprintf(stderr, "workspace too small: %zu\n", ws_size);
    }
    P p{};
    for (int i = 0; i < 34; ++i) p.in[i] = (const float*)d_in[i];
    p.out = (float*)d_out; p.ws = (unsigned char*)d_ws;
    int lo = 0, hi = N_PHASES; unsigned mask = 0xFFFFFFFFu;
    void* args[] = {&p, &lo, &hi, &mask};
    if (hipMemsetAsync((unsigned char*)d_ws + W_BAR, 0, XCD_BAR_WORDS * 4, stream) != hipSuccess) fprintf(stderr, "memset of barrier words failed\n");
    hipError_t e = hipLaunchCooperativeKernel((const void*)mega, dim3(grid), dim3(512), args, LDS_BYTES, stream);
    if (e != hipSuccess) fprintf(stderr, "cooperative launch failed: %s (grid %d)\n", hipGetErrorString(e), grid);
}
```

```cpp
#include <hip/hip_runtime.h>
#include <hip/hip_cooperative_groups.h>
#include <cstdio>
namespace cg = cooperative_groups;

#define LAS __attribute__((address_space(3)))
#define DI __device__ __forceinline__
typedef unsigned short bf16_t;
typedef short bf16x8 __attribute__((ext_vector_type(8)));
typedef short bf16x4 __attribute__((ext_vector_type(4)));
typedef float f32x4 __attribute__((ext_vector_type(4)));
typedef float f32x2 __attribute__((ext_vector_type(2)));
typedef unsigned u32x4 __attribute__((ext_vector_type(4)));
typedef unsigned u32x2 __attribute__((ext_vector_type(2)));

constexpr int MTOK = 65536, DM = 1024, SEQ = 2048, NB = 32;
constexpr int AB_IN = 3340, AB_IN_P = 3584, NSA_IN = 2608, NSA_IN_P = 2816, FF2 = 5632, FFH = 2816;
constexpr int LDS_BYTES = 147456;

constexpr size_t MiB = 1048576;
constexpr size_t W_AB_IN = 0;
constexpr size_t W_AB_OUT = W_AB_IN + (size_t)AB_IN_P * 1024 * 2;
constexpr size_t W_GLU = W_AB_OUT + 2 * MiB;
constexpr size_t W_NSA_IN = W_GLU + 131072;
constexpr size_t W_NSA_OUT = W_NSA_IN + (size_t)NSA_IN_P * 1024 * 2;
constexpr size_t W_KW1 = W_NSA_OUT + 2 * MiB;
constexpr size_t W_VW1 = W_KW1 + MiB;
constexpr size_t W_KW2 = W_VW1 + MiB;
constexpr size_t W_VW2 = W_KW2 + 131072;
constexpr size_t W_FFN_IN = W_VW2 + 131072;
constexpr size_t W_FFN_OUT = W_FFN_IN + 2 * (size_t)FF2 * 1024 * 2;
constexpr size_t W_S5AB = W_FFN_OUT + 2 * (size_t)1024 * FFH * 2;
constexpr size_t W_S5BB = W_S5AB + 8192;
constexpr size_t W_S5CC = W_S5BB + 131072;
constexpr size_t W_B1P = W_S5CC + 65536;
constexpr size_t W_B1PART = W_B1P + 2048;
constexpr size_t W_CTR = W_B1PART + 65536;
constexpr size_t W_BAR = W_CTR + 4096;
constexpr size_t W_END = W_BAR + 16384;
static_assert(W_END <= 64 * MiB, "weights region");
constexpr size_t ACT = 64 * MiB;
constexpr size_t A_QKV = ACT;
constexpr size_t A_YCAT = ACT;
constexpr size_t A_Z = A_QKV + 288 * MiB;
constexpr size_t A_US5 = A_Z + 96 * MiB;
constexpr size_t A_ZS5 = A_US5 + 32 * MiB;
constexpr size_t A_BLAL = A_ZS5 + 32 * MiB;
constexpr size_t A_S5END = A_BLAL + 4 * MiB;
constexpr size_t A_CHUNK = A_S5END + 2 * MiB;
constexpr size_t A_HN = A_CHUNK;
constexpr size_t CH_U = A_CHUNK, CH_W = CH_U + 96 * MiB, CH_QD = CH_W + 96 * MiB, CH_KDT = CH_QD + 96 * MiB, CH_INTRA = CH_KDT + 96 * MiB, CH_GL = CH_INTRA + 48 * MiB;
static_assert(CH_GL + MiB <= 1024 * MiB, "ws");
constexpr size_t F_HN = ACT;
constexpr size_t F_UP = F_HN + 128 * MiB;
constexpr size_t F_HB = F_UP;
constexpr size_t F_ACT = F_UP + 352 * MiB;
static_assert(F_ACT + 352 * MiB <= 1024 * MiB, "ws");
constexpr size_t N_HN = ACT;
constexpr size_t N_Q = N_HN + 128 * MiB;
constexpr size_t N_KC = N_Q + 128 * MiB;
constexpr size_t N_VC = N_KC + 32 * MiB;
constexpr size_t N_KS = N_VC + 32 * MiB;
constexpr size_t N_VST = N_KS + 32 * MiB;
constexpr size_t N_KW = N_VST + 32 * MiB;
constexpr size_t N_VWT = N_KW + 32 * MiB;
constexpr size_t N_GATES = N_VWT + 32 * MiB;
constexpr size_t N_H1K = N_GATES + 12 * MiB;
constexpr size_t N_H1V = N_H1K + 8 * MiB;
constexpr size_t N_KCMP = N_H1V + 8 * MiB;
constexpr size_t N_VCMPT = N_KCMP + 2 * MiB;
constexpr size_t N_AO = N_VCMPT + 2 * MiB;

struct P { const float* in[34]; float* out; unsigned char* ws; };

DI float bf2f(bf16_t b) { return __uint_as_float(((unsigned)b) << 16); }
DI bf16_t f2bf(float f) { return __builtin_bit_cast(bf16_t, (__bf16)f); }
typedef __bf16 bf16v2_t __attribute__((ext_vector_type(2)));
DI unsigned pk2(float lo, float hi) { bf16v2_t v; v.x = (__bf16)lo; v.y = (__bf16)hi; return __builtin_bit_cast(unsigned, v); }
DI float lo16(unsigned u) { return __uint_as_float(u << 16); }
DI float hi16(unsigned u) { return __uint_as_float(u & 0xffff0000u); }
DI float sigmoidf_(float x) { return 1.f / (1.f + __expf(-x)); }
DI float siluf_(float x) { return x / (1.f + __expf(-x)); }
DI float silu_fast(float x) { return x * __builtin_amdgcn_rcpf(1.f + __expf(-x)); }
DI float gelu_tanh(float x) { float u = 0.7978845608028654f * (x + 0.044715f * x * x * x); float e = __expf(2.f * u); float th = 1.f - 2.f / (e + 1.f); return 0.5f * x * (1.f + th); }
DI float wave_sum(float v) { for (int o = 32; o > 0; o >>= 1) v += __shfl_xor(v, o); return v; }
DI f32x4 mfma16(bf16x8 a, bf16x8 b, f32x4 c) { return __builtin_amdgcn_mfma_f32_16x16x32_bf16(a, b, c, 0, 0, 0); }
DI void lds_wait() { asm volatile("s_waitcnt lgkmcnt(0)" ::: "memory"); }

DI void st8bf(bf16_t* dst, f32x4 v0, f32x4 v1);
namespace pg8 {
constexpr int BM = 256, BK = 64, HALF = 128, HTB = HALF * BK * 2, STAGE_BYTES = 8 * HTB, NXCD = 8, WGM = 8;
DI int lds_byte(int r, int c) { const int st = (r >> 4) * 2 + (c >> 5), rr = r & 15, cc = c & 31, ob = rr * 64 + cc * 2; return st * 1024 + (ob ^ (((ob >> 9) & 1) << 5)); }
DI void stage_rc(int b, int& R, int& C) { const int st = b / 1024, sb = b % 1024, swz = sb ^ (((sb >> 9) & 1) << 5); R = (st >> 1) * 16 + swz / 64; C = (st & 1) * 32 + (swz % 64) / 2; }
DI int perm32(int rho) { const int n = rho >> 4, i = rho & 15; return 8 * (i >> 2) + 4 * n + (i & 3); }
struct Unit { int pm, pn; };
struct Order {
    int nM, nN, nwg, G, c; bool direct;
    DI void init(int M, int N, int G_, int c_, bool d_) { nM = M / BM; nN = N / BM; nwg = nM * nN; G = G_; c = c_; direct = d_; }
    DI bool next(int i, Unit& u) const {
        if (direct) { const int pm = c + (i / nN) * G; if (pm >= nM) return false; u.pm = pm; u.pn = i % nN; return true; }
        const long L = (long)i * G + c; if (L >= nwg) return false;
        int wgid = (int)L; { const int q = nwg / NXCD, r = nwg % NXCD, xcd = wgid % NXCD, off = wgid / NXCD; wgid = (xcd < r ? xcd * (q + 1) : r * (q + 1) + (xcd - r) * q) + off; }
        const int nig = WGM * nN, gid = wgid / nig, fm = gid * WGM, gsz = (nM - fm) < WGM ? (nM - fm) : WGM;
        u.pm = fm + ((wgid % nig) % gsz); u.pn = (wgid % nig) / gsz; return true;
    }
};
template <class F>
DI void gemm_phase(const int tid, LAS unsigned char* lds, const bf16_t* Ap, int lda, const bf16_t* Bp, int ldb, int M, int N, int K, int G, int c, bool direct, const F& E) {
    const int wid = __builtin_amdgcn_readfirstlane(tid >> 6), lane = tid & 63, wr = wid >> 2, wc = wid & 3, fr = lane & 15, fq = lane >> 4;
    const int nt = K / BK;
    Order S; S.init(M, N, G, c, direct);
    unsigned voffA[2], voffB[2];
#pragma unroll
    for (int i = 0; i < 2; ++i) { int R, C; stage_rc(tid * 16 + i * 8192, R, C); const int Rb = (R & ~31) + perm32(R & 31);
        voffA[i] = (unsigned)(R * lda + C) * 2u; voffB[i] = (unsigned)(Rb * ldb + C) * 2u; }
    const size_t kstep = (size_t)(BK * 2);
    const size_t hsA = (size_t)HALF * lda * 2, hsB = (size_t)HALF * ldb * 2;
    const size_t tsA = 2 * hsA, tsB = 2 * hsB;
    const unsigned ldsw = (unsigned)wid * 1024u;
    const int aoff = lds_byte(wr * 64 + fr, fq * 8), boff = lds_byte(wc * 32 + fr, fq * 8);
#define PG8_SA(b, h) (((b) * 2 + (h)) * HTB)
#define PG8_SB(b, h) ((4 + (b) * 2 + (h)) * HTB)
#define PG8_STAGE(bufoff, gbase, voff) do { _Pragma("unroll") for (int _i = 0; _i < 2; ++_i) \
        __builtin_amdgcn_global_load_lds((const unsigned*)((const char*)(gbase) + (voff)[_i]), (LAS unsigned*)(lds + (bufoff) + ldsw + _i * 8192), 16, 0, 0); } while (0)
#define PG8_LDA(dst, b, h) do { _Pragma("unroll") for (int m = 0; m < 4; ++m) _Pragma("unroll") for (int k = 0; k < 2; ++k) dst[m][k] = *(const LAS bf16x8*)(lds + PG8_SA(b, h) + aoff + m * 2048 + k * 1024); } while (0)
#define PG8_LDB(dst, b, h) do { _Pragma("unroll") for (int n = 0; n < 2; ++n) _Pragma("unroll") for (int k = 0; k < 2; ++k) dst[n][k] = *(const LAS bf16x8*)(lds + PG8_SB(b, h) + boff + n * 2048 + k * 1024); } while (0)
#define PG8_MMA(ai, bj, At, Bt) do { __builtin_amdgcn_s_setprio(1); _Pragma("unroll") for (int m = 0; m < 4; ++m) _Pragma("unroll") for (int n = 0; n < 2; ++n) _Pragma("unroll") for (int k = 0; k < 2; ++k) \
        acc[ai][bj][m][n] = __builtin_amdgcn_mfma_f32_16x16x32_bf16(Bt[n][k], At[m][k], acc[ai][bj][m][n], 0, 0, 0); __builtin_amdgcn_s_setprio(0); } while (0)
#define PG8_WAIT_V(n) asm volatile("s_waitcnt vmcnt(" #n ")" ::: "memory")
#define PG8_WAIT_L(n) asm volatile("s_waitcnt lgkmcnt(" #n ")" ::: "memory")
#define PG8_BAR __builtin_amdgcn_s_barrier()
#define PG8_SCHED __builtin_amdgcn_sched_barrier(0)
    Unit cur, nxt; int ui = 0;
    if (!S.next(0, cur)) return;
    f32x4 acc[2][2][4][2];
#pragma unroll
    for (int a = 0; a < 2; ++a)
#pragma unroll
        for (int b = 0; b < 2; ++b)
#pragma unroll
            for (int m = 0; m < 4; ++m)
#pragma unroll
                for (int n = 0; n < 2; ++n) acc[a][b][m][n] = (f32x4){0.f, 0.f, 0.f, 0.f};
    bf16x8 At[4][2], B0[2][2], B1[2][2];
    const char* cA = (const char*)Ap + (size_t)cur.pm * tsA; const char* cB = (const char*)Bp + (size_t)cur.pn * tsB;
    PG8_STAGE(PG8_SB(0, 0), cB, voffB); PG8_STAGE(PG8_SA(0, 0), cA, voffA); PG8_STAGE(PG8_SB(0, 1), cB + hsB, voffB); PG8_STAGE(PG8_SA(0, 1), cA + hsA, voffA);
    if (wr == 1) PG8_BAR;
    PG8_WAIT_V(4); PG8_BAR;
    PG8_STAGE(PG8_SB(1, 0), cB + kstep, voffB); PG8_STAGE(PG8_SA(1, 0), cA + kstep, voffA); PG8_STAGE(PG8_SB(1, 1), cB + hsB + kstep, voffB);
    PG8_WAIT_V(6); PG8_BAR;
    for (;;) {
        const bool has_next = S.next(ui + 1, nxt);
        const char* nA = has_next ? (const char*)Ap + (size_t)nxt.pm * tsA : cA; const char* nB = has_next ? (const char*)Bp + (size_t)nxt.pn * tsB : cB;
        for (int t = 0; t < nt; t += 2) {
            const bool last = (t == nt - 2);
            const char* a1 = cA + (size_t)(t + 1) * kstep;
            const char* a2 = last ? nA : cA + (size_t)(t + 2) * kstep; const char* b2 = last ? nB : cB + (size_t)(t + 2) * kstep;
            const char* a3 = a2 + kstep; const char* b3 = b2 + kstep;
            PG8_LDB(B0, 0, 0); PG8_SCHED; PG8_LDA(At, 0, 0); PG8_STAGE(PG8_SA(1, 1), a1 + hsA, voffA);
            PG8_WAIT_L(8); PG8_BAR; PG8_WAIT_L(0); PG8_MMA(0, 0, At, B0); PG8_BAR; PG8_SCHED;
            PG8_LDB(B1, 0, 1); PG8_STAGE(PG8_SB(0, 0), b2, voffB);
            PG8_BAR; PG8_WAIT_L(0); PG8_MMA(0, 1, At, B1); PG8_BAR;
            PG8_LDA(At, 0, 1); PG8_STAGE(PG8_SA(0, 0), a2, voffA);
            PG8_BAR; PG8_WAIT_L(0); PG8_MMA(1, 0, At, B0); PG8_BAR; PG8_SCHED;
            PG8_STAGE(PG8_SB(0, 1), b2 + hsB, voffB);
            PG8_WAIT_V(6); PG8_BAR; PG8_MMA(1, 1, At, B1); PG8_BAR;
            PG8_LDB(B0, 1, 0); PG8_SCHED; PG8_LDA(At, 1, 0); PG8_STAGE(PG8_SA(0, 1), a2 + hsA, voffA);
            PG8_WAIT_L(8); PG8_BAR; PG8_WAIT_L(0); PG8_MMA(0, 0, At, B0); PG8_BAR; PG8_SCHED;
            PG8_LDB(B1, 1, 1); PG8_STAGE(PG8_SB(1, 0), b3, voffB);
            PG8_BAR; PG8_WAIT_L(0); PG8_MMA(0, 1, At, B1); PG8_BAR;
            PG8_LDA(At, 1, 1); PG8_STAGE(PG8_SA(1, 0), a3, voffA);
            PG8_BAR; PG8_WAIT_L(0); PG8_MMA(1, 0, At, B0); PG8_BAR; PG8_SCHED;
            PG8_STAGE(PG8_SB(1, 1), b3 + hsB, voffB);
            PG8_WAIT_V(6); PG8_BAR; PG8_MMA(1, 1, At, B1); PG8_BAR;
        }
        if (E.kind == 7  ) E.fused(acc, cur.pm, cur.pn, wr, wc, fr, fq);
        else if (E.kind == 3  ) {
            const int row0 = cur.pm * BM + wr * 64 + fr, col0 = cur.pn * BM + wc * 32 + 8 * fq;
            f32x4 b0[2], b1[2];
#pragma unroll
            for (int bj = 0; bj < 2; ++bj) { b0[bj] = *(const f32x4*)(E.cf0 + col0 + bj * HALF); b1[bj] = *(const f32x4*)(E.cf0 + col0 + bj * HALF + 4); }
#pragma unroll
            for (int ai = 0; ai < 2; ++ai) {
                u32x4 zz[4][2];
#pragma unroll
                for (int m = 0; m < 4; ++m)
#pragma unroll
                    for (int bj = 0; bj < 2; ++bj) zz[m][bj] = *(const u32x4*)(E.cb0 + (size_t)(row0 + ai * HALF + m * 16) * 256 + col0 + bj * HALF);
#pragma unroll
                for (int m = 0; m < 4; ++m)
#pragma unroll
                    for (int bj = 0; bj < 2; ++bj) { const f32x4 v0 = acc[ai][bj][m][0], v1 = acc[ai][bj][m][1]; const u32x4 z = zz[m][bj]; f32x4 o0, o1;
                        o0[0] = lo16(z.x) * sigmoidf_(v0[0] + b0[bj][0]); o0[1] = hi16(z.x) * sigmoidf_(v0[1] + b0[bj][1]); o0[2] = lo16(z.y) * sigmoidf_(v0[2] + b0[bj][2]); o0[3] = hi16(z.y) * sigmoidf_(v0[3] + b0[bj][3]);
                        o1[0] = lo16(z.z) * sigmoidf_(v1[0] + b1[bj][0]); o1[1] = hi16(z.z) * sigmoidf_(v1[1] + b1[bj][1]); o1[2] = lo16(z.w) * sigmoidf_(v1[2] + b1[bj][2]); o1[3] = hi16(z.w) * sigmoidf_(v1[3] + b1[bj][3]);
                        st8bf(E.d0 + (size_t)(row0 + ai * HALF + m * 16) * 1024 + col0 + bj * HALF, o0, o1); }
            }
        }
        else if (E.kind == 1  ) {
            const int row0 = cur.pm * BM + wr * 64 + fr, col0 = cur.pn * BM + wc * 32 + 8 * fq;
#pragma unroll
            for (int ai = 0; ai < 2; ++ai) {
                f32x4 r[4][2][2];
#pragma unroll
                for (int m = 0; m < 4; ++m)
#pragma unroll
                    for (int bj = 0; bj < 2; ++bj) { const size_t o = (size_t)(row0 + ai * HALF + m * 16) * 1024 + col0 + bj * HALF;
                        r[m][bj][0] = *(const f32x4*)(E.cf0 + o); r[m][bj][1] = *(const f32x4*)(E.cf0 + o + 4); }
#pragma unroll
                for (int m = 0; m < 4; ++m)
#pragma unroll
                    for (int bj = 0; bj < 2; ++bj) { const size_t o = (size_t)(row0 + ai * HALF + m * 16) * 1024 + col0 + bj * HALF;
                        *(f32x4*)(E.f0 + o) = r[m][bj][0] + acc[ai][bj][m][0]; *(f32x4*)(E.f0 + o + 4) = r[m][bj][1] + acc[ai][bj][m][1]; }
            }
        }
        else {
            const int row0 = cur.pm * BM + wr * 64 + fr, col0 = cur.pn * BM + wc * 32 + 8 * fq;
#pragma unroll
            for (int ai = 0; ai < 2; ++ai)
#pragma unroll
                for (int m = 0; m < 4; ++m)
#pragma unroll
                    for (int bj = 0; bj < 2; ++bj) E.st(row0 + ai * HALF + m * 16, col0 + bj * HALF, acc[ai][bj][m][0], acc[ai][bj][m][1]);
        }
        if (!has_next) break;
#pragma unroll
        for (int a = 0; a < 2; ++a)
#pragma unroll
            for (int b = 0; b < 2; ++b)
#pragma unroll
                for (int m = 0; m < 4; ++m)
#pragma unroll
                    for (int n = 0; n < 2; ++n) acc[a][b][m][n] = (f32x4){0.f, 0.f, 0.f, 0.f};
        cur = nxt; cA = nA; cB = nB; ++ui;
    }
    PG8_WAIT_V(0);
    if (wr == 0) PG8_BAR;
    PG8_BAR;
#undef PG8_SA
#undef PG8_SB
#undef PG8_STAGE
#undef PG8_LDA
#undef PG8_LDB
#undef PG8_MMA
#undef PG8_WAIT_V
#undef PG8_WAIT_L
#undef PG8_BAR
#undef PG8_SCHED
}
}

DI void st8bf(bf16_t* dst, f32x4 v0, f32x4 v1) { u32x4 w; w.x = pk2(v0[0], v0[1]); w.y = pk2(v0[2], v0[3]); w.z = pk2(v1[0], v1[1]); w.w = pk2(v1[2], v1[3]); *(u32x4*)dst = w; }

enum { EK_ABIN = 0, EK_RESID, EK_BF, EK_GLU, EK_NSAIN, EK_CMP1, EK_CMP2, EK_FFNUP };
struct Epi { int kind, ldc, flag, pad; bf16_t *d0, *d1, *d2; float* f0; const float* cf0; const float* cf1; const bf16_t* cb0;
    DI void st(int row, int col, f32x4 v0, f32x4 v1) const {
        switch (kind) {
        case EK_ABIN: {
            if (col < 256) st8bf(d0 + (size_t)row * 256 + col, v0, v1);
            else if (col < 2560) st8bf(d1 + (size_t)row * 2304 + (col - 256), v0, v1);
            else if (col < 3328) st8bf(d2 + (size_t)row * 768 + (col - 2560), v0, v1);
            else { const int cc = col - 3328; if (cc < 16) { float* d = f0 + (size_t)row * 16 + cc; *(f32x4*)d = v0; *(f32x4*)(d + 4) = v1; } } } break;
        case EK_RESID: {
            const size_t o = (size_t)row * 1024 + col; const f32x4 r0 = *(const f32x4*)(cf0 + o), r1 = *(const f32x4*)(cf0 + o + 4);
            *(f32x4*)(f0 + o) = r0 + v0; *(f32x4*)(f0 + o + 4) = r1 + v1; } break;
        case EK_BF: st8bf(d0 + (size_t)row * ldc + col, v0, v1); break;
        case EK_GLU: {
            const u32x4 zz = *(const u32x4*)(cb0 + (size_t)row * 256 + col); const f32x4 b0 = *(const f32x4*)(cf0 + col), b1 = *(const f32x4*)(cf0 + col + 4);
            f32x4 o0, o1;
            o0[0] = lo16(zz.x) * sigmoidf_(v0[0] + b0[0]); o0[1] = hi16(zz.x) * sigmoidf_(v0[1] + b0[1]); o0[2] = lo16(zz.y) * sigmoidf_(v0[2] + b0[2]); o0[3] = hi16(zz.y) * sigmoidf_(v0[3] + b0[3]);
            o1[0] = lo16(zz.z) * sigmoidf_(v1[0] + b1[0]); o1[1] = hi16(zz.z) * sigmoidf_(v1[1] + b1[1]); o1[2] = lo16(zz.w) * sigmoidf_(v1[2] + b1[2]); o1[3] = hi16(zz.w) * sigmoidf_(v1[3] + b1[3]);
            st8bf(d0 + (size_t)row * 1024 + col, o0, o1); } break;
        case EK_NSAIN: {
            if (col < 1024) { st8bf(d0 + (size_t)row * 1024 + col, v0 * 0.18033688011112042f, v1 * 0.18033688011112042f);   }
            else if (col < 2560) {
                const int cc0 = col - 1024, ts = cc0 >> 8, cc = cc0 & 255, g = cc >> 6, dd = cc & 63, b = row >> 11, t = row & 2047;
                bf16_t* base = d1 + (size_t)ts * (16 * MiB);
                if (ts == 3 || ts == 5) { bf16_t* d = base + ((size_t)(b * 4 + g) * 64 + dd) * 2048 + t;
#pragma unroll
                    for (int e = 0; e < 4; ++e) { d[(size_t)e * 2048] = f2bf(v0[e]); d[(size_t)(e + 4) * 2048] = f2bf(v1[e]); } }
                else st8bf(base + ((size_t)(b * 4 + g) * 2048 + t) * 64 + dd, v0, v1);
            } else { const int cc = col - 2560; if (cc < 48) { float* d = f0 + (size_t)row * 48 + cc;
#pragma unroll
                    for (int e = 0; e < 4; ++e) { d[e] = sigmoidf_(v0[e]); d[e + 4] = sigmoidf_(v1[e]); } } } } break;
        case EK_CMP1: {
            const f32x4 b0 = *(const f32x4*)(cf0 + col), b1 = *(const f32x4*)(cf0 + col + 4); f32x4 o0, o1;
#pragma unroll
            for (int e = 0; e < 4; ++e) { o0[e] = gelu_tanh(v0[e] + b0[e]); o1[e] = gelu_tanh(v1[e] + b1[e]); }
            st8bf(d0 + (size_t)row * 256 + col, o0, o1); } break;
        case EK_CMP2: {
            if (col < 64) {
                if (!flag) st8bf(d0 + (size_t)row * 64 + col, v0, v1);
                else { bf16_t* d = d0 + ((size_t)(row >> 7) * 64 + col) * 128 + (row & 127);
#pragma unroll
                    for (int e = 0; e < 4; ++e) { d[e * 128] = f2bf(v0[e]); d[(e + 4) * 128] = f2bf(v1[e]); } } } } break;
        default: break;
        }
    }
    DI void fused(const f32x4 (&acc)[2][2][4][2], int pm, int pn, int wr, int wc, int fr, int fq) const;
};

template <int CTRL> DI float dppf(float v) { return __builtin_bit_cast(float, __builtin_amdgcn_update_dpp(0, __builtin_bit_cast(int, v), CTRL, 0xf, 0xf, true)); }
DI void Epi::fused(const f32x4 (&acc)[2][2][4][2], int pm, int pn, int wr, int wc, int fr, int fq) const {
    const Epi& E = *this;
#pragma unroll
    for (int bj = 0; bj < 2; ++bj) {
        const int ncol = pn * 256 + bj * 128 + wc * 32 + 8 * fq, j0 = (ncol >> 3) * 4;
        const f32x4 wa0 = *(const f32x4*)(E.cf0 + j0), wa1 = *(const f32x4*)(E.cf0 + FF2 + j0), wa2 = *(const f32x4*)(E.cf0 + 2 * FF2 + j0);
        const f32x4 wb0 = *(const f32x4*)(E.cf0 + FFH + j0), wb1 = *(const f32x4*)(E.cf0 + FF2 + FFH + j0), wb2 = *(const f32x4*)(E.cf0 + 2 * FF2 + FFH + j0);
        const f32x4 ba = *(const f32x4*)(E.cf1 + j0), bb = *(const f32x4*)(E.cf1 + FFH + j0);
#pragma unroll
        for (int ai = 0; ai < 2; ++ai) {
            f32x4 pa = (f32x4){0.f, 0.f, 0.f, 0.f}, pb = pa;
#pragma unroll
            for (int m = 0; m < 4; ++m) {
                const f32x4 ca = acc[ai][bj][m][0], cb = acc[ai][bj][m][1];
                const int row = pm * 256 + ai * 128 + wr * 64 + m * 16 + fr;
                float o[4];
#pragma unroll
                for (int e = 0; e < 4; ++e) {
                    const float a1 = dppf<0x111>(ca[e]) + dppf<0x10F>(pa[e]), a2 = dppf<0x112>(ca[e]) + dppf<0x10E>(pa[e]);
                    const float b1 = dppf<0x111>(cb[e]) + dppf<0x10F>(pb[e]), b2 = dppf<0x112>(cb[e]) + dppf<0x10E>(pb[e]);
                    const float ya = fmaf(wa0[e], a2, fmaf(wa1[e], a1, fmaf(wa2[e], ca[e], ba[e])));
                    const float yb = fmaf(wb0[e], b2, fmaf(wb1[e], b1, fmaf(wb2[e], cb[e], bb[e])));
                    o[e] = silu_fast(ya) * yb; }
                if (m > 0 || fr >= 2) { u32x2 w; w.x = pk2(o[0], o[1]); w.y = pk2(o[2], o[3]); *(u32x2*)(E.d0 + (size_t)row * FFH + j0) = w; }
                if ((m == 0 && fr < 2) || (m == 3 && fr >= 14)) { float* hb = E.f0 + ((size_t)(row >> 6) * 4 + (m == 0 ? fr : fr - 12)) * FF2 + ncol; *(f32x4*)hb = ca; *(f32x4*)(hb + 4) = cb; }
                pa = ca; pb = cb;
            }
        }
    }
}
DI void ffn_fix_phase(const int tid, const P& p, int layer, int G, int c) {
    const float* hb = (const float*)(p.ws + F_HB); bf16_t* act = (bf16_t*)(p.ws + F_ACT);
    const float* cw = p.in[28] + (size_t)layer * 3 * FF2; const float* cbv = p.in[29] + (size_t)layer * FF2;
    const int nitems = 1024 * 2 * 704;
    for (int it = c * 512 + tid; it < nitems; it += G * 512) {
        const int q = it % 704, t = (it / 704) & 1, kb = it / 1408, j0 = q * 4, nc = q * 8;
        const bool first = (kb & 31) == 0;
        const float* r0 = hb + ((size_t)kb * 4 + t) * FF2 + nc;
        const float* r1 = (t == 1) ? hb + ((size_t)kb * 4 + 0) * FF2 + nc : hb + ((size_t)(kb - 1) * 4 + 3) * FF2 + nc;
        const float* r2 = (t == 1) ? hb + ((size_t)(kb - 1) * 4 + 3) * FF2 + nc : hb + ((size_t)(kb - 1) * 4 + 2) * FF2 + nc;
        const f32x4 z4 = (f32x4){0.f, 0.f, 0.f, 0.f};
        const f32x4 a0 = *(const f32x4*)r0, b0 = *(const f32x4*)(r0 + 4);
        const bool have1 = (t == 1) || !first, have2 = !first;
        const f32x4 a1 = have1 ? *(const f32x4*)r1 : z4, b1 = have1 ? *(const f32x4*)(r1 + 4) : z4;
        const f32x4 a2 = have2 ? *(const f32x4*)r2 : z4, b2 = have2 ? *(const f32x4*)(r2 + 4) : z4;
        const f32x4 wa0 = *(const f32x4*)(cw + j0), wa1 = *(const f32x4*)(cw + FF2 + j0), wa2 = *(const f32x4*)(cw + 2 * FF2 + j0);
        const f32x4 wb0 = *(const f32x4*)(cw + FFH + j0), wb1 = *(const f32x4*)(cw + FF2 + FFH + j0), wb2 = *(const f32x4*)(cw + 2 * FF2 + FFH + j0);
        const f32x4 ba = *(const f32x4*)(cbv + j0), bb = *(const f32x4*)(cbv + FFH + j0);
        float o[4];
#pragma unroll
        for (int e = 0; e < 4; ++e) { const float ya = fmaf(wa0[e], a2[e], fmaf(wa1[e], a1[e], fmaf(wa2[e], a0[e], ba[e]))), yb = fmaf(wb0[e], b2[e], fmaf(wb1[e], b1[e], fmaf(wb2[e], b0[e], bb[e]))); o[e] = silu_fast(ya) * yb; }
        u32x2 w; w.x = pk2(o[0], o[1]); w.y = pk2(o[2], o[3]);
        *(u32x2*)(act + ((size_t)kb * 64 + t) * FFH + j0) = w;
    }
}

DI void prep_unit(const int tid, LAS unsigned char* lds, const float* src, bf16_t* dst, int K, int N, int u, bool perm) {
    LAS float* tile = (LAS float*)lds;
    const int ntk = K / 64, tk = u % ntk, tn = u / ntk;
    { const int c4 = tid & 63, kb = tid >> 6, n = tn * 256 + c4 * 4, ns = perm ? (((n & 4) ? FFH : 0) + (n >> 3) * 4) : n;
      f32x4 v[8];
#pragma unroll
      for (int kk = 0; kk < 8; ++kk) { const int k = kb + kk * 8; v[kk] = (n < N) ? *(const f32x4*)(src + (size_t)(tk * 64 + k) * N + ns) : (f32x4){0.f, 0.f, 0.f, 0.f}; }
#pragma unroll
      for (int kk = 0; kk < 8; ++kk) *(LAS f32x4*)(tile + (kb + kk * 8) * 260 + c4 * 4) = v[kk]; }
    __syncthreads();
#pragma unroll
    for (int i = 0; i < 4; ++i) { const int pc = tid + i * 512, nl = pc & 255, k8 = pc >> 8;
        float t[8];
#pragma unroll
        for (int e = 0; e < 8; ++e) t[e] = tile[(k8 * 8 + e) * 260 + nl];
        u32x4 w; w.x = pk2(t[0], t[1]); w.y = pk2(t[2], t[3]); w.z = pk2(t[4], t[5]); w.w = pk2(t[6], t[7]);
        *(u32x4*)(dst + (size_t)(tn * 256 + nl) * K + tk * 64 + k8 * 8) = w; }
    __syncthreads();
}

template <bool TO_BF16>
DI void rms_rows(const int tid, const float* src, const float* gam, bf16_t* dst, float* fdst, int G, int c) {
    constexpr int NR = 8;
    const int wave = tid >> 6, lane = tid & 63;
    f32x4 g4[4];
#pragma unroll
    for (int k = 0; k < 4; ++k) g4[k] = *(const f32x4*)(gam + k * 256 + lane * 4);
    for (int r = (c * 8 + wave) * NR; r < MTOK; r += G * 8 * NR) {
        f32x4 v[NR][4]; float s[NR];
#pragma unroll
        for (int q = 0; q < NR; ++q)
#pragma unroll
            for (int k = 0; k < 4; ++k) v[q][k] = *(const f32x4*)(src + (size_t)(r + q) * 1024 + k * 256 + lane * 4);
#pragma unroll
        for (int q = 0; q < NR; ++q) { s[q] = 0.f;
#pragma unroll
            for (int k = 0; k < 4; ++k) s[q] += v[q][k][0] * v[q][k][0] + v[q][k][1] * v[q][k][1] + v[q][k][2] * v[q][k][2] + v[q][k][3] * v[q][k][3]; }
#pragma unroll
        for (int o = 32; o > 0; o >>= 1)
#pragma unroll
            for (int q = 0; q < NR; ++q) s[q] += __shfl_xor(s[q], o);
#pragma unroll
        for (int q = 0; q < NR; ++q) { const float sc = rsqrtf(s[q] * (1.f / 1024.f) + 1e-6f);
#pragma unroll
            for (int k = 0; k < 4; ++k) {
                if (TO_BF16) { u32x2 o; o.x = pk2(v[q][k][0] * sc * g4[k][0], v[q][k][1] * sc * g4[k][1]); o.y = pk2(v[q][k][2] * sc * g4[k][2], v[q][k][3] * sc * g4[k][3]);
                    *(u32x2*)(dst + (size_t)(r + q) * 1024 + k * 256 + lane * 4) = o; }
                else *(f32x4*)(fdst + (size_t)(r + q) * 1024 + k * 256 + lane * 4) = v[q][k] * sc * g4[k]; } }
    }
}
DI void rms_phase(const int tid, const float* src, const float* gam, bf16_t* dst, int G, int c) { rms_rows<true>(tid, src, gam, dst, nullptr, G, c); }
DI void rms_final(const int tid, float* io, const float* gam, int G, int c) { rms_rows<false>(tid, io, gam, nullptr, io, G, c); }
DI void rms_owned(const int tid, float* h, const float* gam, bf16_t* dst, int G, int c) {
    const int wave = tid >> 6, lane = tid & 63;
    for (int pm = c; pm < MTOK / 256; pm += G)
        for (int rr = 0; rr < 32; ++rr) {
            const int r = pm * 256 + wave * 32 + rr;
            float* p = h + (size_t)r * 1024; f32x4 v[4]; float ss = 0.f;
#pragma unroll
            for (int k = 0; k < 4; ++k) { v[k] = *(const f32x4*)(p + k * 256 + lane * 4); ss += v[k][0] * v[k][0] + v[k][1] * v[k][1] + v[k][2] * v[k][2] + v[k][3] * v[k][3]; }
            ss = wave_sum(ss); const float sc = rsqrtf(ss * (1.f / 1024.f) + 1e-6f);
#pragma unroll
            for (int k = 0; k < 4; ++k) { const f32x4 g4 = *(const f32x4*)(gam + k * 256 + lane * 4);
                if (dst) { u32x2 o; o.x = pk2(v[k][0] * sc * g4[0], v[k][1] * sc * g4[1]); o.y = pk2(v[k][2] * sc * g4[2], v[k][3] * sc * g4[3]); *(u32x2*)(dst + (size_t)r * 1024 + k * 256 + lane * 4) = o; }
                else *(f32x4*)(p + k * 256 + lane * 4) = v[k] * sc * g4; }
        }
}

template <bool PASSB>
DI void s5_pass(const int tid, LAS unsigned char* lds, const P& p, int G, int c0) {
    const int wave = tid >> 6, lane = tid & 63, fr = lane & 15, fq = lane >> 4;
    LAS float* ubuf = (LAS float*)(lds + wave * 8192);
    LAS bf16_t* hbuf = (LAS bf16_t*)(lds + wave * 8192 + 1024);
    const float* abar = (const float*)(p.ws + W_S5AB); const float* bbar = (const float*)(p.ws + W_S5BB); const bf16_t* ccat = (const bf16_t*)(p.ws + W_S5CC);
    const bf16_t* us5 = (const bf16_t*)(p.ws + A_US5); bf16_t* zs5 = (bf16_t*)(p.ws + A_ZS5); float* hend = (float*)(p.ws + A_S5END);
    const float* dskip = p.in[10];
    for (int bu = c0; bu < 512; bu += G) {
        const int g = bu >> 5, wu = (bu & 31) * 8 + wave, b = wu >> 3, seg = wu & 7;
        float bre[16], bim[16];
        { const f32x4* bp = (const f32x4*)(bbar + ((size_t)(g * 64 + lane)) * 32);
#pragma unroll
          for (int k = 0; k < 4; ++k) { f32x4 v = bp[k]; bre[4 * k] = v[0]; bre[4 * k + 1] = v[1]; bre[4 * k + 2] = v[2]; bre[4 * k + 3] = v[3]; }
#pragma unroll
          for (int k = 0; k < 4; ++k) { f32x4 v = bp[4 + k]; bim[4 * k] = v[0]; bim[4 * k + 1] = v[1]; bim[4 * k + 2] = v[2]; bim[4 * k + 3] = v[3]; } }
        const float are = abar[(g * 64 + lane) * 2], aim = abar[(g * 64 + lane) * 2 + 1];
        float hre = 0.f, him = 0.f;
        bf16x8 cf[4]; float dsk = 0.f;
        if (PASSB) {
#pragma unroll
            for (int ks = 0; ks < 4; ++ks) cf[ks] = *(const bf16x8*)(ccat + ((size_t)(g * 16 + fr)) * 128 + ks * 32 + fq * 8);
            dsk = dskip[g * 16 + fr];
            float pr = are, pi = aim;
#pragma unroll
            for (int s = 0; s < 8; ++s) { const float nr = pr * pr - pi * pi, ni = 2.f * pr * pi; pr = nr; pi = ni; }
            for (int s = 0; s < seg; ++s) { const float* he = hend + (((size_t)(b * 16 + g) * 8 + s) * 64 + lane) * 2; const float er = he[0], ei = he[1];
                const float nr = pr * hre - pi * him + er, ni = pr * him + pi * hre + ei; hre = nr; him = ni; }
        }
        const size_t tokbase = (size_t)b * SEQ + seg * 256;
        for (int tile = 0; tile < 16; ++tile) {
            if (lane < 32) { const int tk = lane >> 1, hf = lane & 1;
                const u32x4 raw = *(const u32x4*)(us5 + (tokbase + tile * 16 + tk) * 256 + g * 16 + hf * 8);
                LAS float* d = ubuf + tk * 16 + hf * 8;
                *(LAS f32x4*)d = (f32x4){lo16(raw.x), hi16(raw.x), lo16(raw.y), hi16(raw.y)}; *(LAS f32x4*)(d + 4) = (f32x4){lo16(raw.z), hi16(raw.z), lo16(raw.w), hi16(raw.w)}; }
            lds_wait();
#pragma unroll 4
            for (int t = 0; t < 16; ++t) {
                float bur = 0.f, bui = 0.f;
#pragma unroll
                for (int k = 0; k < 4; ++k) { const f32x4 u = *(const LAS f32x4*)(ubuf + t * 16 + k * 4);
#pragma unroll
                    for (int e = 0; e < 4; ++e) { bur += bre[4 * k + e] * u[e]; bui += bim[4 * k + e] * u[e]; } }
                const float nr = are * hre - aim * him + bur, ni = are * him + aim * hre + bui; hre = nr; him = ni;
                if (PASSB) { hbuf[t * 136 + lane] = f2bf(hre); hbuf[t * 136 + 64 + lane] = f2bf(-him); }
            }
            if (PASSB) {
                lds_wait();
                f32x4 acc = (f32x4){0.f, 0.f, 0.f, 0.f};
#pragma unroll
                for (int ks = 0; ks < 4; ++ks) { const bf16x8 a = *(const LAS bf16x8*)(hbuf + fr * 136 + ks * 32 + fq * 8); acc = mfma16(a, cf[ks], acc); }
#pragma unroll
                for (int j = 0; j < 4; ++j) { const int tk = fq * 4 + j; const float y = acc[j] + dsk * ubuf[tk * 16 + fr];
                    zs5[(tokbase + tile * 16 + tk) * 256 + g * 16 + fr] = f2bf(gelu_tanh(y)); }
            }
            lds_wait();
        }
        if (!PASSB) { float* he = hend + (((size_t)(b * 16 + g) * 8 + seg) * 64 + lane) * 2; he[0] = hre; he[1] = him; }
    }
}

DI void gdn_prep_phase(const int tid, LAS unsigned char* lds, const P& p, int G, int c) {
    const int hb = tid >> 8, ht = tid & 255, lane = tid & 63, wv = __builtin_amdgcn_readfirstlane(ht >> 6), fr = lane & 15, fq = lane >> 4;
    LAS unsigned char* base = lds + hb * 65536;
    LAS bf16_t* Qs = (LAS bf16_t*)base; LAS bf16_t* Ks = Qs + 64 * 136;
    LAS float* Ls = (LAS float*)(base + 2 * 17408); LAS float* tb = (LAS float*)(base + 3 * 17408);
    const bf16_t* qkv = (const bf16_t*)(p.ws + A_QKV); const float* blal = (const float*)(p.ws + A_BLAL);
    const float* convw = p.in[13]; const float* a_log = p.in[14]; const float* dt_bias = p.in[15];
    bf16_t* Uc = (bf16_t*)(p.ws + CH_U); bf16_t* Wc = (bf16_t*)(p.ws + CH_W); bf16_t* QDc = (bf16_t*)(p.ws + CH_QD); bf16_t* KDTc = (bf16_t*)(p.ws + CH_KDT); bf16_t* INc = (bf16_t*)(p.ws + CH_INTRA); float* GLc = (float*)(p.ws + CH_GL);
    for (int u = c * 2 + hb; u < 6144; u += 2 * G) {
        const int n = u & 31, bh = u >> 5, h = bh % 6, b = bh / 6; const size_t cid = (size_t)u;
        const long tok0 = (long)b * SEQ + n * 64;
        float xs[64];
        {
            const int ch = ht & 127, th = ht >> 7, isv = th, colq = h * 128 + ch, colkv = 768 + isv * 768 + h * 128 + ch, t0 = th * 32;
            bf16_t qraw[35], kvraw[67];
            const bool haloq = (n > 0) || (t0 > 0), halokv = (n > 0);
#pragma unroll
            for (int e = 0; e < 3; ++e) { qraw[e] = haloq ? qkv[(tok0 + t0 - 3 + e) * 2304 + colq] : (bf16_t)0; kvraw[e] = halokv ? qkv[(tok0 - 3 + e) * 2304 + colkv] : (bf16_t)0; }
#pragma unroll
            for (int e = 0; e < 32; ++e) qraw[3 + e] = qkv[(tok0 + t0 + e) * 2304 + colq];
#pragma unroll
            for (int e = 0; e < 64; ++e) kvraw[3 + e] = qkv[(tok0 + e) * 2304 + colkv];
            { const float w0 = convw[colq], w1 = convw[2304 + colq], w2 = convw[4608 + colq], w3 = convw[6912 + colq];
#pragma unroll
              for (int e = 0; e < 32; ++e) { const float y = w0 * bf2f(qraw[e]) + w1 * bf2f(qraw[e + 1]) + w2 * bf2f(qraw[e + 2]) + w3 * bf2f(qraw[e + 3]); Qs[(t0 + e) * 136 + ch] = f2bf(silu_fast(y)); } }
            { const float w0 = convw[colkv], w1 = convw[2304 + colkv], w2 = convw[4608 + colkv], w3 = convw[6912 + colkv];
#pragma unroll
              for (int e = 0; e < 64; ++e) { const float y = w0 * bf2f(kvraw[e]) + w1 * bf2f(kvraw[e + 1]) + w2 * bf2f(kvraw[e + 2]) + w3 * bf2f(kvraw[e + 3]); xs[e] = silu_fast(y); }
              if (!isv) {
#pragma unroll
                  for (int tt = 0; tt < 64; ++tt) Ks[tt * 136 + ch] = f2bf(xs[tt]); } }
        }
        if (ht < 64) { const float bl = blal[(tok0 + ht) * 16 + h], al = blal[(tok0 + ht) * 16 + 6 + h];
            const float x = al + dt_bias[h]; const float sp = fmaxf(x, 0.f) + log1pf(expf(-fabsf(x))); float gsum = -expf(a_log[h]) * sp;
#pragma unroll
            for (int off = 1; off < 64; off <<= 1) { const float v = __shfl_up(gsum, off); if (lane >= off) gsum += v; }
            tb[ht] = 1.f / (1.f + expf(-bl)); tb[64 + ht] = gsum; }
        __syncthreads();
        f32x4 kk[4], qk[4];
        { bf16x8 aK[4], aQ[4];
#pragma unroll
          for (int ks = 0; ks < 4; ++ks) { aK[ks] = *(const LAS bf16x8*)(Ks + (wv * 16 + fr) * 136 + ks * 32 + fq * 8); aQ[ks] = *(const LAS bf16x8*)(Qs + (wv * 16 + fr) * 136 + ks * 32 + fq * 8); }
          f32x4 qq = (f32x4){0.f, 0.f, 0.f, 0.f};
#pragma unroll
          for (int ks = 0; ks < 4; ++ks) qq = mfma16(aQ[ks], aQ[ks], qq);
#pragma unroll
          for (int ct = 0; ct < 4; ++ct) { kk[ct] = (f32x4){0.f, 0.f, 0.f, 0.f}; qk[ct] = (f32x4){0.f, 0.f, 0.f, 0.f};
              if (ct <= wv) {
#pragma unroll
                  for (int ks = 0; ks < 4; ++ks) { const bf16x8 bK = *(const LAS bf16x8*)(Ks + (ct * 16 + fr) * 136 + ks * 32 + fq * 8); kk[ct] = mfma16(aK[ks], bK, kk[ct]); qk[ct] = mfma16(aQ[ks], bK, qk[ct]); } }
              if (ct == wv && (fr >> 2) == fq) { const int j = fr & 3; const float dk = j == 0 ? kk[ct][0] : j == 1 ? kk[ct][1] : j == 2 ? kk[ct][2] : kk[ct][3];
                  const float dq = j == 0 ? qq[0] : j == 1 ? qq[1] : j == 2 ? qq[2] : qq[3]; tb[128 + wv * 16 + fr] = dq; tb[192 + wv * 16 + fr] = dk; } } }
        __syncthreads();
        {
            float rkc[4], rqc[4], gcc[4], btc[4], rks[4], gcs[4];
#pragma unroll
            for (int j = 0; j < 4; ++j) { const int cr = wv * 16 + fq * 4 + j; rkc[j] = rsqrtf(tb[192 + cr] + 1e-6f); rqc[j] = rsqrtf(tb[128 + cr] + 1e-6f) * 0.08838834764831845f; gcc[j] = tb[64 + cr]; btc[j] = tb[cr]; }
#pragma unroll
            for (int ct = 0; ct < 4; ++ct) { const int sc = ct * 16 + fr; rks[ct] = rsqrtf(tb[192 + sc] + 1e-6f); gcs[ct] = tb[64 + sc]; }
#pragma unroll
            for (int ct = 0; ct < 4; ++ct)
#pragma unroll
                for (int j = 0; j < 4; ++j) { const int cr = wv * 16 + fq * 4 + j, sc = ct * 16 + fr;
                    const float e = (sc <= cr) ? __expf(gcc[j] - gcs[ct]) : 0.f;
                    Ls[(cr >> 1) * 136 + sc * 2 + (cr & 1)] = (sc < cr) ? btc[j] * rkc[j] * rks[ct] * kk[ct][j] * e : 0.f;
                    INc[cid * 4096 + cr * 64 + sc] = f2bf(rqc[j] * rks[ct] * qk[ct][j] * e); }
            if (ht < 64) { const float rk = rsqrtf(tb[192 + ht] + 1e-6f), gch = tb[64 + ht];
                tb[256 + ht] = rk * __expf(tb[64 + 63] - gch); tb[320 + ht] = rk * tb[ht] * __expf(gch); }
        }
        __syncthreads();
        { const int ch = ht & 127, isv = ht >> 7; const float gl = tb[64 + 63];
          if (!isv) {
#pragma unroll
              for (int i8 = 0; i8 < 8; ++i8) { float kd[8];
#pragma unroll
                  for (int e = 0; e < 8; ++e) { const int tt = i8 * 8 + e; kd[e] = xs[tt] * tb[256 + tt]; xs[tt] = xs[tt] * tb[320 + tt]; }
                  u32x4 w; w.x = pk2(kd[0], kd[1]); w.y = pk2(kd[2], kd[3]); w.z = pk2(kd[4], kd[5]); w.w = pk2(kd[6], kd[7]);
                  *(u32x4*)(KDTc + cid * 8192 + ch * 64 + i8 * 8) = w; }
          } else {
#pragma unroll
              for (int tt = 0; tt < 64; ++tt) xs[tt] *= tb[tt]; }
#pragma unroll
          for (int kb = 0; kb < 8; ++kb) {
#pragma unroll
              for (int pp = 0; pp < 4; ++pp) { const int pr = 4 * kb + pp;
                  f32x2 s = (f32x2){xs[2 * pr], xs[2 * pr + 1]};
#pragma unroll
                  for (int j = 8 * kb; j < 2 * pr; j += 2) { const f32x4 l = *(const LAS f32x4*)(Ls + pr * 136 + j * 2);
                      s -= (f32x2){l[0], l[1]} * (f32x2){xs[j], xs[j]}; s -= (f32x2){l[2], l[3]} * (f32x2){xs[j + 1], xs[j + 1]}; }
                  xs[2 * pr] = s[0];
                  xs[2 * pr + 1] = s[1] - Ls[pr * 136 + 4 * pr + 1] * s[0]; }
#pragma unroll
              for (int pr = 4 * kb + 4; pr < 32; ++pr) {
                  f32x2 s0 = (f32x2){xs[2 * pr], xs[2 * pr + 1]}, s1 = (f32x2){0.f, 0.f};
#pragma unroll
                  for (int q = 0; q < 4; ++q) { const int j = 8 * kb + 2 * q; const f32x4 l = *(const LAS f32x4*)(Ls + pr * 136 + j * 2);
                      s0 -= (f32x2){l[0], l[1]} * (f32x2){xs[j], xs[j]}; s1 -= (f32x2){l[2], l[3]} * (f32x2){xs[j + 1], xs[j + 1]}; }
                  const f32x2 s = s0 + s1; xs[2 * pr] = s[0]; xs[2 * pr + 1] = s[1]; }
          }
          if (isv) {
#pragma unroll
              for (int i8 = 0; i8 < 8; ++i8) { u32x4 w; w.x = pk2(xs[i8 * 8], xs[i8 * 8 + 1]); w.y = pk2(xs[i8 * 8 + 2], xs[i8 * 8 + 3]); w.z = pk2(xs[i8 * 8 + 4], xs[i8 * 8 + 5]); w.w = pk2(xs[i8 * 8 + 6], xs[i8 * 8 + 7]);
                  *(u32x4*)(Uc + cid * 8192 + ch * 64 + i8 * 8) = w; }
          } else { bf16_t* dst = Wc + cid * 8192 + ch;
#pragma unroll
              for (int tt = 0; tt < 64; ++tt) dst[tt * 128] = f2bf(xs[tt]); }
          { const int tt = ht >> 2, d0 = (ht & 3) * 32; const float fac = rsqrtf(tb[128 + tt] + 1e-6f) * 0.08838834764831845f * __expf(tb[64 + tt]);
#pragma unroll
            for (int i = 0; i < 4; ++i) { const u32x4 r = *(const LAS u32x4*)(Qs + tt * 136 + d0 + i * 8); u32x4 w;
                w.x = pk2(lo16(r.x) * fac, hi16(r.x) * fac); w.y = pk2(lo16(r.y) * fac, hi16(r.y) * fac); w.z = pk2(lo16(r.z) * fac, hi16(r.z) * fac); w.w = pk2(lo16(r.w) * fac, hi16(r.w) * fac);
                *(u32x4*)(QDc + cid * 8192 + tt * 128 + d0 + i * 8) = w; } }
          if (ht == 0) GLc[cid] = __expf(gl); }
        __syncthreads();
    }
}

DI void gdn_seq_phase(const int tid, LAS unsigned char* lds, const P& p, int G, int c) {
    const int w = __builtin_amdgcn_readfirstlane(tid >> 6), lane = tid & 63, fr = lane & 15, fq = lane >> 4, ct = w & 3, eh = w >> 2;
    LAS bf16_t* ST = (LAS bf16_t*)lds;
    LAS bf16_t* VT = (LAS bf16_t*)(lds + 34816);
    LAS float* OT = (LAS float*)(lds + 34816 + 18432);
    const bf16_t* Uc = (const bf16_t*)(p.ws + CH_U); const bf16_t* Wc = (const bf16_t*)(p.ws + CH_W); const bf16_t* QDc = (const bf16_t*)(p.ws + CH_QD); const bf16_t* KDTc = (const bf16_t*)(p.ws + CH_KDT); const bf16_t* INc = (const bf16_t*)(p.ws + CH_INTRA); const float* GLc = (const float*)(p.ws + CH_GL);
    const bf16_t* Z = (const bf16_t*)(p.ws + A_Z); bf16_t* ycat = (bf16_t*)(p.ws + A_YCAT); const float* normw = p.in[16];
    for (int u = c; u < 192; u += G) {
        const int h = u % 6, b = u / 6;
        for (int i = tid; i < 128 * 136 / 2; i += 512) ((LAS unsigned*)ST)[i] = 0u;
        f32x4 Sacc[8];
#pragma unroll
        for (int e = 0; e < 8; ++e) Sacc[e] = (f32x4){0.f, 0.f, 0.f, 0.f};
        __syncthreads();
        bf16x8 Wf[4], Qf[4], If[2], Kf[2]; u32x2 uvr[4]; float gl;
        const int wrow = (ct * 16 + fr) * 128 + fq * 8, irow = (ct * 16 + fr) * 64 + fq * 8, krow = (w * 16 + fr) * 64 + fq * 8;
        { const size_t cid = (size_t)u * 32;
#pragma unroll
          for (int ks = 0; ks < 4; ++ks) { Wf[ks] = *(const bf16x8*)(Wc + cid * 8192 + wrow + ks * 32); Qf[ks] = *(const bf16x8*)(QDc + cid * 8192 + wrow + ks * 32); }
#pragma unroll
          for (int ks = 0; ks < 2; ++ks) { If[ks] = *(const bf16x8*)(INc + cid * 4096 + irow + ks * 32); Kf[ks] = *(const bf16x8*)(KDTc + cid * 8192 + krow + ks * 32); }
#pragma unroll
          for (int et = 0; et < 4; ++et) uvr[et] = *(const u32x2*)(Uc + cid * 8192 + (eh * 64 + et * 16 + fr) * 64 + ct * 16 + fq * 4);
          gl = GLc[cid]; }
        for (int n = 0; n < 32; ++n) {
            const size_t cid = (size_t)u * 32 + n, cnx = (cid + 1 < 6144) ? cid + 1 : cid;
            const int tt = tid >> 3, e0 = (tid & 7) * 16; const size_t tok = (size_t)b * SEQ + n * 64 + tt;
            const u32x4 z0 = *(const u32x4*)(Z + tok * 768 + h * 128 + e0), z1 = *(const u32x4*)(Z + tok * 768 + h * 128 + e0 + 8);
            f32x4 T1[4], O1[4];
#pragma unroll
            for (int et = 0; et < 4; ++et) { T1[et] = (f32x4){0.f, 0.f, 0.f, 0.f}; O1[et] = (f32x4){0.f, 0.f, 0.f, 0.f};
#pragma unroll
                for (int ks = 0; ks < 4; ++ks) { const bf16x8 bb = *(const LAS bf16x8*)(ST + (eh * 64 + et * 16 + fr) * 136 + ks * 32 + fq * 8); T1[et] = mfma16(Wf[ks], bb, T1[et]); O1[et] = mfma16(Qf[ks], bb, O1[et]); } }
#pragma unroll
            for (int ks = 0; ks < 4; ++ks) { Wf[ks] = *(const bf16x8*)(Wc + cnx * 8192 + wrow + ks * 32); Qf[ks] = *(const bf16x8*)(QDc + cnx * 8192 + wrow + ks * 32); }
#pragma unroll
            for (int et = 0; et < 4; ++et) { u32x2 pk; pk.x = pk2(lo16(uvr[et].x) - T1[et][0], hi16(uvr[et].x) - T1[et][1]); pk.y = pk2(lo16(uvr[et].y) - T1[et][2], hi16(uvr[et].y) - T1[et][3]);
                *(LAS u32x2*)(VT + (eh * 64 + et * 16 + fr) * 72 + ct * 16 + fq * 4) = pk; }
#pragma unroll
            for (int et = 0; et < 4; ++et) uvr[et] = *(const u32x2*)(Uc + cnx * 8192 + (eh * 64 + et * 16 + fr) * 64 + ct * 16 + fq * 4);
            __syncthreads();
#pragma unroll
            for (int et = 0; et < 4; ++et) {
#pragma unroll
                for (int ks = 0; ks < 2; ++ks) { const bf16x8 bb = *(const LAS bf16x8*)(VT + (eh * 64 + et * 16 + fr) * 72 + ks * 32 + fq * 8); O1[et] = mfma16(If[ks], bb, O1[et]); }
#pragma unroll
                for (int j = 0; j < 4; ++j) OT[(ct * 16 + fq * 4 + j) * 132 + eh * 64 + et * 16 + fr] = O1[et][j]; }
#pragma unroll
            for (int ks = 0; ks < 2; ++ks) If[ks] = *(const bf16x8*)(INc + cnx * 4096 + irow + ks * 32);
#pragma unroll
            for (int e8 = 0; e8 < 8; ++e8) { Sacc[e8] = Sacc[e8] * gl;
#pragma unroll
                for (int ks = 0; ks < 2; ++ks) { const bf16x8 aa = *(const LAS bf16x8*)(VT + (e8 * 16 + fr) * 72 + ks * 32 + fq * 8); Sacc[e8] = mfma16(aa, Kf[ks], Sacc[e8]); } }
#pragma unroll
            for (int ks = 0; ks < 2; ++ks) Kf[ks] = *(const bf16x8*)(KDTc + cnx * 8192 + krow + ks * 32);
            gl = GLc[cnx];
            __syncthreads();
#pragma unroll
            for (int e8 = 0; e8 < 8; ++e8)
#pragma unroll
                for (int j = 0; j < 4; ++j) ST[(e8 * 16 + fq * 4 + j) * 136 + w * 16 + fr] = f2bf(Sacc[e8][j]);
            { float o[16]; float ss = 0.f;
#pragma unroll
              for (int i = 0; i < 4; ++i) { const f32x4 v = *(const LAS f32x4*)(OT + tt * 132 + e0 + i * 4); o[4 * i] = v[0]; o[4 * i + 1] = v[1]; o[4 * i + 2] = v[2]; o[4 * i + 3] = v[3]; ss += v[0] * v[0] + v[1] * v[1] + v[2] * v[2] + v[3] * v[3]; }
              ss += __shfl_xor(ss, 1); ss += __shfl_xor(ss, 2); ss += __shfl_xor(ss, 4);
              const float sc = rsqrtf(ss * (1.f / 128.f) + 1e-6f);
              float zz[16] = {lo16(z0.x), hi16(z0.x), lo16(z0.y), hi16(z0.y), lo16(z0.z), hi16(z0.z), lo16(z0.w), hi16(z0.w), lo16(z1.x), hi16(z1.x), lo16(z1.y), hi16(z1.y), lo16(z1.z), hi16(z1.z), lo16(z1.w), hi16(z1.w)};
              float r[16];
#pragma unroll
              for (int i = 0; i < 16; ++i) r[i] = o[i] * sc * normw[e0 + i] * silu_fast(zz[i]);
              u32x4 w0, w1; w0.x = pk2(r[0], r[1]); w0.y = pk2(r[2], r[3]); w0.z = pk2(r[4], r[5]); w0.w = pk2(r[6], r[7]); w1.x = pk2(r[8], r[9]); w1.y = pk2(r[10], r[11]); w1.z = pk2(r[12], r[13]); w1.w = pk2(r[14], r[15]);
              *(u32x4*)(ycat + tok * 1024 + 256 + h * 128 + e0) = w0; *(u32x4*)(ycat + tok * 1024 + 256 + h * 128 + e0 + 8) = w1; }
            __syncthreads();
        }
    }
}

DI void convact_phase(const int tid, const P& p, int layer, int half, int G, int c) {
    const bf16_t* up = (const bf16_t*)(p.ws + F_UP); bf16_t* act = (bf16_t*)(p.ws + F_ACT);
    const float* cw = p.in[28] + (size_t)layer * 3 * FF2; const float* cb = p.in[29] + (size_t)layer * FF2;
    const int nitems = (32768 / 8) * 352;
    for (int it = c * 512 + tid; it < nitems; it += G * 512) {
        const int ck = it % 352, run = it / 352, ch = ck * 8, r0 = run * 8, sp0 = r0 & 2047;
        float wa[3][8], wb[3][8], ba[8], bb[8];
#pragma unroll
        for (int k = 0; k < 3; ++k)
#pragma unroll
            for (int e = 0; e < 8; ++e) { wa[k][e] = cw[k * FF2 + ch + e]; wb[k][e] = cw[k * FF2 + FFH + ch + e]; }
#pragma unroll
        for (int e = 0; e < 8; ++e) { ba[e] = cb[ch + e]; bb[e] = cb[FFH + ch + e]; }
        u32x4 a0 = (u32x4){0, 0, 0, 0}, a1 = a0, b0 = a0, b1 = a0;
        if (sp0 > 0) { a0 = *(const u32x4*)(up + (size_t)(r0 - 2) * FF2 + ch); a1 = *(const u32x4*)(up + (size_t)(r0 - 1) * FF2 + ch); b0 = *(const u32x4*)(up + (size_t)(r0 - 2) * FF2 + FFH + ch); b1 = *(const u32x4*)(up + (size_t)(r0 - 1) * FF2 + FFH + ch); }
#pragma unroll
        for (int r = 0; r < 8; ++r) {
            const u32x4 a2 = *(const u32x4*)(up + (size_t)(r0 + r) * FF2 + ch), b2 = *(const u32x4*)(up + (size_t)(r0 + r) * FF2 + FFH + ch);
            const unsigned A0[4] = {a0.x, a0.y, a0.z, a0.w}, A1[4] = {a1.x, a1.y, a1.z, a1.w}, A2[4] = {a2.x, a2.y, a2.z, a2.w}, B0[4] = {b0.x, b0.y, b0.z, b0.w}, B1[4] = {b1.x, b1.y, b1.z, b1.w}, B2[4] = {b2.x, b2.y, b2.z, b2.w};
            float o[8];
#pragma unroll
            for (int q = 0; q < 4; ++q) {
                const float al = wa[0][2 * q] * lo16(A0[q]) + wa[1][2 * q] * lo16(A1[q]) + wa[2][2 * q] * lo16(A2[q]) + ba[2 * q];
                const float ah = wa[0][2 * q + 1] * hi16(A0[q]) + wa[1][2 * q + 1] * hi16(A1[q]) + wa[2][2 * q + 1] * hi16(A2[q]) + ba[2 * q + 1];
                const float bl = wb[0][2 * q] * lo16(B0[q]) + wb[1][2 * q] * lo16(B1[q]) + wb[2][2 * q] * lo16(B2[q]) + bb[2 * q];
                const float bh = wb[0][2 * q + 1] * hi16(B0[q]) + wb[1][2 * q + 1] * hi16(B1[q]) + wb[2][2 * q + 1] * hi16(B2[q]) + bb[2 * q + 1];
                o[2 * q] = siluf_(al) * bl; o[2 * q + 1] = siluf_(ah) * bh; }
            u32x4 w; w.x = pk2(o[0], o[1]); w.y = pk2(o[2], o[3]); w.z = pk2(o[4], o[5]); w.w = pk2(o[6], o[7]);
            *(u32x4*)(act + ((size_t)half * 32768 + r0 + r) * FFH + ch) = w;
            a0 = a1; a1 = a2; b0 = b1; b1 = b2; }
    }
}

DI void nsa_attn_phase(const int tid0, LAS unsigned char* lds, const P& p, int G, int c) {
    const int w = __builtin_amdgcn_readfirstlane(tid0 >> 6), r = w & 3, qh = w >> 2;
    LAS bf16_t* Qs = (LAS bf16_t*)lds;
    LAS bf16_t* Kc = (LAS bf16_t*)(lds + 36864);
    LAS bf16_t* VcT = (LAS bf16_t*)(lds + 36864 + 18432);
    LAS bf16_t* KV0 = (LAS bf16_t*)(lds + 72704);
    LAS float* imp4 = (LAS float*)(lds + 109568);
    LAS unsigned* selm = (LAS unsigned*)(lds + 109568 + 33792);
    const bf16_t* Q = (const bf16_t*)(p.ws + N_Q); const bf16_t* KS = (const bf16_t*)(p.ws + N_KS); const bf16_t* VST = (const bf16_t*)(p.ws + N_VST); const bf16_t* KW = (const bf16_t*)(p.ws + N_KW); const bf16_t* VWT = (const bf16_t*)(p.ws + N_VWT);
    const bf16_t* KCMP = (const bf16_t*)(p.ws + N_KCMP); const bf16_t* VCMPT = (const bf16_t*)(p.ws + N_VCMPT); const float* gates = (const float*)(p.ws + N_GATES); bf16_t* AO = (bf16_t*)(p.ws + N_AO);
    for (int idx = c; idx < 4096; idx += G) {
        int tid = tid0; asm volatile("" : "+v"(tid));
        const int lane = tid & 63, fr = lane & 15, fq = lane >> 4;
        const int rnd = idx >> 8, hi_half = (idx >> 7) & 1, i = 31 - 2 * rnd - (hi_half ^ (rnd & 1)), bg = idx & 127, b = bg >> 2, g = bg & 3, hd = g * 4 + r;
        const size_t tokb = (size_t)b * SEQ + i * 64;
        const int nkt = (i >> 2) + 1;
#pragma unroll
        for (int k = 0; k < 4; ++k) { const int pc = tid + k * 512, row = pc >> 3, cc = pc & 7, rr = row >> 6, ql = row & 63;
            *(LAS u32x4*)(Qs + row * 72 + cc * 8) = *(const u32x4*)(Q + (tokb + ql) * 1024 + (g * 4 + rr) * 64 + cc * 8); }
#pragma unroll
        for (int k = 0; k < 2; ++k) { const int pc = tid + k * 512; { const int row = pc >> 3, cc = pc & 7; if (row < nkt * 16) *(LAS u32x4*)(Kc + row * 72 + cc * 8) = *(const u32x4*)(KCMP + (size_t)bg * 8192 + row * 64 + cc * 8); }
            { const int row = pc >> 4, cc = pc & 15; *(LAS u32x4*)(VcT + row * 136 + cc * 8) = *(const u32x4*)(VCMPT + (size_t)bg * 8192 + row * 128 + cc * 8); } }
        __syncthreads();
        bf16x8 Qf[2][2];
#pragma unroll
        for (int qt = 0; qt < 2; ++qt)
#pragma unroll
            for (int ks = 0; ks < 2; ++ks) Qf[qt][ks] = *(const LAS bf16x8*)(Qs + (r * 64 + qh * 32 + qt * 16 + fr) * 72 + ks * 32 + fq * 8);
        const float slope2 = exp2f(-0.5f * (float)(hd + 1)) * 1.4426950408889634f;
        float sc16[16];
#pragma unroll
        for (int e = 0; e < 16; ++e) sc16[e] = slope2 * (float)((e >> 2) * 16 + (e & 3));
        int tq[2]; float g0[2], g1[2], g2[2];
#pragma unroll
        for (int qt = 0; qt < 2; ++qt) { const int ql = qh * 32 + qt * 16 + fr; tq[qt] = i * 64 + ql; const float* gp = gates + (tokb + ql) * 48 + hd * 3; g0[qt] = gp[0]; g1[qt] = gp[1]; g2[qt] = gp[2]; }
        f32x4 outacc[4][2];
#pragma unroll
        for (int qt = 0; qt < 2; ++qt) {
            const int jmax = tq[qt] >= 31 ? ((tq[qt] - 31) >> 4) : -1;
            const float sl16 = slope2 * 16.f, jb = (float)(fq * 4);
            f32x4 S[8];
#pragma unroll
            for (int kt = 0; kt < 8; ++kt) { S[kt] = (f32x4){0.f, 0.f, 0.f, 0.f};
                if (kt < nkt) {
#pragma unroll
                    for (int ks = 0; ks < 2; ++ks) { const bf16x8 kf = *(const LAS bf16x8*)(Kc + (kt * 16 + fr) * 72 + ks * 32 + fq * 8); S[kt] = mfma16(kf, Qf[qt][ks], S[kt]); } } }
            float m = -1e30f;
#pragma unroll
            for (int kt = 0; kt < 8; ++kt) if (kt < nkt) {
#pragma unroll
                for (int j = 0; j < 4; ++j) { const int jc = kt * 16 + fq * 4 + j; const float s = fmaf(sl16, jb + (float)(kt * 16 + j), S[kt][j]); S[kt][j] = (jc <= jmax) ? s : -1e30f; m = fmaxf(m, S[kt][j]); } }
            m = fmaxf(m, __shfl_xor(m, 16)); m = fmaxf(m, __shfl_xor(m, 32));
            float l = 0.f;
#pragma unroll
            for (int kt = 0; kt < 8; ++kt) if (kt < nkt) {
#pragma unroll
                for (int j = 0; j < 4; ++j) { const float pv = (S[kt][j] > -1e29f) ? __builtin_amdgcn_exp2f(S[kt][j] - m) : 0.f; S[kt][j] = pv; l += pv; } }
            l += __shfl_xor(l, 16); l += __shfl_xor(l, 32);
            const float inv = l > 0.f ? 1.f / l : 0.f;
            float prev3 = 0.f;
#pragma unroll
            for (int kt = 0; kt < 8; ++kt) if (kt < nkt) {
#pragma unroll
                for (int j = 0; j < 4; ++j) S[kt][j] *= inv;
                const float p3 = S[kt][3];
                const float x1 = __shfl(p3, (lane + 48) & 63), x2 = __shfl(prev3, (lane + 48) & 63);
                const float carry = (fq > 0) ? x1 : x2;
                imp4[(r * 64 + qh * 32 + qt * 16 + fr) * 33 + kt * 4 + fq] = S[kt][0] + S[kt][1] + S[kt][2] + 0.5f * p3 + 0.5f * carry;
                prev3 = p3; }
#pragma unroll
            for (int dt = 0; dt < 4; ++dt) outacc[dt][qt] = (f32x4){0.f, 0.f, 0.f, 0.f};
#pragma unroll
            for (int s = 0; s < 4; ++s) if (2 * s < nkt) {
                u32x4 t; t.x = pk2(S[2 * s][0], S[2 * s][1]); t.y = pk2(S[2 * s][2], S[2 * s][3]); t.z = pk2(S[2 * s + 1][0], S[2 * s + 1][1]); t.w = pk2(S[2 * s + 1][2], S[2 * s + 1][3]);
                const bf16x8 pf = __builtin_bit_cast(bf16x8, t);
#pragma unroll
                for (int dt = 0; dt < 4; ++dt) { u32x4 tv; const u32x2 v0 = *(const LAS u32x2*)(VcT + (dt * 16 + fr) * 136 + s * 32 + fq * 4), v1 = *(const LAS u32x2*)(VcT + (dt * 16 + fr) * 136 + s * 32 + 16 + fq * 4);
                    tv.x = v0.x; tv.y = v0.y; tv.z = v1.x; tv.w = v1.y; outacc[dt][qt] = mfma16(__builtin_bit_cast(bf16x8, tv), pf, outacc[dt][qt]); } }
#pragma unroll
            for (int dt = 0; dt < 4; ++dt) outacc[dt][qt] = outacc[dt][qt] * g0[qt];
        }
        __syncthreads();
        if (tid < 64) { unsigned mask;
            if (i <= 3) mask = (1u << (i + 1)) - 1u;
            else { float v1 = -1.f, v2 = -1.f; int n1 = 0, n2 = 0;
                for (int n = 1; n < i; ++n) { const float v = ((imp4[(0 * 64 + tid) * 33 + n] + imp4[(1 * 64 + tid) * 33 + n]) + imp4[(2 * 64 + tid) * 33 + n]) + imp4[(3 * 64 + tid) * 33 + n];
                    if (v > v1) { v2 = v1; n2 = n1; v1 = v; n1 = n; } else if (v > v2) { v2 = v; n2 = n; } }
                mask = 1u | (1u << i) | (1u << n1) | (1u << n2); }
            selm[tid] = mask; }
        __syncthreads();
        unsigned sm[2];
#pragma unroll
        for (int qt = 0; qt < 2; ++qt) sm[qt] = selm[qh * 32 + qt * 16 + fr];
#pragma unroll
        for (int br = 0; br < 2; ++br) {
            const bf16_t* Kg = (br == 0 ? KS : KW) + (size_t)bg * 131072; const bf16_t* Vg = (br == 0 ? VST : VWT) + (size_t)bg * 131072;
            const int n0 = (br == 0) ? 0 : (i >= 4 ? i - 4 : 0), npair = (i - n0 + 2) >> 1;
            f32x4 O[4][2]; float lrun[2] = {0.f, 0.f};
#pragma unroll
            for (int dt = 0; dt < 4; ++dt)
#pragma unroll
                for (int qt = 0; qt < 2; ++qt) O[dt][qt] = (f32x4){0.f, 0.f, 0.f, 0.f};
            const int lrow = tid >> 3, lcc = tid & 7;
            u32x4 kx[2], vx[2];
#pragma unroll
            for (int h = 0; h < 2; ++h) { const int nn = (n0 + h <= i) ? n0 + h : i; kx[h] = *(const u32x4*)(Kg + ((size_t)nn * 64 + lrow) * 64 + lcc * 8); vx[h] = *(const u32x4*)(Vg + (size_t)lrow * 2048 + nn * 64 + lcc * 8); }
            __syncthreads();
#pragma unroll
            for (int h = 0; h < 2; ++h) { *(LAS u32x4*)(KV0 + h * 9216 + lrow * 72 + lcc * 8) = kx[h]; *(LAS u32x4*)(KV0 + h * 9216 + 4608 + lrow * 72 + lcc * 8) = vx[h]; }
            __syncthreads();
#pragma unroll 1
            for (int pi = 0; pi < npair; ++pi) {
                LAS bf16_t* Tc = (pi & 1) ? Qs : KV0; LAS bf16_t* Tn = (pi & 1) ? KV0 : Qs;
                const int na = n0 + 2 * pi;
                if (pi + 1 < npair) {
#pragma unroll
                    for (int h = 0; h < 2; ++h) { const int nn = (na + 2 + h <= i) ? na + 2 + h : i; kx[h] = *(const u32x4*)(Kg + ((size_t)nn * 64 + lrow) * 64 + lcc * 8); vx[h] = *(const u32x4*)(Vg + (size_t)lrow * 2048 + nn * 64 + lcc * 8); } }
                bf16x8 pf[2][2][2]; bool act[2][2];
#pragma unroll
                for (int h = 0; h < 2; ++h) {
                    const int n = na + h; const bool nvalid = (n <= i);
                    const bool edge = (n == i) || (br == 1 && n == i - 4);
                    LAS bf16_t* Kt = Tc + h * 9216;
#pragma unroll
                    for (int qt = 0; qt < 2; ++qt) {
                        const bool bsel = nvalid && ((br == 1) || ((sm[qt] >> n) & 1u));
                        act[h][qt] = nvalid && ((br == 1) || (__ballot(bsel) != 0ull));
                        pf[h][0][qt] = (bf16x8){0, 0, 0, 0, 0, 0, 0, 0}; pf[h][1][qt] = pf[h][0][qt];
                        if (act[h][qt]) {
                            const float sb = bsel ? slope2 * (float)(n * 64 + fq * 4 - tq[qt]) : -1e9f;
                            f32x4 S[4];
#pragma unroll
                            for (int kt = 0; kt < 4; ++kt) { S[kt] = (f32x4){sb + sc16[kt * 4], sb + sc16[kt * 4 + 1], sb + sc16[kt * 4 + 2], sb + sc16[kt * 4 + 3]};
#pragma unroll
                                for (int ks = 0; ks < 2; ++ks) { const bf16x8 kf = *(const LAS bf16x8*)(Kt + (kt * 16 + fr) * 72 + ks * 32 + fq * 8); S[kt] = mfma16(kf, Qf[qt][ks], S[kt]); } }
                            float ls = 0.f;
                            if (edge) {
#pragma unroll
                                for (int kt = 0; kt < 4; ++kt)
#pragma unroll
                                    for (int j = 0; j < 4; ++j) { const int pos = n * 64 + kt * 16 + fq * 4 + j; const bool valid = (pos <= tq[qt]) && (br == 0 || pos > tq[qt] - 256);
                                        const float pv = valid ? __builtin_amdgcn_exp2f(S[kt][j]) : 0.f; S[kt][j] = pv; ls += pv; }
                            } else {
#pragma unroll
                                for (int kt = 0; kt < 4; ++kt)
#pragma unroll
                                    for (int j = 0; j < 4; ++j) { const float pv = __builtin_amdgcn_exp2f(S[kt][j]); S[kt][j] = pv; ls += pv; }
                            }
                            lrun[qt] += ls;
#pragma unroll
                            for (int s = 0; s < 2; ++s) { u32x4 t; t.x = pk2(S[2 * s][0], S[2 * s][1]); t.y = pk2(S[2 * s][2], S[2 * s][3]); t.z = pk2(S[2 * s + 1][0], S[2 * s + 1][1]); t.w = pk2(S[2 * s + 1][2], S[2 * s + 1][3]); pf[h][s][qt] = __builtin_bit_cast(bf16x8, t); }
                        }
                    }
                }
#pragma unroll
                for (int h = 0; h < 2; ++h) {
                    LAS bf16_t* VtT = Tc + h * 9216 + 4608;
                    if (act[h][0] || act[h][1]) {
#pragma unroll
                        for (int s = 0; s < 2; ++s)
#pragma unroll
                            for (int dt = 0; dt < 4; ++dt) { u32x4 t; const u32x2 v0 = *(const LAS u32x2*)(VtT + (dt * 16 + fr) * 72 + s * 32 + fq * 4), v1 = *(const LAS u32x2*)(VtT + (dt * 16 + fr) * 72 + s * 32 + 16 + fq * 4);
                                t.x = v0.x; t.y = v0.y; t.z = v1.x; t.w = v1.y; const bf16x8 vf = __builtin_bit_cast(bf16x8, t);
#pragma unroll
                                for (int qt = 0; qt < 2; ++qt) if (act[h][qt]) O[dt][qt] = mfma16(vf, pf[h][s][qt], O[dt][qt]); } }
                }
                if (pi + 1 < npair) {
#pragma unroll
                    for (int h = 0; h < 2; ++h) { *(LAS u32x4*)(Tn + h * 9216 + lrow * 72 + lcc * 8) = kx[h]; *(LAS u32x4*)(Tn + h * 9216 + 4608 + lrow * 72 + lcc * 8) = vx[h]; } }
                __syncthreads();
            }
#pragma unroll
            for (int qt = 0; qt < 2; ++qt) { float l = lrun[qt]; l += __shfl_xor(l, 16); l += __shfl_xor(l, 32); const float sc = (br == 0 ? g1[qt] : g2[qt]) / l;
#pragma unroll
                for (int dt = 0; dt < 4; ++dt) outacc[dt][qt] = outacc[dt][qt] + O[dt][qt] * sc; }
        }
#pragma unroll
        for (int qt = 0; qt < 2; ++qt)
#pragma unroll
            for (int dt = 0; dt < 4; ++dt) { u32x2 o; o.x = pk2(outacc[dt][qt][0], outacc[dt][qt][1]); o.y = pk2(outacc[dt][qt][2], outacc[dt][qt][3]);
                *(u32x2*)(AO + (tokb + qh * 32 + qt * 16 + fr) * 1024 + hd * 64 + dt * 16 + fq * 4) = o; }
        __syncthreads();
    }
}

DI void weight_prep(const int tid, LAS unsigned char* lds, const P& p, int G, int c, bool late) {
    unsigned char* ws = p.ws;
    {
        const int nu[13] = {224, 64, 4, 176, 64, 32, 32, 4, 4, 352, 352, 176, 176};
        int total = 0;
#pragma unroll
        for (int m = 0; m < 13; ++m) total += nu[m];
        const int u_lo = late ? nu[0] : 0, u_hi = late ? total : nu[0];
        for (int gu = u_lo + c; gu < u_hi; gu += G) {
            int m = 0, u = gu;
#pragma unroll
            for (int q = 0; q < 12; ++q) if (m == q && u >= nu[q]) { u -= nu[q]; m = q + 1; }
            const float* s; bf16_t* d; int K, N; bool perm = false;
            switch (m) {
            case 0: s = p.in[1]; d = (bf16_t*)(ws + W_AB_IN); K = 1024; N = AB_IN; break;
            case 1: s = p.in[2]; d = (bf16_t*)(ws + W_AB_OUT); K = 1024; N = 1024; break;
            case 2: s = p.in[11]; d = (bf16_t*)(ws + W_GLU); K = 256; N = 256; break;
            case 3: s = p.in[17]; d = (bf16_t*)(ws + W_NSA_IN); K = 1024; N = NSA_IN; break;
            case 4: s = p.in[18]; d = (bf16_t*)(ws + W_NSA_OUT); K = 1024; N = 1024; break;
            case 5: s = p.in[21]; d = (bf16_t*)(ws + W_KW1); K = 2048; N = 256; break;
            case 6: s = p.in[24]; d = (bf16_t*)(ws + W_VW1); K = 2048; N = 256; break;
            case 7: s = p.in[23]; d = (bf16_t*)(ws + W_KW2); K = 256; N = 64; break;
            case 8: s = p.in[26]; d = (bf16_t*)(ws + W_VW2); K = 256; N = 64; break;
            case 9: s = p.in[27]; d = (bf16_t*)(ws + W_FFN_IN); K = 1024; N = FF2; perm = true; break;
            case 10: s = p.in[27] + (size_t)1024 * FF2; d = (bf16_t*)(ws + W_FFN_IN) + (size_t)FF2 * 1024; K = 1024; N = FF2; perm = true; break;
            case 11: s = p.in[30]; d = (bf16_t*)(ws + W_FFN_OUT); K = FFH; N = 1024; break;
            default: s = p.in[30] + (size_t)FFH * 1024; d = (bf16_t*)(ws + W_FFN_OUT) + (size_t)1024 * FFH; K = FFH; N = 1024; break;
            }
            prep_unit(tid, lds, s, d, K, N, u, perm);
        }
    }
}
DI void prologue_phase(const int tid, LAS unsigned char* lds, const P& p, int G, int c) {
    unsigned char* ws = p.ws;
    weight_prep(tid, lds, p, G, c, false);
    if (c == G - 1) {
        float* abar = (float*)(ws + W_S5AB); float* bbar = (float*)(ws + W_S5BB); bf16_t* ccat = (bf16_t*)(ws + W_S5CC);
        for (int idx = tid; idx < 1024; idx += 512) { const int g = idx >> 6;
            const float step = expf(p.in[5][g]), lr = p.in[3][idx], li = p.in[4][idx];
            const float mag = expf(lr * step), are = mag * cosf(li * step), aim = mag * sinf(li * step);
            const float den = lr * lr + li * li, nre = are - 1.f, nim = aim;
            const float zre = (nre * lr + nim * li) / den, zim = (nim * lr - nre * li) / den;
            abar[idx * 2] = are; abar[idx * 2 + 1] = aim;
            for (int h = 0; h < 16; ++h) { const float br = p.in[6][idx * 16 + h], bi = p.in[7][idx * 16 + h]; bbar[idx * 32 + h] = zre * br - zim * bi; bbar[idx * 32 + 16 + h] = zre * bi + zim * br; } }
        for (int idx = tid; idx < 16 * 16 * 128; idx += 512) { const int k = idx & 127, gh = idx >> 7;
            ccat[idx] = f2bf(k < 64 ? p.in[8][gh * 64 + k] : p.in[9][gh * 64 + k - 64]); }
        if (tid < 64) ((unsigned*)(ws + W_CTR))[tid] = 0u;
    }
    if (c < 32) {
        const int kv = c >> 4, sl = c & 15, n = tid & 255, hf = tid >> 8; const float* pe = p.in[kv ? 20 : 19]; const float* w1 = p.in[kv ? 24 : 21];
        float wv[64];
#pragma unroll
        for (int k = 0; k < 64; ++k) wv[k] = w1[(size_t)(sl * 128 + hf * 64 + k) * 256 + n];
        float acc = 0.f;
#pragma unroll
        for (int k = 0; k < 64; ++k) acc += pe[sl * 128 + hf * 64 + k] * wv[k];
        ((float*)(ws + W_B1PART))[((kv * 16 + sl) * 2 + hf) * 256 + n] = acc;
    }
    rms_phase(tid, p.in[0], p.in[31], (bf16_t*)(ws + A_HN), G, c);
}

#define XB_TMO      128
#define XB_XCNT(j)  (256  + 64 * (j))
#define XB_XSUB(j)  (1280 + 64 * (j))
#define XB_XGEN(j)  (2304 + 64 * (j))
#define XB_TOP      3328
#define XB_TOPGEN   3392
#define XCD_BAR_WORDS 3456
#define XB_SPIN_CAP (1u << 20)
DI unsigned xb_ld(unsigned* p)              { return __hip_atomic_load(p, __ATOMIC_RELAXED, __HIP_MEMORY_SCOPE_AGENT); }
DI unsigned xb_add(unsigned* p, unsigned v) { return __hip_atomic_fetch_add(p, v, __ATOMIC_RELAXED, __HIP_MEMORY_SCOPE_AGENT); }
DI unsigned xb_xcc_id() { return (unsigned)__builtin_amdgcn_s_getreg((3 << 11) | 20) & 0xFu; }
#define XB_SPIN(cond, bar) do { unsigned _sp = 0; while (cond) { __builtin_amdgcn_s_sleep(1); \
    if ((++_sp & 255u) == 0u) { if (xb_ld(&(bar)[XB_TMO])) break; if (_sp > XB_SPIN_CAP) { atomicAdd(&(bar)[XB_TMO], 1u); break; } } } } while (0)
struct XcdBarrier { unsigned* bar; unsigned x; volatile LAS unsigned* st; };
DI XcdBarrier xcd_barrier_post(unsigned* bar, volatile LAS unsigned* st) {
    XcdBarrier b; b.bar = bar; b.x = xb_xcc_id(); b.st = st;
    if (threadIdx.x == 0) (void)xb_add(&bar[XB_XCNT(b.x)], 1u);
    return b;
}
DI void xcd_barrier_complete(unsigned* bar, unsigned x, unsigned& nloc, unsigned& nx) {
    const unsigned G = gridDim.x * gridDim.y * gridDim.z;
    unsigned sum, cnt, mine, sp = 0u;
    for (;;) {
        sum = 0u; cnt = 0u; mine = 0u;
#pragma unroll
        for (unsigned j = 0; j < 16; ++j) { const unsigned c = xb_ld(&bar[XB_XCNT(j)]); sum += c; cnt += (c > 0u) ? 1u : 0u; mine = (j == x) ? c : mine; }
        if (sum == G) break;
        __builtin_amdgcn_s_sleep(1);
        if ((++sp & 255u) == 0u) { if (xb_ld(&bar[XB_TMO])) break; if (sp > XB_SPIN_CAP) { atomicAdd(&bar[XB_TMO], 1u); break; } }
    }
    nloc = mine > 0u ? mine : 1u; nx = cnt > 0u ? cnt : 1u;
}
DI void xcd_barrier(const XcdBarrier& b) {
    asm volatile("s_waitcnt vmcnt(0)" ::: "memory");
    __syncthreads();
    if (threadIdx.x == 0) {
        unsigned* bar = b.bar;
        __builtin_amdgcn_s_waitcnt(0);
        unsigned nloc = b.st[0], nx = b.st[1];
        if (nloc == 0u) { xcd_barrier_complete(bar, b.x, nloc, nx); b.st[0] = nloc; b.st[1] = nx; }
        const unsigned old = xb_add(&bar[XB_XSUB(b.x)], 1u);
        const unsigned gen = old / nloc;
        if (old + 1u == (gen + 1u) * nloc) {
            __builtin_amdgcn_fence(__ATOMIC_RELEASE, "agent");
            asm volatile("s_waitcnt vmcnt(0)" ::: "memory");
            const unsigned og = xb_add(&bar[XB_TOP], 1u);
            const unsigned tg = og / nx;
            if (og + 1u == (tg + 1u) * nx) xb_add(&bar[XB_TOPGEN], 1u);
            else XB_SPIN(xb_ld(&bar[XB_TOPGEN]) == tg, bar);
            __builtin_amdgcn_fence(__ATOMIC_ACQUIRE, "agent");
            xb_add(&bar[XB_XGEN(b.x)], 1u);
            asm volatile("s_waitcnt vmcnt(0)" ::: "memory");
        } else {
            XB_SPIN(xb_ld(&bar[XB_XGEN(b.x)]) == gen, bar);
            __builtin_amdgcn_fence(__ATOMIC_ACQUIRE, "agent");
            asm volatile("s_waitcnt vmcnt(0)" ::: "memory");
        }
    }
    __syncthreads();
}

constexpr int EXTRA_SEAMS = 0;
constexpr bool DUP_BARRIER = false;
constexpr bool FUSE_RMS_TAIL = false;
constexpr int SUBDUP = 0;
constexpr unsigned DUP_MASK = 0u;
__global__ void __launch_bounds__(512, 2) mega(P p, int ph_lo, int ph_hi, unsigned ph_mask) {
    extern __shared__ __attribute__((aligned(16))) unsigned char lds_raw[];
    LAS unsigned char* lds = (LAS unsigned char*)lds_raw;
    cg::grid_group grid = cg::this_grid();
    const int G = gridDim.x, c = blockIdx.x;
    unsigned char* ws = p.ws;
    volatile LAS unsigned* xbst = (volatile LAS unsigned*)(lds + LDS_BYTES - 16);
    if (threadIdx.x < 4) xbst[threadIdx.x] = 0u;
    __syncthreads();
    const XcdBarrier xbar = xcd_barrier_post((unsigned*)(ws + W_BAR), xbst);
    if (ph_lo > 1000) grid.sync();
#pragma unroll 1
    for (int ph2 = ph_lo * 2; ph2 < ph_hi * 2; ++ph2) {
        const int ph = ph2 >> 1;
        if (ph == 9 || ph == 10 || ph == 21 || ph == 22) continue;
        if (FUSE_RMS_TAIL && (ph == 6 || ph == 12 || ph == 18 || ph == 24)) continue;
        if ((ph2 & 1) && !((DUP_MASK >> ph) & 1u)) continue;
        if (ph2 & 1) __syncthreads();
        int tid = threadIdx.x; asm volatile("" : "+v"(tid));
        int kind = ph, layer = 0, sub = 0;
        if (ph >= 6 && ph <= 11) { kind = 100; layer = 0; sub = ph - 6; }
        if (ph >= 18 && ph <= 23) { kind = 100; layer = 1; sub = ph - 18; }
        if (kind == 100) kind = (sub == 0) ? 100 : (sub == 5) ? 103 : (sub & 1) ? 101 : 102;
        const int half = (sub - 1) >> 1;
        bool gdirect = false; const float* tail_g = nullptr; bf16_t* tail_dst = nullptr; bool tail = false;
        bool is_gemm = false; const bf16_t* gA = nullptr; const bf16_t* gB = nullptr; int lda = 0, ldb = 0, gM = 0, gN = 0, gK = 0, gG = G, gc = c;
        Epi E{};
        if (!((ph_mask >> ph) & 1u)) kind = -1;
        switch (kind) {
        case 0: prologue_phase(tid, lds, p, G, c); break;
        case 1: {
            is_gemm = true; E.kind = EK_ABIN; E.d0 = (bf16_t*)(ws + A_US5); E.d1 = (bf16_t*)(ws + A_QKV); E.d2 = (bf16_t*)(ws + A_Z); E.f0 = (float*)(ws + A_BLAL);
            gA = (const bf16_t*)(ws + A_HN); lda = 1024; gB = (const bf16_t*)(ws + W_AB_IN); ldb = 1024; gM = MTOK; gN = AB_IN_P; gK = 1024; } break;
        case 2: for (int rp = 0; rp < ((SUBDUP & 1) ? 2 : 1); ++rp) { s5_pass<false>(tid, lds, p, G, c); __syncthreads(); }
                for (int rp = 0; rp < ((SUBDUP & 2) ? 2 : 1); ++rp) { gdn_prep_phase(tid, lds, p, G, c); __syncthreads(); } break;
        case 3: if (c == G - 1) { const int t = tid; const int kv = t >> 8, n = t & 255; float a = p.in[kv ? 25 : 22][n];
                    for (int s = 0; s < 32; ++s) a += ((const float*)(ws + W_B1PART))[(kv * 32 + s) * 256 + n];
                    ((float*)(ws + W_B1P))[kv * 256 + n] = a; }
                if (G > 192) { if (c >= 192) weight_prep(tid, lds, p, G - 192, c - 192, true); } else weight_prep(tid, lds, p, G, c, true);
                __syncthreads();
                for (int rp = 0; rp < ((SUBDUP & 4) ? 2 : 1); ++rp) { gdn_seq_phase(tid, lds, p, G, c); __syncthreads(); }
                for (int rp = 0; rp < ((SUBDUP & 8) ? 2 : 1); ++rp) { s5_pass<true>(tid, lds, p, G, (c + G - 192 % G) % G); __syncthreads(); } break;
        case 4: is_gemm = true; E.kind = EK_GLU; E.cb0 = (const bf16_t*)(ws + A_ZS5); E.cf0 = p.in[12]; E.d0 = (bf16_t*)(ws + A_YCAT);
            gA = (const bf16_t*)(ws + A_ZS5); lda = 256; gB = (const bf16_t*)(ws + W_GLU); ldb = 256; gM = MTOK; gN = 256; gK = 256; break;
        case 5: is_gemm = true; E.kind = EK_RESID; E.cf0 = p.in[0]; E.f0 = p.out; gdirect = FUSE_RMS_TAIL; tail = FUSE_RMS_TAIL; tail_g = p.in[32]; tail_dst = (bf16_t*)(ws + F_HN);
            gA = (const bf16_t*)(ws + A_YCAT); lda = 1024; gB = (const bf16_t*)(ws + W_AB_OUT); ldb = 1024; gM = MTOK; gN = 1024; gK = 1024; break;
        case 12: rms_phase(tid, p.out, p.in[31] + 1024, (bf16_t*)(ws + N_HN), G, c); break;
        case 13: is_gemm = true; E.kind = EK_NSAIN; E.d0 = (bf16_t*)(ws + N_Q); E.d1 = (bf16_t*)(ws + N_KC); E.f0 = (float*)(ws + N_GATES);
            gA = (const bf16_t*)(ws + N_HN); lda = 1024; gB = (const bf16_t*)(ws + W_NSA_IN); ldb = 1024; gM = MTOK; gN = NSA_IN_P; gK = 1024; break;
        case 14: { const int kv = (c >= G / 2); is_gemm = true; E.kind = EK_CMP1; E.d0 = (bf16_t*)(ws + (kv ? N_H1V : N_H1K)); E.cf0 = (const float*)(ws + W_B1P) + kv * 256;
            gA = (const bf16_t*)(ws + (kv ? N_VC : N_KC)); lda = 1024; gB = (const bf16_t*)(ws + (kv ? W_VW1 : W_KW1)); ldb = 2048; gM = 16384; gN = 256; gK = 2048; gG = G / 2; gc = kv ? c - G / 2 : c; } break;
        case 15: { const int kv = (c >= G / 2); is_gemm = true; E.kind = EK_CMP2; E.flag = kv; E.d0 = (bf16_t*)(ws + (kv ? N_VCMPT : N_KCMP));
            gA = (const bf16_t*)(ws + (kv ? N_H1V : N_H1K)); lda = 256; gB = (const bf16_t*)(ws + (kv ? W_VW2 : W_KW2)); ldb = 256; gM = 16384; gN = 256; gK = 256; gG = G / 2; gc = kv ? c - G / 2 : c; } break;
        case 16: nsa_attn_phase(tid, lds, p, G, c); break;
        case 17: is_gemm = true; E.kind = EK_RESID; E.cf0 = p.out; E.f0 = p.out; gdirect = FUSE_RMS_TAIL; tail = FUSE_RMS_TAIL; tail_g = p.in[32] + 1024; tail_dst = (bf16_t*)(ws + F_HN);
            gA = (const bf16_t*)(ws + N_AO); lda = 1024; gB = (const bf16_t*)(ws + W_NSA_OUT); ldb = 1024; gM = MTOK; gN = 1024; gK = 1024; break;
        case 100: rms_phase(tid, p.out, p.in[32] + layer * 1024, (bf16_t*)(ws + F_HN), G, c); break;
        case 101: is_gemm = true; E.kind = EK_FFNUP; E.d0 = (bf16_t*)(ws + F_ACT); E.f0 = (float*)(ws + F_HB); E.cf0 = p.in[28] + (size_t)layer * 3 * FF2; E.cf1 = p.in[29] + (size_t)layer * FF2;
            gA = (const bf16_t*)(ws + F_HN); lda = 1024; gB = (const bf16_t*)(ws + W_FFN_IN) + (size_t)layer * FF2 * 1024; ldb = 1024; gM = MTOK; gN = FF2; gK = 1024; break;
        case 102: ffn_fix_phase(tid, p, layer, G, c); break;
        case 103: is_gemm = true; E.kind = EK_RESID; E.cf0 = p.out; E.f0 = p.out; gdirect = FUSE_RMS_TAIL; tail = FUSE_RMS_TAIL; if (layer == 0) { tail_g = p.in[31] + 1024; tail_dst = (bf16_t*)(ws + N_HN); } else { tail_g = p.in[33]; tail_dst = nullptr; }
            gA = (const bf16_t*)(ws + F_ACT); lda = FFH; gB = (const bf16_t*)(ws + W_FFN_OUT) + (size_t)layer * 1024 * FFH; ldb = FFH; gM = MTOK; gN = 1024; gK = FFH; break;
        case 24: rms_final(tid, p.out, p.in[33], G, c); break;
        default: break;
        }
        if (is_gemm) pg8::gemm_phase(tid, lds, gA, lda, gB, ldb, gM, gN, gK, gG, gc, gdirect, E);
        if (tail) {
            asm volatile("s_waitcnt vmcnt(0)" ::: "memory"); __syncthreads();
            __builtin_amdgcn_fence(__ATOMIC_ACQUIRE, "agent"); asm volatile("s_waitcnt vmcnt(0)" ::: "memory");
            rms_owned(tid, p.out, tail_g, tail_dst, G, c);
        }
        if (!(ph2 & 1) && ((DUP_MASK >> ph) & 1u)) { if (DUP_BARRIER) xcd_barrier(xbar); continue; }
        for (int xs = 0; xs < ((ph == 0) ? EXTRA_SEAMS : 0); ++xs) xcd_barrier(xbar);
        if (ph + 1 < ph_hi) xcd_barrier(xbar);
    }
}
constexpr int N_PHASES = 25;

extern "C" void kernel_launch(void* const* d_in, const int* in_sizes, int n_in, void* d_out, int out_size, void* d_ws, size_t ws_size, hipStream_t stream) {
    static int grid = 0;
    if (grid == 0) {
        int dev = 0, cus = 0, per_cu = 0;
        hipGetDevice(&dev); hipDeviceGetAttribute(&cus, hipDeviceAttributeMultiprocessorCount, dev);
        if (hipFuncSetAttribute((const void*)mega, hipFuncAttributeMaxDynamicSharedMemorySize, LDS_BYTES) != hipSuccess) fprintf(stderr, "hipFuncSetAttribute failed\n");
        if (hipOccupancyMaxActiveBlocksPerMultiprocessor(&per_cu, (const void*)mega, 512, LDS_BYTES) != hipSuccess || per_cu < 1) { fprintf(stderr, "occupancy query: %d\n", per_cu); per_cu = 1; }
        (void)hipGetLastError();
        grid = cus;
        if (ws_size < 1024 * MiB) fprintf(stderr, "workspace too small: %zu\n", ws_size);
    }
    P p{};
    for (int i = 0; i < 34; ++i) p.in[i] = (const float*)d_in[i];
    p.out = (float*)d_out; p.ws = (unsigned char*)d_ws;
    int lo = 0, hi = N_PHASES; unsigned mask = 0xFFFFFFFFu;
    void* args[] = {&p, &lo, &hi, &mask};
    if (hipMemsetAsync((unsigned char*)d_ws + W_BAR, 0, XCD_BAR_WORDS * 4, stream) != hipSuccess) fprintf(stderr, "memset of barrier words failed\n");
    hipError_t e = hipLaunchCooperativeKernel((const void*)mega, dim3(grid), dim3(512), args, LDS_BYTES, stream);
    if (e != hipSuccess) fprintf(stderr, "cooperative launch failed: %s (grid %d)\n", hipGetErrorString(e), grid);
}
```

```cpp
#include <hip/hip_runtime.h>
#include <hip/hip_cooperative_groups.h>
#include <cstdio>
namespace cg = cooperative_groups;

#define LAS __attribute__((address_space(3)))
#define DI __device__ __forceinline__
typedef unsigned short bf16_t;
typedef short bf16x8 __attribute__((ext_vector_type(8)));
typedef short bf16x4 __attribute__((ext_vector_type(4)));
typedef float f32x4 __attribute__((ext_vector_type(4)));
typedef float f32x2 __attribute__((ext_vector_type(2)));
typedef unsigned u32x4 __attribute__((ext_vector_type(4)));
typedef unsigned u32x2 __attribute__((ext_vector_type(2)));

constexpr int MTOK = 65536, DM = 1024, SEQ = 2048, NB = 32;
constexpr int AB_IN = 3340, AB_IN_P = 3584, NSA_IN = 2608, NSA_IN_P = 2816, FF2 = 5632, FFH = 2816;
constexpr int LDS_BYTES = 147456;

constexpr size_t MiB = 1048576;
constexpr size_t W_AB_IN = 0;
constexpr size_t W_AB_OUT = W_AB_IN + (size_t)AB_IN_P * 1024 * 2;
constexpr size_t W_GLU = W_AB_OUT + 2 * MiB;
constexpr size_t W_NSA_IN = W_GLU + 131072;
constexpr size_t W_NSA_OUT = W_NSA_IN + (size_t)NSA_IN_P * 1024 * 2;
constexpr size_t W_KW1 = W_NSA_OUT + 2 * MiB;
constexpr size_t W_VW1 = W_KW1 + MiB;
constexpr size_t W_KW2 = W_VW1 + MiB;
constexpr size_t W_VW2 = W_KW2 + 131072;
constexpr size_t W_FFN_IN = W_VW2 + 131072;
constexpr size_t W_FFN_OUT = W_FFN_IN + 2 * (size_t)FF2 * 1024 * 2;
constexpr size_t W_S5AB = W_FFN_OUT + 2 * (size_t)1024 * FFH * 2;
constexpr size_t W_S5BB = W_S5AB + 8192;
constexpr size_t W_S5CC = W_S5BB + 131072;
constexpr size_t W_B1P = W_S5CC + 65536;
constexpr size_t W_B1PART = W_B1P + 2048;
constexpr size_t W_CTR = W_B1PART + 65536;
constexpr size_t W_BAR = W_CTR + 4096;
constexpr size_t W_END = W_BAR + 16384;
static_assert(W_END <= 64 * MiB, "weights region");
constexpr size_t ACT = 64 * MiB;
constexpr size_t A_QKV = ACT;
constexpr size_t A_YCAT = ACT;
constexpr size_t A_Z = A_QKV + 288 * MiB;
constexpr size_t A_US5 = A_Z + 96 * MiB;
constexpr size_t A_ZS5 = A_US5 + 32 * MiB;
constexpr size_t A_BLAL = A_ZS5 + 32 * MiB;
constexpr size_t A_S5END = A_BLAL + 4 * MiB;
constexpr size_t A_CHUNK = A_S5END + 2 * MiB;
constexpr size_t A_HN = A_CHUNK;
constexpr size_t CH_U = A_CHUNK, CH_W = CH_U + 96 * MiB, CH_QD = CH_W + 96 * MiB, CH_KDT = CH_QD + 96 * MiB, CH_INTRA = CH_KDT + 96 * MiB, CH_GL = CH_INTRA + 48 * MiB;
static_assert(CH_GL + MiB <= 1024 * MiB, "ws");
constexpr size_t F_HN = ACT;
constexpr size_t F_UP = F_HN + 128 * MiB;
constexpr size_t F_HB = F_UP;
constexpr size_t F_ACT = F_UP + 352 * MiB;
static_assert(F_ACT + 352 * MiB <= 1024 * MiB, "ws");
constexpr size_t N_HN = ACT;
constexpr size_t N_Q = N_HN + 128 * MiB;
constexpr size_t N_KC = N_Q + 128 * MiB;
constexpr size_t N_VC = N_KC + 32 * MiB;
constexpr size_t N_KS = N_VC + 32 * MiB;
constexpr size_t N_VST = N_KS + 32 * MiB;
constexpr size_t N_KW = N_VST + 32 * MiB;
constexpr size_t N_VWT = N_KW + 32 * MiB;
constexpr size_t N_GATES = N_VWT + 32 * MiB;
constexpr size_t N_H1K = N_GATES + 12 * MiB;
constexpr size_t N_H1V = N_H1K + 8 * MiB;
constexpr size_t N_KCMP = N_H1V + 8 * MiB;
constexpr size_t N_VCMPT = N_KCMP + 2 * MiB;
constexpr size_t N_AO = N_VCMPT + 2 * MiB;

struct P { const float* in[34]; float* out; unsigned char* ws; };

DI float bf2f(bf16_t b) { return __uint_as_float(((unsigned)b) << 16); }
DI bf16_t f2bf(float f) { return __builtin_bit_cast(bf16_t, (__bf16)f); }
typedef __bf16 bf16v2_t __attribute__((ext_vector_type(2)));
DI unsigned pk2(float lo, float hi) { bf16v2_t v; v.x = (__bf16)lo; v.y = (__bf16)hi; return __builtin_bit_cast(unsigned, v); }
DI float lo16(unsigned u) { return __uint_as_float(u << 16); }
DI float hi16(unsigned u) { return __uint_as_float(u & 0xffff0000u); }
DI float sigmoidf_(float x) { return 1.f / (1.f + __expf(-x)); }
DI float siluf_(float x) { return x / (1.f + __expf(-x)); }
DI float silu_fast(float x) { return x * __builtin_amdgcn_rcpf(1.f + __expf(-x)); }
DI float gelu_tanh(float x) { float u = 0.7978845608028654f * (x + 0.044715f * x * x * x); float e = __expf(2.f * u); float th = 1.f - 2.f / (e + 1.f); return 0.5f * x * (1.f + th); }
DI float wave_sum(float v) { for (int o = 32; o > 0; o >>= 1) v += __shfl_xor(v, o); return v; }
DI f32x4 mfma16(bf16x8 a, bf16x8 b, f32x4 c) { return __builtin_amdgcn_mfma_f32_16x16x32_bf16(a, b, c, 0, 0, 0); }
DI void lds_wait() { asm volatile("s_waitcnt lgkmcnt(0)" ::: "memory"); }

DI void st8bf(bf16_t* dst, f32x4 v0, f32x4 v1);
namespace pg8 {
constexpr int BM = 256, BK = 64, HALF = 128, HTB = HALF * BK * 2, STAGE_BYTES = 8 * HTB, NXCD = 8, WGM = 8;
DI int lds_byte(int r, int c) { const int st = (r >> 4) * 2 + (c >> 5), rr = r & 15, cc = c & 31, ob = rr * 64 + cc * 2; return st * 1024 + (ob ^ (((ob >> 9) & 1) << 5)); }
DI void stage_rc(int b, int& R, int& C) { const int st = b / 1024, sb = b % 1024, swz = sb ^ (((sb >> 9) & 1) << 5); R = (st >> 1) * 16 + swz / 64; C = (st & 1) * 32 + (swz % 64) / 2; }
DI int perm32(int rho) { const int n = rho >> 4, i = rho & 15; return 8 * (i >> 2) + 4 * n + (i & 3); }
struct Unit { int pm, pn; };
struct Order {
    int nM, nN, nwg, G, c; bool direct;
    DI void init(int M, int N, int G_, int c_, bool d_) { nM = M / BM; nN = N / BM; nwg = nM * nN; G = G_; c = c_; direct = d_; }
    DI bool next(int i, Unit& u) const {
        if (direct) { const int pm = c + (i / nN) * G; if (pm >= nM) return false; u.pm = pm; u.pn = i % nN; return true; }
        const long L = (long)i * G + c; if (L >= nwg) return false;
        int wgid = (int)L; { const int q = nwg / NXCD, r = nwg % NXCD, xcd = wgid % NXCD, off = wgid / NXCD; wgid = (xcd < r ? xcd * (q + 1) : r * (q + 1) + (xcd - r) * q) + off; }
        const int nig = WGM * nN, gid = wgid / nig, fm = gid * WGM, gsz = (nM - fm) < WGM ? (nM - fm) : WGM;
        u.pm = fm + ((wgid % nig) % gsz); u.pn = (wgid % nig) / gsz; return true;
    }
};
template <class F>
DI void gemm_phase(const int tid, LAS unsigned char* lds, const bf16_t* Ap, int lda, const bf16_t* Bp, int ldb, int M, int N, int K, int G, int c, bool direct, const F& E) {
    const int wid = __builtin_amdgcn_readfirstlane(tid >> 6), lane = tid & 63, wr = wid >> 2, wc = wid & 3, fr = lane & 15, fq = lane >> 4;
    const int nt = K / BK;
    Order S; S.init(M, N, G, c, direct);
    unsigned voffA[2], voffB[2];
#pragma unroll
    for (int i = 0; i < 2; ++i) { int R, C; stage_rc(tid * 16 + i * 8192, R, C); const int Rb = (R & ~31) + perm32(R & 31);
        voffA[i] = (unsigned)(R * lda + C) * 2u; voffB[i] = (unsigned)(Rb * ldb + C) * 2u; }
    const size_t kstep = (size_t)(BK * 2);
    const size_t hsA = (size_t)HALF * lda * 2, hsB = (size_t)HALF * ldb * 2;
    const size_t tsA = 2 * hsA, tsB = 2 * hsB;
    const unsigned ldsw = (unsigned)wid * 1024u;
    const int aoff = lds_byte(wr * 64 + fr, fq * 8), boff = lds_byte(wc * 32 + fr, fq * 8);
#define PG8_SA(b, h) (((b) * 2 + (h)) * HTB)
#define PG8_SB(b, h) ((4 + (b) * 2 + (h)) * HTB)
#define PG8_STAGE(bufoff, gbase, voff) do { _Pragma("unroll") for (int _i = 0; _i < 2; ++_i) \
        __builtin_amdgcn_global_load_lds((const unsigned*)((const char*)(gbase) + (voff)[_i]), (LAS unsigned*)(lds + (bufoff) + ldsw + _i * 8192), 16, 0, 0); } while (0)
#define PG8_LDA(dst, b, h) do { _Pragma("unroll") for (int m = 0; m < 4; ++m) _Pragma("unroll") for (int k = 0; k < 2; ++k) dst[m][k] = *(const LAS bf16x8*)(lds + PG8_SA(b, h) + aoff + m * 2048 + k * 1024); } while (0)
#define PG8_LDB(dst, b, h) do { _Pragma("unroll") for (int n = 0; n < 2; ++n) _Pragma("unroll") for (int k = 0; k < 2; ++k) dst[n][k] = *(const LAS bf16x8*)(lds + PG8_SB(b, h) + boff + n * 2048 + k * 1024); } while (0)
#define PG8_MMA(ai, bj, At, Bt) do { __builtin_amdgcn_s_setprio(1); _Pragma("unroll") for (int m = 0; m < 4; ++m) _Pragma("unroll") for (int n = 0; n < 2; ++n) _Pragma("unroll") for (int k = 0; k < 2; ++k) \
        acc[ai][bj][m][n] = __builtin_amdgcn_mfma_f32_16x16x32_bf16(Bt[n][k], At[m][k], acc[ai][bj][m][n], 0, 0, 0); __builtin_amdgcn_s_setprio(0); } while (0)
#define PG8_WAIT_V(n) asm volatile("s_waitcnt vmcnt(" #n ")" ::: "memory")
#define PG8_WAIT_L(n) asm volatile("s_waitcnt lgkmcnt(" #n ")" ::: "memory")
#define PG8_BAR __builtin_amdgcn_s_barrier()
#define PG8_SCHED __builtin_amdgcn_sched_barrier(0)
    Unit cur, nxt; int ui = 0;
    if (!S.next(0, cur)) return;
    f32x4 acc[2][2][4][2];
#pragma unroll
    for (int a = 0; a < 2; ++a)
#pragma unroll
        for (int b = 0; b < 2; ++b)
#pragma unroll
            for (int m = 0; m < 4; ++m)
#pragma unroll
                for (int n = 0; n < 2; ++n) acc[a][b][m][n] = (f32x4){0.f, 0.f, 0.f, 0.f};
    bf16x8 At[4][2], B0[2][2], B1[2][2];
    const char* cA = (const char*)Ap + (size_t)cur.pm * tsA; const char* cB = (const char*)Bp + (size_t)cur.pn * tsB;
    PG8_STAGE(PG8_SB(0, 0), cB, voffB); PG8_STAGE(PG8_SA(0, 0), cA, voffA); PG8_STAGE(PG8_SB(0, 1), cB + hsB, voffB); PG8_STAGE(PG8_SA(0, 1), cA + hsA, voffA);
    if (wr == 1) PG8_BAR;
    PG8_WAIT_V(4); PG8_BAR;
    PG8_STAGE(PG8_SB(1, 0), cB + kstep, voffB); PG8_STAGE(PG8_SA(1, 0), cA + kstep, voffA); PG8_STAGE(PG8_SB(1, 1), cB + hsB + kstep, voffB);
    PG8_WAIT_V(6); PG8_BAR;
    for (;;) {
        const bool has_next = S.next(ui + 1, nxt);
        const char* nA = has_next ? (const char*)Ap + (size_t)nxt.pm * tsA : cA; const char* nB = has_next ? (const char*)Bp + (size_t)nxt.pn * tsB : cB;
        for (int t = 0; t < nt; t += 2) {
            const bool last = (t == nt - 2);
            const char* a1 = cA + (size_t)(t + 1) * kstep;
            const char* a2 = last ? nA : cA + (size_t)(t + 2) * kstep; const char* b2 = last ? nB : cB + (size_t)(t + 2) * kstep;
            const char* a3 = a2 + kstep; const char* b3 = b2 + kstep;
            PG8_LDB(B0, 0, 0); PG8_SCHED; PG8_LDA(At, 0, 0); PG8_STAGE(PG8_SA(1, 1), a1 + hsA, voffA);
            PG8_WAIT_L(8); PG8_BAR; PG8_WAIT_L(0); PG8_MMA(0, 0, At, B0); PG8_BAR; PG8_SCHED;
            PG8_LDB(B1, 0, 1); PG8_STAGE(PG8_SB(0, 0), b2, voffB);
            PG8_BAR; PG8_WAIT_L(0); PG8_MMA(0, 1, At, B1); PG8_BAR;
            PG8_LDA(At, 0, 1); PG8_STAGE(PG8_SA(0, 0), a2, voffA);
            PG8_BAR; PG8_WAIT_L(0); PG8_MMA(1, 0, At, B0); PG8_BAR; PG8_SCHED;
            PG8_STAGE(PG8_SB(0, 1), b2 + hsB, voffB);
            PG8_WAIT_V(6); PG8_BAR; PG8_MMA(1, 1, At, B1); PG8_BAR;
            PG8_LDB(B0, 1, 0); PG8_SCHED; PG8_LDA(At, 1, 0); PG8_STAGE(PG8_SA(0, 1), a2 + hsA, voffA);
            PG8_WAIT_L(8); PG8_BAR; PG8_WAIT_L(0); PG8_MMA(0, 0, At, B0); PG8_BAR; PG8_SCHED;
            PG8_LDB(B1, 1, 1); PG8_STAGE(PG8_SB(1, 0), b3, voffB);
            PG8_BAR; PG8_WAIT_L(0); PG8_MMA(0, 1, At, B1); PG8_BAR;
            PG8_LDA(At, 1, 1); PG8_STAGE(PG8_SA(1, 0), a3, voffA);
            PG8_BAR; PG8_WAIT_L(0); PG8_MMA(1, 0, At, B0); PG8_BAR; PG8_SCHED;
            PG8_STAGE(PG8_SB(1, 1), b3 + hsB, voffB);
            PG8_WAIT_V(6); PG8_BAR; PG8_MMA(1, 1, At, B1); PG8_BAR;
        }
        if (E.kind == 7  ) E.fused(acc, cur.pm, cur.pn, wr, wc, fr, fq);
        else if (E.kind == 3  ) {
            const int row0 = cur.pm * BM + wr * 64 + fr, col0 = cur.pn * BM + wc * 32 + 8 * fq;
            f32x4 b0[2], b1[2];
#pragma unroll
            for (int bj = 0; bj < 2; ++bj) { b0[bj] = *(const f32x4*)(E.cf0 + col0 + bj * HALF); b1[bj] = *(const f32x4*)(E.cf0 + col0 + bj * HALF + 4); }
#pragma unroll
            for (int ai = 0; ai < 2; ++ai) {
                u32x4 zz[4][2];
#pragma unroll
                for (int m = 0; m < 4; ++m)
#pragma unroll
                    for (int bj = 0; bj < 2; ++bj) zz[m][bj] = *(const u32x4*)(E.cb0 + (size_t)(row0 + ai * HALF + m * 16) * 256 + col0 + bj * HALF);
#pragma unroll
                for (int m = 0; m < 4; ++m)
#pragma unroll
                    for (int bj = 0; bj < 2; ++bj) { const f32x4 v0 = acc[ai][bj][m][0], v1 = acc[ai][bj][m][1]; const u32x4 z = zz[m][bj]; f32x4 o0, o1;
                        o0[0] = lo16(z.x) * sigmoidf_(v0[0] + b0[bj][0]); o0[1] = hi16(z.x) * sigmoidf_(v0[1] + b0[bj][1]); o0[2] = lo16(z.y) * sigmoidf_(v0[2] + b0[bj][2]); o0[3] = hi16(z.y) * sigmoidf_(v0[3] + b0[bj][3]);
                        o1[0] = lo16(z.z) * sigmoidf_(v1[0] + b1[bj][0]); o1[1] = hi16(z.z) * sigmoidf_(v1[1] + b1[bj][1]); o1[2] = lo16(z.w) * sigmoidf_(v1[2] + b1[bj][2]); o1[3] = hi16(z.w) * sigmoidf_(v1[3] + b1[bj][3]);
                        st8bf(E.d0 + (size_t)(row0 + ai * HALF + m * 16) * 1024 + col0 + bj * HALF, o0, o1); }
            }
        }
        else if (E.kind == 1  ) {
            const int row0 = cur.pm * BM + wr * 64 + fr, col0 = cur.pn * BM + wc * 32 + 8 * fq;
#pragma unroll
            for (int ai = 0; ai < 2; ++ai) {
                f32x4 r[4][2][2];
#pragma unroll
                for (int m = 0; m < 4; ++m)
#pragma unroll
                    for (int bj = 0; bj < 2; ++bj) { const size_t o = (size_t)(row0 + ai * HALF + m * 16) * 1024 + col0 + bj * HALF;
                        r[m][bj][0] = *(const f32x4*)(E.cf0 + o); r[m][bj][1] = *(const f32x4*)(E.cf0 + o + 4); }
#pragma unroll
                for (int m = 0; m < 4; ++m)
#pragma unroll
                    for (int bj = 0; bj < 2; ++bj) { const size_t o = (size_t)(row0 + ai * HALF + m * 16) * 1024 + col0 + bj * HALF;
                        *(f32x4*)(E.f0 + o) = r[m][bj][0] + acc[ai][bj][m][0]; *(f32x4*)(E.f0 + o + 4) = r[m][bj][1] + acc[ai][bj][m][1]; }
            }
        }
        else {
            const int row0 = cur.pm * BM + wr * 64 + fr, col0 = cur.pn * BM + wc * 32 + 8 * fq;
#pragma unroll
            for (int ai = 0; ai < 2; ++ai)
#pragma unroll
                for (int m = 0; m < 4; ++m)
#pragma unroll
                    for (int bj = 0; bj < 2; ++bj) E.st(row0 + ai * HALF + m * 16, col0 + bj * HALF, acc[ai][bj][m][0], acc[ai][bj][m][1]);
        }
        if (!has_next) break;
#pragma unroll
        for (int a = 0; a < 2; ++a)
#pragma unroll
            for (int b = 0; b < 2; ++b)
#pragma unroll
                for (int m = 0; m < 4; ++m)
#pragma unroll
                    for (int n = 0; n < 2; ++n) acc[a][b][m][n] = (f32x4){0.f, 0.f, 0.f, 0.f};
        cur = nxt; cA = nA; cB = nB; ++ui;
    }
    PG8_WAIT_V(0);
    if (wr == 0) PG8_BAR;
    PG8_BAR;
#undef PG8_SA
#undef PG8_SB
#undef PG8_STAGE
#undef PG8_LDA
#undef PG8_LDB
#undef PG8_MMA
#undef PG8_WAIT_V
#undef PG8_WAIT_L
#undef PG8_BAR
#undef PG8_SCHED
}
}

DI void st8bf(bf16_t* dst, f32x4 v0, f32x4 v1) { u32x4 w; w.x = pk2(v0[0], v0[1]); w.y = pk2(v0[2], v0[3]); w.z = pk2(v1[0], v1[1]); w.w = pk2(v1[2], v1[3]); *(u32x4*)dst = w; }

enum { EK_ABIN = 0, EK_RESID, EK_BF, EK_GLU, EK_NSAIN, EK_CMP1, EK_CMP2, EK_FFNUP };
struct Epi { int kind, ldc, flag, pad; bf16_t *d0, *d1, *d2; float* f0; const float* cf0; const float* cf1; const bf16_t* cb0;
    DI void st(int row, int col, f32x4 v0, f32x4 v1) const {
        switch (kind) {
        case EK_ABIN: {
            if (col < 256) st8bf(d0 + (size_t)row * 256 + col, v0, v1);
            else if (col < 2560) st8bf(d1 + (size_t)row * 2304 + (col - 256), v0, v1);
            else if (col < 3328) st8bf(d2 + (size_t)row * 768 + (col - 2560), v0, v1);
            else { const int cc = col - 3328; if (cc < 16) { float* d = f0 + (size_t)row * 16 + cc; *(f32x4*)d = v0; *(f32x4*)(d + 4) = v1; } } } break;
        case EK_RESID: {
            const size_t o = (size_t)row * 1024 + col; const f32x4 r0 = *(const f32x4*)(cf0 + o), r1 = *(const f32x4*)(cf0 + o + 4);
            *(f32x4*)(f0 + o) = r0 + v0; *(f32x4*)(f0 + o + 4) = r1 + v1; } break;
        case EK_BF: st8bf(d0 + (size_t)row * ldc + col, v0, v1); break;
        case EK_GLU: {
            const u32x4 zz = *(const u32x4*)(cb0 + (size_t)row * 256 + col); const f32x4 b0 = *(const f32x4*)(cf0 + col), b1 = *(const f32x4*)(cf0 + col + 4);
            f32x4 o0, o1;
            o0[0] = lo16(zz.x) * sigmoidf_(v0[0] + b0[0]); o0[1] = hi16(zz.x) * sigmoidf_(v0[1] + b0[1]); o0[2] = lo16(zz.y) * sigmoidf_(v0[2] + b0[2]); o0[3] = hi16(zz.y) * sigmoidf_(v0[3] + b0[3]);
            o1[0] = lo16(zz.z) * sigmoidf_(v1[0] + b1[0]); o1[1] = hi16(zz.z) * sigmoidf_(v1[1] + b1[1]); o1[2] = lo16(zz.w) * sigmoidf_(v1[2] + b1[2]); o1[3] = hi16(zz.w) * sigmoidf_(v1[3] + b1[3]);
            st8bf(d0 + (size_t)row * 1024 + col, o0, o1); } break;
        case EK_NSAIN: {
            if (col < 1024) { st8bf(d0 + (size_t)row * 1024 + col, v0 * 0.18033688011112042f, v1 * 0.18033688011112042f);   }
            else if (col < 2560) {
                const int cc0 = col - 1024, ts = cc0 >> 8, cc = cc0 & 255, g = cc >> 6, dd = cc & 63, b = row >> 11, t = row & 2047;
                bf16_t* base = d1 + (size_t)ts * (16 * MiB);
                if (ts == 3 || ts == 5) { bf16_t* d = base + ((size_t)(b * 4 + g) * 64 + dd) * 2048 + t;
#pragma unroll
                    for (int e = 0; e < 4; ++e) { d[(size_t)e * 2048] = f2bf(v0[e]); d[(size_t)(e + 4) * 2048] = f2bf(v1[e]); } }
                else st8bf(base + ((size_t)(b * 4 + g) * 2048 + t) * 64 + dd, v0, v1);
            } else { const int cc = col - 2560; if (cc < 48) { float* d = f0 + (size_t)row * 48 + cc;
#pragma unroll
                    for (int e = 0; e < 4; ++e) { d[e] = sigmoidf_(v0[e]); d[e + 4] = sigmoidf_(v1[e]); } } } } break;
        case EK_CMP1: {
            const f32x4 b0 = *(const f32x4*)(cf0 + col), b1 = *(const f32x4*)(cf0 + col + 4); f32x4 o0, o1;
#pragma unroll
            for (int e = 0; e < 4; ++e) { o0[e] = gelu_tanh(v0[e] + b0[e]); o1[e] = gelu_tanh(v1[e] + b1[e]); }
            st8bf(d0 + (size_t)row * 256 + col, o0, o1); } break;
        case EK_CMP2: {
            if (col < 64) {
                if (!flag) st8bf(d0 + (size_t)row * 64 + col, v0, v1);
                else { bf16_t* d = d0 + ((size_t)(row >> 7) * 64 + col) * 128 + (row & 127);
#pragma unroll
                    for (int e = 0; e < 4; ++e) { d[e * 128] = f2bf(v0[e]); d[(e + 4) * 128] = f2bf(v1[e]); } } } } break;
        default: break;
        }
    }
    DI void fused(const f32x4 (&acc)[2][2][4][2], int pm, int pn, int wr, int wc, int fr, int fq) const;
};

template <int CTRL> DI float dppf(float v) { return __builtin_bit_cast(float, __builtin_amdgcn_update_dpp(0, __builtin_bit_cast(int, v), CTRL, 0xf, 0xf, true)); }
DI void Epi::fused(const f32x4 (&acc)[2][2][4][2], int pm, int pn, int wr, int wc, int fr, int fq) const {
    const Epi& E = *this;
#pragma unroll
    for (int bj = 0; bj < 2; ++bj) {
        const int ncol = pn * 256 + bj * 128 + wc * 32 + 8 * fq, j0 = (ncol >> 3) * 4;
        const f32x4 wa0 = *(const f32x4*)(E.cf0 + j0), wa1 = *(const f32x4*)(E.cf0 + FF2 + j0), wa2 = *(const f32x4*)(E.cf0 + 2 * FF2 + j0);
        const f32x4 wb0 = *(const f32x4*)(E.cf0 + FFH + j0), wb1 = *(const f32x4*)(E.cf0 + FF2 + FFH + j0), wb2 = *(const f32x4*)(E.cf0 + 2 * FF2 + FFH + j0);
        const f32x4 ba = *(const f32x4*)(E.cf1 + j0), bb = *(const f32x4*)(E.cf1 + FFH + j0);
#pragma unroll
        for (int ai = 0; ai < 2; ++ai) {
            f32x4 pa = (f32x4){0.f, 0.f, 0.f, 0.f}, pb = pa;
#pragma unroll
            for (int m = 0; m < 4; ++m) {
                const f32x4 ca = acc[ai][bj][m][0], cb = acc[ai][bj][m][1];
                const int row = pm * 256 + ai * 128 + wr * 64 + m * 16 + fr;
                float o[4];
#pragma unroll
                for (int e = 0; e < 4; ++e) {
                    const float a1 = dppf<0x111>(ca[e]) + dppf<0x10F>(pa[e]), a2 = dppf<0x112>(ca[e]) + dppf<0x10E>(pa[e]);
                    const float b1 = dppf<0x111>(cb[e]) + dppf<0x10F>(pb[e]), b2 = dppf<0x112>(cb[e]) + dppf<0x10E>(pb[e]);
                    const float ya = fmaf(wa0[e], a2, fmaf(wa1[e], a1, fmaf(wa2[e], ca[e], ba[e])));
                    const float yb = fmaf(wb0[e], b2, fmaf(wb1[e], b1, fmaf(wb2[e], cb[e], bb[e])));
                    o[e] = silu_fast(ya) * yb; }
                if (m > 0 || fr >= 2) { u32x2 w; w.x = pk2(o[0], o[1]); w.y = pk2(o[2], o[3]); *(u32x2*)(E.d0 + (size_t)row * FFH + j0) = w; }
                if ((m == 0 && fr < 2) || (m == 3 && fr >= 14)) { float* hb = E.f0 + ((size_t)(row >> 6) * 4 + (m == 0 ? fr : fr - 12)) * FF2 + ncol; *(f32x4*)hb = ca; *(f32x4*)(hb + 4) = cb; }
                pa = ca; pb = cb;
            }
        }
    }
}
DI void ffn_fix_phase(const int tid, const P& p, int layer, int G, int c) {
    const float* hb = (const float*)(p.ws + F_HB); bf16_t* act = (bf16_t*)(p.ws + F_ACT);
    const float* cw = p.in[28] + (size_t)layer * 3 * FF2; const float* cbv = p.in[29] + (size_t)layer * FF2;
    const int nitems = 1024 * 2 * 704;
    for (int it = c * 512 + tid; it < nitems; it += G * 512) {
        const int q = it % 704, t = (it / 704) & 1, kb = it / 1408, j0 = q * 4, nc = q * 8;
        const bool first = (kb & 31) == 0;
        const float* r0 = hb + ((size_t)kb * 4 + t) * FF2 + nc;
        const float* r1 = (t == 1) ? hb + ((size_t)kb * 4 + 0) * FF2 + nc : hb + ((size_t)(kb - 1) * 4 + 3) * FF2 + nc;
        const float* r2 = (t == 1) ? hb + ((size_t)(kb - 1) * 4 + 3) * FF2 + nc : hb + ((size_t)(kb - 1) * 4 + 2) * FF2 + nc;
        const f32x4 z4 = (f32x4){0.f, 0.f, 0.f, 0.f};
        const f32x4 a0 = *(const f32x4*)r0, b0 = *(const f32x4*)(r0 + 4);
        const bool have1 = (t == 1) || !first, have2 = !first;
        const f32x4 a1 = have1 ? *(const f32x4*)r1 : z4, b1 = have1 ? *(const f32x4*)(r1 + 4) : z4;
        const f32x4 a2 = have2 ? *(const f32x4*)r2 : z4, b2 = have2 ? *(const f32x4*)(r2 + 4) : z4;
        const f32x4 wa0 = *(const f32x4*)(cw + j0), wa1 = *(const f32x4*)(cw + FF2 + j0), wa2 = *(const f32x4*)(cw + 2 * FF2 + j0);
        const f32x4 wb0 = *(const f32x4*)(cw + FFH + j0), wb1 = *(const f32x4*)(cw + FF2 + FFH + j0), wb2 = *(const f32x4*)(cw + 2 * FF2 + FFH + j0);
        const f32x4 ba = *(const f32x4*)(cbv + j0), bb = *(const f32x4*)(cbv + FFH + j0);
        float o[4];
#pragma unroll
        for (int e = 0; e < 4; ++e) { const float ya = fmaf(wa0[e], a2[e], fmaf(wa1[e], a1[e], fmaf(wa2[e], a0[e], ba[e]))), yb = fmaf(wb0[e], b2[e], fmaf(wb1[e], b1[e], fmaf(wb2[e], b0[e], bb[e]))); o[e] = silu_fast(ya) * yb; }
        u32x2 w; w.x = pk2(o[0], o[1]); w.y = pk2(o[2], o[3]);
        *(u32x2*)(act + ((size_t)kb * 64 + t) * FFH + j0) = w;
    }
}

DI void prep_unit(const int tid, LAS unsigned char* lds, const float* src, bf16_t* dst, int K, int N, int u, bool perm) {
    LAS float* tile = (LAS float*)lds;
    const int ntk = K / 64, tk = u % ntk, tn = u / ntk;
    { const int c4 = tid & 63, kb = tid >> 6, n = tn * 256 + c4 * 4, ns = perm ? (((n & 4) ? FFH : 0) + (n >> 3) * 4) : n;
      f32x4 v[8];
#pragma unroll
      for (int kk = 0; kk < 8; ++kk) { const int k = kb + kk * 8; v[kk] = (n < N) ? *(const f32x4*)(src + (size_t)(tk * 64 + k) * N + ns) : (f32x4){0.f, 0.f, 0.f, 0.f}; }
#pragma unroll
      for (int kk = 0; kk < 8; ++kk) *(LAS f32x4*)(tile + (kb + kk * 8) * 260 + c4 * 4) = v[kk]; }
    __syncthreads();
#pragma unroll
    for (int i = 0; i < 4; ++i) { const int pc = tid + i * 512, nl = pc & 255, k8 = pc >> 8;
        float t[8];
#pragma unroll
        for (int e = 0; e < 8; ++e) t[e] = tile[(k8 * 8 + e) * 260 + nl];
        u32x4 w; w.x = pk2(t[0], t[1]); w.y = pk2(t[2], t[3]); w.z = pk2(t[4], t[5]); w.w = pk2(t[6], t[7]);
        *(u32x4*)(dst + (size_t)(tn * 256 + nl) * K + tk * 64 + k8 * 8) = w; }
    __syncthreads();
}

template <bool TO_BF16>
DI void rms_rows(const int tid, const float* src, const float* gam, bf16_t* dst, float* fdst, int G, int c) {
    constexpr int NR = 8;
    const int wave = tid >> 6, lane = tid & 63;
    f32x4 g4[4];
#pragma unroll
    for (int k = 0; k < 4; ++k) g4[k] = *(const f32x4*)(gam + k * 256 + lane * 4);
    for (int r = (c * 8 + wave) * NR; r < MTOK; r += G * 8 * NR) {
        f32x4 v[NR][4]; float s[NR];
#pragma unroll
        for (int q = 0; q < NR; ++q)
#pragma unroll
            for (int k = 0; k < 4; ++k) v[q][k] = *(const f32x4*)(src + (size_t)(r + q) * 1024 + k * 256 + lane * 4);
#pragma unroll
        for (int q = 0; q < NR; ++q) { s[q] = 0.f;
#pragma unroll
            for (int k = 0; k < 4; ++k) s[q] += v[q][k][0] * v[q][k][0] + v[q][k][1] * v[q][k][1] + v[q][k][2] * v[q][k][2] + v[q][k][3] * v[q][k][3]; }
#pragma unroll
        for (int o = 32; o > 0; o >>= 1)
#pragma unroll
            for (int q = 0; q < NR; ++q) s[q] += __shfl_xor(s[q], o);
#pragma unroll
        for (int q = 0; q < NR; ++q) { const float sc = rsqrtf(s[q] * (1.f / 1024.f) + 1e-6f);
#pragma unroll
            for (int k = 0; k < 4; ++k) {
                if (TO_BF16) { u32x2 o; o.x = pk2(v[q][k][0] * sc * g4[k][0], v[q][k][1] * sc * g4[k][1]); o.y = pk2(v[q][k][2] * sc * g4[k][2], v[q][k][3] * sc * g4[k][3]);
                    *(u32x2*)(dst + (size_t)(r + q) * 1024 + k * 256 + lane * 4) = o; }
                else *(f32x4*)(fdst + (size_t)(r + q) * 1024 + k * 256 + lane * 4) = v[q][k] * sc * g4[k]; } }
    }
}
DI void rms_phase(const int tid, const float* src, const float* gam, bf16_t* dst, int G, int c) { rms_rows<true>(tid, src, gam, dst, nullptr, G, c); }
DI void rms_final(const int tid, float* io, const float* gam, int G, int c) { rms_rows<false>(tid, io, gam, nullptr, io, G, c); }
DI void rms_owned(const int tid, float* h, const float* gam, bf16_t* dst, int G, int c) {
    const int wave = tid >> 6, lane = tid & 63;
    for (int pm = c; pm < MTOK / 256; pm += G)
        for (int rr = 0; rr < 32; ++rr) {
            const int r = pm * 256 + wave * 32 + rr;
            float* p = h + (size_t)r * 1024; f32x4 v[4]; float ss = 0.f;
#pragma unroll
            for (int k = 0; k < 4; ++k) { v[k] = *(const f32x4*)(p + k * 256 + lane * 4); ss += v[k][0] * v[k][0] + v[k][1] * v[k][1] + v[k][2] * v[k][2] + v[k][3] * v[k][3]; }
            ss = wave_sum(ss); const float sc = rsqrtf(ss * (1.f / 1024.f) + 1e-6f);
#pragma unroll
            for (int k = 0; k < 4; ++k) { const f32x4 g4 = *(const f32x4*)(gam + k * 256 + lane * 4);
                if (dst) { u32x2 o; o.x = pk2(v[k][0] * sc * g4[0], v[k][1] * sc * g4[1]); o.y = pk2(v[k][2] * sc * g4[2], v[k][3] * sc * g4[3]); *(u32x2*)(dst + (size_t)r * 1024 + k * 256 + lane * 4) = o; }
                else *(f32x4*)(p + k * 256 + lane * 4) = v[k] * sc * g4; }
        }
}

template <bool PASSB>
DI void s5_pass(const int tid, LAS unsigned char* lds, const P& p, int G, int c0) {
    const int wave = tid >> 6, lane = tid & 63, fr = lane & 15, fq = lane >> 4;
    LAS float* ubuf = (LAS float*)(lds + wave * 8192);
    LAS bf16_t* hbuf = (LAS bf16_t*)(lds + wave * 8192 + 1024);
    const float* abar = (const float*)(p.ws + W_S5AB); const float* bbar = (const float*)(p.ws + W_S5BB); const bf16_t* ccat = (const bf16_t*)(p.ws + W_S5CC);
    const bf16_t* us5 = (const bf16_t*)(p.ws + A_US5); bf16_t* zs5 = (bf16_t*)(p.ws + A_ZS5); float* hend = (float*)(p.ws + A_S5END);
    const float* dskip = p.in[10];
    for (int bu = c0; bu < 512; bu += G) {
        const int g = bu >> 5, wu = (bu & 31) * 8 + wave, b = wu >> 3, seg = wu & 7;
        float bre[16], bim[16];
        { const f32x4* bp = (const f32x4*)(bbar + ((size_t)(g * 64 + lane)) * 32);
#pragma unroll
          for (int k = 0; k < 4; ++k) { f32x4 v = bp[k]; bre[4 * k] = v[0]; bre[4 * k + 1] = v[1]; bre[4 * k + 2] = v[2]; bre[4 * k + 3] = v[3]; }
#pragma unroll
          for (int k = 0; k < 4; ++k) { f32x4 v = bp[4 + k]; bim[4 * k] = v[0]; bim[4 * k + 1] = v[1]; bim[4 * k + 2] = v[2]; bim[4 * k + 3] = v[3]; } }
        const float are = abar[(g * 64 + lane) * 2], aim = abar[(g * 64 + lane) * 2 + 1];
        float hre = 0.f, him = 0.f;
        bf16x8 cf[4]; float dsk = 0.f;
        if (PASSB) {
#pragma unroll
            for (int ks = 0; ks < 4; ++ks) cf[ks] = *(const bf16x8*)(ccat + ((size_t)(g * 16 + fr)) * 128 + ks * 32 + fq * 8);
            dsk = dskip[g * 16 + fr];
            float pr = are, pi = aim;
#pragma unroll
            for (int s = 0; s < 8; ++s) { const float nr = pr * pr - pi * pi, ni = 2.f * pr * pi; pr = nr; pi = ni; }
            for (int s = 0; s < seg; ++s) { const float* he = hend + (((size_t)(b * 16 + g) * 8 + s) * 64 + lane) * 2; const float er = he[0], ei = he[1];
                const float nr = pr * hre - pi * him + er, ni = pr * him + pi * hre + ei; hre = nr; him = ni; }
        }
        const size_t tokbase = (size_t)b * SEQ + seg * 256;
        for (int tile = 0; tile < 16; ++tile) {
            if (lane < 32) { const int tk = lane >> 1, hf = lane & 1;
                const u32x4 raw = *(const u32x4*)(us5 + (tokbase + tile * 16 + tk) * 256 + g * 16 + hf * 8);
                LAS float* d = ubuf + tk * 16 + hf * 8;
                *(LAS f32x4*)d = (f32x4){lo16(raw.x), hi16(raw.x), lo16(raw.y), hi16(raw.y)}; *(LAS f32x4*)(d + 4) = (f32x4){lo16(raw.z), hi16(raw.z), lo16(raw.w), hi16(raw.w)}; }
            lds_wait();
#pragma unroll 4
            for (int t = 0; t < 16; ++t) {
                float bur = 0.f, bui = 0.f;
#pragma unroll
                for (int k = 0; k < 4; ++k) { const f32x4 u = *(const LAS f32x4*)(ubuf + t * 16 + k * 4);
#pragma unroll
                    for (int e = 0; e < 4; ++e) { bur += bre[4 * k + e] * u[e]; bui += bim[4 * k + e] * u[e]; } }
                const float nr = are * hre - aim * him + bur, ni = are * him + aim * hre + bui; hre = nr; him = ni;
                if (PASSB) { hbuf[t * 136 + lane] = f2bf(hre); hbuf[t * 136 + 64 + lane] = f2bf(-him); }
            }
            if (PASSB) {
                lds_wait();
                f32x4 acc = (f32x4){0.f, 0.f, 0.f, 0.f};
#pragma unroll
                for (int ks = 0; ks < 4; ++ks) { const bf16x8 a = *(const LAS bf16x8*)(hbuf + fr * 136 + ks * 32 + fq * 8); acc = mfma16(a, cf[ks], acc); }
#pragma unroll
                for (int j = 0; j < 4; ++j) { const int tk = fq * 4 + j; const float y = acc[j] + dsk * ubuf[tk * 16 + fr];
                    zs5[(tokbase + tile * 16 + tk) * 256 + g * 16 + fr] = f2bf(gelu_tanh(y)); }
            }
            lds_wait();
        }
        if (!PASSB) { float* he = hend + (((size_t)(b * 16 + g) * 8 + seg) * 64 + lane) * 2; he[0] = hre; he[1] = him; }
    }
}

DI void gdn_prep_phase(const int tid, LAS unsigned char* lds, const P& p, int G, int c) {
    const int hb = tid >> 8, ht = tid & 255, lane = tid & 63, wv = __builtin_amdgcn_readfirstlane(ht >> 6), fr = lane & 15, fq = lane >> 4;
    LAS unsigned char* base = lds + hb * 65536;
    LAS bf16_t* Qs = (LAS bf16_t*)base; LAS bf16_t* Ks = Qs + 64 * 136;
    LAS float* Ls = (LAS float*)(base + 2 * 17408); LAS float* tb = (LAS float*)(base + 3 * 17408);
    const bf16_t* qkv = (const bf16_t*)(p.ws + A_QKV); const float* blal = (const float*)(p.ws + A_BLAL);
    const float* convw = p.in[13]; const float* a_log = p.in[14]; const float* dt_bias = p.in[15];
    bf16_t* Uc = (bf16_t*)(p.ws + CH_U); bf16_t* Wc = (bf16_t*)(p.ws + CH_W); bf16_t* QDc = (bf16_t*)(p.ws + CH_QD); bf16_t* KDTc = (bf16_t*)(p.ws + CH_KDT); bf16_t* INc = (bf16_t*)(p.ws + CH_INTRA); float* GLc = (float*)(p.ws + CH_GL);
    for (int u = c * 2 + hb; u < 6144; u += 2 * G) {
        const int n = u & 31, bh = u >> 5, h = bh % 6, b = bh / 6; const size_t cid = (size_t)u;
        const long tok0 = (long)b * SEQ + n * 64;
        float xs[64];
        {
            const int ch = ht & 127, th = ht >> 7, isv = th, colq = h * 128 + ch, colkv = 768 + isv * 768 + h * 128 + ch, t0 = th * 32;
            bf16_t qraw[35], kvraw[67];
            const bool haloq = (n > 0) || (t0 > 0), halokv = (n > 0);
#pragma unroll
            for (int e = 0; e < 3; ++e) { qraw[e] = haloq ? qkv[(tok0 + t0 - 3 + e) * 2304 + colq] : (bf16_t)0; kvraw[e] = halokv ? qkv[(tok0 - 3 + e) * 2304 + colkv] : (bf16_t)0; }
#pragma unroll
            for (int e = 0; e < 32; ++e) qraw[3 + e] = qkv[(tok0 + t0 + e) * 2304 + colq];
#pragma unroll
            for (int e = 0; e < 64; ++e) kvraw[3 + e] = qkv[(tok0 + e) * 2304 + colkv];
            { const float w0 = convw[colq], w1 = convw[2304 + colq], w2 = convw[4608 + colq], w3 = convw[6912 + colq];
#pragma unroll
              for (int e = 0; e < 32; ++e) { const float y = w0 * bf2f(qraw[e]) + w1 * bf2f(qraw[e + 1]) + w2 * bf2f(qraw[e + 2]) + w3 * bf2f(qraw[e + 3]); Qs[(t0 + e) * 136 + ch] = f2bf(silu_fast(y)); } }
            { const float w0 = convw[colkv], w1 = convw[2304 + colkv], w2 = convw[4608 + colkv], w3 = convw[6912 + colkv];
#pragma unroll
              for (int e = 0; e < 64; ++e) { const float y = w0 * bf2f(kvraw[e]) + w1 * bf2f(kvraw[e + 1]) + w2 * bf2f(kvraw[e + 2]) + w3 * bf2f(kvraw[e + 3]); xs[e] = silu_fast(y); }
              if (!isv) {
#pragma unroll
                  for (int tt = 0; tt < 64; ++tt) Ks[tt * 136 + ch] = f2bf(xs[tt]); } }
        }
        if (ht < 64) { const float bl = blal[(tok0 + ht) * 16 + h], al = blal[(tok0 + ht) * 16 + 6 + h];
            const float x = al + dt_bias[h]; const float sp = fmaxf(x, 0.f) + log1pf(expf(-fabsf(x))); float gsum = -expf(a_log[h]) * sp;
#pragma unroll
            for (int off = 1; off < 64; off <<= 1) { const float v = __shfl_up(gsum, off); if (lane >= off) gsum += v; }
            tb[ht] = 1.f / (1.f + expf(-bl)); tb[64 + ht] = gsum; }
        __syncthreads();
        f32x4 kk[4], qk[4];
        { bf16x8 aK[4], aQ[4];
#pragma unroll
          for (int ks = 0; ks < 4; ++ks) { aK[ks] = *(const LAS bf16x8*)(Ks + (wv * 16 + fr) * 136 + ks * 32 + fq * 8); aQ[ks] = *(const LAS bf16x8*)(Qs + (wv * 16 + fr) * 136 + ks * 32 + fq * 8); }
          f32x4 qq = (f32x4){0.f, 0.f, 0.f, 0.f};
#pragma unroll
          for (int ks = 0; ks < 4; ++ks) qq = mfma16(aQ[ks], aQ[ks], qq);
#pragma unroll
          for (int ct = 0; ct < 4; ++ct) { kk[ct] = (f32x4){0.f, 0.f, 0.f, 0.f}; qk[ct] = (f32x4){0.f, 0.f, 0.f, 0.f};
              if (ct <= wv) {
#pragma unroll
                  for (int ks = 0; ks < 4; ++ks) { const bf16x8 bK = *(const LAS bf16x8*)(Ks + (ct * 16 + fr) * 136 + ks * 32 + fq * 8); kk[ct] = mfma16(aK[ks], bK, kk[ct]); qk[ct] = mfma16(aQ[ks], bK, qk[ct]); } }
              if (ct == wv && (fr >> 2) == fq) { const int j = fr & 3; const float dk = j == 0 ? kk[ct][0] : j == 1 ? kk[ct][1] : j == 2 ? kk[ct][2] : kk[ct][3];
                  const float dq = j == 0 ? qq[0] : j == 1 ? qq[1] : j == 2 ? qq[2] : qq[3]; tb[128 + wv * 16 + fr] = dq; tb[192 + wv * 16 + fr] = dk; } } }
        __syncthreads();
        {
            float rkc[4], rqc[4], gcc[4], btc[4], rks[4], gcs[4];
#pragma unroll
            for (int j = 0; j < 4; ++j) { const int cr = wv * 16 + fq * 4 + j; rkc[j] = rsqrtf(tb[192 + cr] + 1e-6f); rqc[j] = rsqrtf(tb[128 + cr] + 1e-6f) * 0.08838834764831845f; gcc[j] = tb[64 + cr]; btc[j] = tb[cr]; }
#pragma unroll
            for (int ct = 0; ct < 4; ++ct) { const int sc = ct * 16 + fr; rks[ct] = rsqrtf(tb[192 + sc] + 1e-6f); gcs[ct] = tb[64 + sc]; }
#pragma unroll
            for (int ct = 0; ct < 4; ++ct)
#pragma unroll
                for (int j = 0; j < 4; ++j) { const int cr = wv * 16 + fq * 4 + j, sc = ct * 16 + fr;
                    const float e = (sc <= cr) ? __expf(gcc[j] - gcs[ct]) : 0.f;
                    Ls[(cr >> 1) * 136 + sc * 2 + (cr & 1)] = (sc < cr) ? btc[j] * rkc[j] * rks[ct] * kk[ct][j] * e : 0.f;
                    INc[cid * 4096 + cr * 64 + sc] = f2bf(rqc[j] * rks[ct] * qk[ct][j] * e); }
            if (ht < 64) { const float rk = rsqrtf(tb[192 + ht] + 1e-6f), gch = tb[64 + ht];
                tb[256 + ht] = rk * __expf(tb[64 + 63] - gch); tb[320 + ht] = rk * tb[ht] * __expf(gch); }
        }
        __syncthreads();
        { const int ch = ht & 127, isv = ht >> 7; const float gl = tb[64 + 63];
          if (!isv) {
#pragma unroll
              for (int i8 = 0; i8 < 8; ++i8) { float kd[8];
#pragma unroll
                  for (int e = 0; e < 8; ++e) { const int tt = i8 * 8 + e; kd[e] = xs[tt] * tb[256 + tt]; xs[tt] = xs[tt] * tb[320 + tt]; }
                  u32x4 w; w.x = pk2(kd[0], kd[1]); w.y = pk2(kd[2], kd[3]); w.z = pk2(kd[4], kd[5]); w.w = pk2(kd[6], kd[7]);
                  *(u32x4*)(KDTc + cid * 8192 + ch * 64 + i8 * 8) = w; }
          } else {
#pragma unroll
              for (int tt = 0; tt < 64; ++tt) xs[tt] *= tb[tt]; }
#pragma unroll
          for (int kb = 0; kb < 8; ++kb) {
#pragma unroll
              for (int pp = 0; pp < 4; ++pp) { const int pr = 4 * kb + pp;
                  f32x2 s = (f32x2){xs[2 * pr], xs[2 * pr + 1]};
#pragma unroll
                  for (int j = 8 * kb; j < 2 * pr; j += 2) { const f32x4 l = *(const LAS f32x4*)(Ls + pr * 136 + j * 2);
                      s -= (f32x2){l[0], l[1]} * (f32x2){xs[j], xs[j]}; s -= (f32x2){l[2], l[3]} * (f32x2){xs[j + 1], xs[j + 1]}; }
                  xs[2 * pr] = s[0];
                  xs[2 * pr + 1] = s[1] - Ls[pr * 136 + 4 * pr + 1] * s[0]; }
#pragma unroll
              for (int pr = 4 * kb + 4; pr < 32; ++pr) {
                  f32x2 s0 = (f32x2){xs[2 * pr], xs[2 * pr + 1]}, s1 = (f32x2){0.f, 0.f};
#pragma unroll
                  for (int q = 0; q < 4; ++q) { const int j = 8 * kb + 2 * q; const f32x4 l = *(const LAS f32x4*)(Ls + pr * 136 + j * 2);
                      s0 -= (f32x2){l[0], l[1]} * (f32x2){xs[j], xs[j]}; s1 -= (f32x2){l[2], l[3]} * (f32x2){xs[j + 1], xs[j + 1]}; }
                  const f32x2 s = s0 + s1; xs[2 * pr] = s[0]; xs[2 * pr + 1] = s[1]; }
          }
          if (isv) {
#pragma unroll
              for (int i8 = 0; i8 < 8; ++i8) { u32x4 w; w.x = pk2(xs[i8 * 8], xs[i8 * 8 + 1]); w.y = pk2(xs[i8 * 8 + 2], xs[i8 * 8 + 3]); w.z = pk2(xs[i8 * 8 + 4], xs[i8 * 8 + 5]); w.w = pk2(xs[i8 * 8 + 6], xs[i8 * 8 + 7]);
                  *(u32x4*)(Uc + cid * 8192 + ch * 64 + i8 * 8) = w; }
          } else { bf16_t* dst = Wc + cid * 8192 + ch;
#pragma unroll
              for (int tt = 0; tt < 64; ++tt) dst[tt * 128] = f2bf(xs[tt]); }
          { const int tt = ht >> 2, d0 = (ht & 3) * 32; const float fac = rsqrtf(tb[128 + tt] + 1e-6f) * 0.08838834764831845f * __expf(tb[64 + tt]);
#pragma unroll
            for (int i = 0; i < 4; ++i) { const u32x4 r = *(const LAS u32x4*)(Qs + tt * 136 + d0 + i * 8); u32x4 w;
                w.x = pk2(lo16(r.x) * fac, hi16(r.x) * fac); w.y = pk2(lo16(r.y) * fac, hi16(r.y) * fac); w.z = pk2(lo16(r.z) * fac, hi16(r.z) * fac); w.w = pk2(lo16(r.w) * fac, hi16(r.w) * fac);
                *(u32x4*)(QDc + cid * 8192 + tt * 128 + d0 + i * 8) = w; } }
          if (ht == 0) GLc[cid] = __expf(gl); }
        __syncthreads();
    }
}

DI void gdn_seq_phase(const int tid, LAS unsigned char* lds, const P& p, int G, int c) {
    const int w = __builtin_amdgcn_readfirstlane(tid >> 6), lane = tid & 63, fr = lane & 15, fq = lane >> 4, ct = w & 3, eh = w >> 2;
    LAS bf16_t* ST = (LAS bf16_t*)lds;
    LAS bf16_t* VT = (LAS bf16_t*)(lds + 34816);
    LAS float* OT = (LAS float*)(lds + 34816 + 18432);
    const bf16_t* Uc = (const bf16_t*)(p.ws + CH_U); const bf16_t* Wc = (const bf16_t*)(p.ws + CH_W); const bf16_t* QDc = (const bf16_t*)(p.ws + CH_QD); const bf16_t* KDTc = (const bf16_t*)(p.ws + CH_KDT); const bf16_t* INc = (const bf16_t*)(p.ws + CH_INTRA); const float* GLc = (const float*)(p.ws + CH_GL);
    const bf16_t* Z = (const bf16_t*)(p.ws + A_Z); bf16_t* ycat = (bf16_t*)(p.ws + A_YCAT); const float* normw = p.in[16];
    for (int u = c; u < 192; u += G) {
        const int h = u % 6, b = u / 6;
        for (int i = tid; i < 128 * 136 / 2; i += 512) ((LAS unsigned*)ST)[i] = 0u;
        f32x4 Sacc[8];
#pragma unroll
        for (int e = 0; e < 8; ++e) Sacc[e] = (f32x4){0.f, 0.f, 0.f, 0.f};
        __syncthreads();
        bf16x8 Wf[4], Qf[4], If[2], Kf[2]; u32x2 uvr[4]; float gl;
        const int wrow = (ct * 16 + fr) * 128 + fq * 8, irow = (ct * 16 + fr) * 64 + fq * 8, krow = (w * 16 + fr) * 64 + fq * 8;
        { const size_t cid = (size_t)u * 32;
#pragma unroll
          for (int ks = 0; ks < 4; ++ks) { Wf[ks] = *(const bf16x8*)(Wc + cid * 8192 + wrow + ks * 32); Qf[ks] = *(const bf16x8*)(QDc + cid * 8192 + wrow + ks * 32); }
#pragma unroll
          for (int ks = 0; ks < 2; ++ks) { If[ks] = *(const bf16x8*)(INc + cid * 4096 + irow + ks * 32); Kf[ks] = *(const bf16x8*)(KDTc + cid * 8192 + krow + ks * 32); }
#pragma unroll
          for (int et = 0; et < 4; ++et) uvr[et] = *(const u32x2*)(Uc + cid * 8192 + (eh * 64 + et * 16 + fr) * 64 + ct * 16 + fq * 4);
          gl = GLc[cid]; }
        for (int n = 0; n < 32; ++n) {
            const size_t cid = (size_t)u * 32 + n, cnx = (cid + 1 < 6144) ? cid + 1 : cid;
            const int tt = tid >> 3, e0 = (tid & 7) * 16; const size_t tok = (size_t)b * SEQ + n * 64 + tt;
            const u32x4 z0 = *(const u32x4*)(Z + tok * 768 + h * 128 + e0), z1 = *(const u32x4*)(Z + tok * 768 + h * 128 + e0 + 8);
            f32x4 T1[4], O1[4];
#pragma unroll
            for (int et = 0; et < 4; ++et) { T1[et] = (f32x4){0.f, 0.f, 0.f, 0.f}; O1[et] = (f32x4){0.f, 0.f, 0.f, 0.f};
#pragma unroll
                for (int ks = 0; ks < 4; ++ks) { const bf16x8 bb = *(const LAS bf16x8*)(ST + (eh * 64 + et * 16 + fr) * 136 + ks * 32 + fq * 8); T1[et] = mfma16(Wf[ks], bb, T1[et]); O1[et] = mfma16(Qf[ks], bb, O1[et]); } }
#pragma unroll
            for (int ks = 0; ks < 4; ++ks) { Wf[ks] = *(const bf16x8*)(Wc + cnx * 8192 + wrow + ks * 32); Qf[ks] = *(const bf16x8*)(QDc + cnx * 8192 + wrow + ks * 32); }
#pragma unroll
            for (int et = 0; et < 4; ++et) { u32x2 pk; pk.x = pk2(lo16(uvr[et].x) - T1[et][0], hi16(uvr[et].x) - T1[et][1]); pk.y = pk2(lo16(uvr[et].y) - T1[et][2], hi16(uvr[et].y) - T1[et][3]);
                *(LAS u32x2*)(VT + (eh * 64 + et * 16 + fr) * 72 + ct * 16 + fq * 4) = pk; }
#pragma unroll
            for (int et = 0; et < 4; ++et) uvr[et] = *(const u32x2*)(Uc + cnx * 8192 + (eh * 64 + et * 16 + fr) * 64 + ct * 16 + fq * 4);
            __syncthreads();
#pragma unroll
            for (int et = 0; et < 4; ++et) {
#pragma unroll
                for (int ks = 0; ks < 2; ++ks) { const bf16x8 bb = *(const LAS bf16x8*)(VT + (eh * 64 + et * 16 + fr) * 72 + ks * 32 + fq * 8); O1[et] = mfma16(If[ks], bb, O1[et]); }
#pragma unroll
                for (int j = 0; j < 4; ++j) OT[(ct * 16 + fq * 4 + j) * 132 + eh * 64 + et * 16 + fr] = O1[et][j]; }
#pragma unroll
            for (int ks = 0; ks < 2; ++ks) If[ks] = *(const bf16x8*)(INc + cnx * 4096 + irow + ks * 32);
#pragma unroll
            for (int e8 = 0; e8 < 8; ++e8) { Sacc[e8] = Sacc[e8] * gl;
#pragma unroll
                for (int ks = 0; ks < 2; ++ks) { const bf16x8 aa = *(const LAS bf16x8*)(VT + (e8 * 16 + fr) * 72 + ks * 32 + fq * 8); Sacc[e8] = mfma16(aa, Kf[ks], Sacc[e8]); } }
#pragma unroll
            for (int ks = 0; ks < 2; ++ks) Kf[ks] = *(const bf16x8*)(KDTc + cnx * 8192 + krow + ks * 32);
            gl = GLc[cnx];
#pragma unroll
            for (int e8 = 0; e8 < 8; ++e8)
#pragma unroll
                for (int j = 0; j < 4; ++j) ST[(e8 * 16 + fq * 4 + j) * 136 + w * 16 + fr] = f2bf(Sacc[e8][j]);
            __syncthreads();
            { float o[16]; float ss = 0.f;
#pragma unroll
              for (int i = 0; i < 4; ++i) { const f32x4 v = *(const LAS f32x4*)(OT + tt * 132 + e0 + i * 4); o[4 * i] = v[0]; o[4 * i + 1] = v[1]; o[4 * i + 2] = v[2]; o[4 * i + 3] = v[3]; ss += v[0] * v[0] + v[1] * v[1] + v[2] * v[2] + v[3] * v[3]; }
              ss += __shfl_xor(ss, 1); ss += __shfl_xor(ss, 2); ss += __shfl_xor(ss, 4);
              const float sc = rsqrtf(ss * (1.f / 128.f) + 1e-6f);
              float zz[16] = {lo16(z0.x), hi16(z0.x), lo16(z0.y), hi16(z0.y), lo16(z0.z), hi16(z0.z), lo16(z0.w), hi16(z0.w), lo16(z1.x), hi16(z1.x), lo16(z1.y), hi16(z1.y), lo16(z1.z), hi16(z1.z), lo16(z1.w), hi16(z1.w)};
              float r[16];
#pragma unroll
              for (int i = 0; i < 16; ++i) r[i] = o[i] * sc * normw[e0 + i] * silu_fast(zz[i]);
              u32x4 w0, w1; w0.x = pk2(r[0], r[1]); w0.y = pk2(r[2], r[3]); w0.z = pk2(r[4], r[5]); w0.w = pk2(r[6], r[7]); w1.x = pk2(r[8], r[9]); w1.y = pk2(r[10], r[11]); w1.z = pk2(r[12], r[13]); w1.w = pk2(r[14], r[15]);
              *(u32x4*)(ycat + tok * 1024 + 256 + h * 128 + e0) = w0; *(u32x4*)(ycat + tok * 1024 + 256 + h * 128 + e0 + 8) = w1; }
        }
        __syncthreads();
    }
}

DI void convact_phase(const int tid, const P& p, int layer, int half, int G, int c) {
    const bf16_t* up = (const bf16_t*)(p.ws + F_UP); bf16_t* act = (bf16_t*)(p.ws + F_ACT);
    const float* cw = p.in[28] + (size_t)layer * 3 * FF2; const float* cb = p.in[29] + (size_t)layer * FF2;
    const int nitems = (32768 / 8) * 352;
    for (int it = c * 512 + tid; it < nitems; it += G * 512) {
        const int ck = it % 352, run = it / 352, ch = ck * 8, r0 = run * 8, sp0 = r0 & 2047;
        float wa[3][8], wb[3][8], ba[8], bb[8];
#pragma unroll
        for (int k = 0; k < 3; ++k)
#pragma unroll
            for (int e = 0; e < 8; ++e) { wa[k][e] = cw[k * FF2 + ch + e]; wb[k][e] = cw[k * FF2 + FFH + ch + e]; }
#pragma unroll
        for (int e = 0; e < 8; ++e) { ba[e] = cb[ch + e]; bb[e] = cb[FFH + ch + e]; }
        u32x4 a0 = (u32x4){0, 0, 0, 0}, a1 = a0, b0 = a0, b1 = a0;
        if (sp0 > 0) { a0 = *(const u32x4*)(up + (size_t)(r0 - 2) * FF2 + ch); a1 = *(const u32x4*)(up + (size_t)(r0 - 1) * FF2 + ch); b0 = *(const u32x4*)(up + (size_t)(r0 - 2) * FF2 + FFH + ch); b1 = *(const u32x4*)(up + (size_t)(r0 - 1) * FF2 + FFH + ch); }
#pragma unroll
        for (int r = 0; r < 8; ++r) {
            const u32x4 a2 = *(const u32x4*)(up + (size_t)(r0 + r) * FF2 + ch), b2 = *(const u32x4*)(up + (size_t)(r0 + r) * FF2 + FFH + ch);
            const unsigned A0[4] = {a0.x, a0.y, a0.z, a0.w}, A1[4] = {a1.x, a1.y, a1.z, a1.w}, A2[4] = {a2.x, a2.y, a2.z, a2.w}, B0[4] = {b0.x, b0.y, b0.z, b0.w}, B1[4] = {b1.x, b1.y, b1.z, b1.w}, B2[4] = {b2.x, b2.y, b2.z, b2.w};
            float o[8];
#pragma unroll
            for (int q = 0; q < 4; ++q) {
                const float al = wa[0][2 * q] * lo16(A0[q]) + wa[1][2 * q] * lo16(A1[q]) + wa[2][2 * q] * lo16(A2[q]) + ba[2 * q];
                const float ah = wa[0][2 * q + 1] * hi16(A0[q]) + wa[1][2 * q + 1] * hi16(A1[q]) + wa[2][2 * q + 1] * hi16(A2[q]) + ba[2 * q + 1];
                const float bl = wb[0][2 * q] * lo16(B0[q]) + wb[1][2 * q] * lo16(B1[q]) + wb[2][2 * q] * lo16(B2[q]) + bb[2 * q];
                const float bh = wb[0][2 * q + 1] * hi16(B0[q]) + wb[1][2 * q + 1] * hi16(B1[q]) + wb[2][2 * q + 1] * hi16(B2[q]) + bb[2 * q + 1];
                o[2 * q] = siluf_(al) * bl; o[2 * q + 1] = siluf_(ah) * bh; }
            u32x4 w; w.x = pk2(o[0], o[1]); w.y = pk2(o[2], o[3]); w.z = pk2(o[4], o[5]); w.w = pk2(o[6], o[7]);
            *(u32x4*)(act + ((size_t)half * 32768 + r0 + r) * FFH + ch) = w;
            a0 = a1; a1 = a2; b0 = b1; b1 = b2; }
    }
}

DI void nsa_attn_phase(const int tid0, LAS unsigned char* lds, const P& p, int G, int c) {
    const int w = __builtin_amdgcn_readfirstlane(tid0 >> 6), r = w & 3, qh = w >> 2;
    LAS bf16_t* Qs = (LAS bf16_t*)lds;
    LAS bf16_t* Kc = (LAS bf16_t*)(lds + 36864);
    LAS bf16_t* VcT = (LAS bf16_t*)(lds + 36864 + 18432);
    LAS bf16_t* KV0 = (LAS bf16_t*)(lds + 72704);
    LAS float* imp4 = (LAS float*)(lds + 109568);
    LAS unsigned* selm = (LAS unsigned*)(lds + 109568 + 33792);
    const bf16_t* Q = (const bf16_t*)(p.ws + N_Q); const bf16_t* KS = (const bf16_t*)(p.ws + N_KS); const bf16_t* VST = (const bf16_t*)(p.ws + N_VST); const bf16_t* KW = (const bf16_t*)(p.ws + N_KW); const bf16_t* VWT = (const bf16_t*)(p.ws + N_VWT);
    const bf16_t* KCMP = (const bf16_t*)(p.ws + N_KCMP); const bf16_t* VCMPT = (const bf16_t*)(p.ws + N_VCMPT); const float* gates = (const float*)(p.ws + N_GATES); bf16_t* AO = (bf16_t*)(p.ws + N_AO);
    for (int idx = c; idx < 4096; idx += G) {
        int tid = tid0; asm volatile("" : "+v"(tid));
        const int lane = tid & 63, fr = lane & 15, fq = lane >> 4;
        const int rnd = idx >> 8, hi_half = (idx >> 7) & 1, i = 31 - 2 * rnd - (hi_half ^ (rnd & 1)), bg = idx & 127, b = bg >> 2, g = bg & 3, hd = g * 4 + r;
        const size_t tokb = (size_t)b * SEQ + i * 64;
        const int nkt = (i >> 2) + 1;
#pragma unroll
        for (int k = 0; k < 4; ++k) { const int pc = tid + k * 512, row = pc >> 3, cc = pc & 7, rr = row >> 6, ql = row & 63;
            *(LAS u32x4*)(Qs + row * 72 + cc * 8) = *(const u32x4*)(Q + (tokb + ql) * 1024 + (g * 4 + rr) * 64 + cc * 8); }
#pragma unroll
        for (int k = 0; k < 2; ++k) { const int pc = tid + k * 512; { const int row = pc >> 3, cc = pc & 7; if (row < nkt * 16) *(LAS u32x4*)(Kc + row * 72 + cc * 8) = *(const u32x4*)(KCMP + (size_t)bg * 8192 + row * 64 + cc * 8); }
            { const int row = pc >> 4, cc = pc & 15; *(LAS u32x4*)(VcT + row * 136 + cc * 8) = *(const u32x4*)(VCMPT + (size_t)bg * 8192 + row * 128 + cc * 8); } }
        __syncthreads();
        bf16x8 Qf[2][2];
#pragma unroll
        for (int qt = 0; qt < 2; ++qt)
#pragma unroll
            for (int ks = 0; ks < 2; ++ks) Qf[qt][ks] = *(const LAS bf16x8*)(Qs + (r * 64 + qh * 32 + qt * 16 + fr) * 72 + ks * 32 + fq * 8);
        const float slope2 = exp2f(-0.5f * (float)(hd + 1)) * 1.4426950408889634f;
        float sc16[16];
#pragma unroll
        for (int e = 0; e < 16; ++e) sc16[e] = slope2 * (float)((e >> 2) * 16 + (e & 3));
        int tq[2]; float g0[2], g1[2], g2[2];
#pragma unroll
        for (int qt = 0; qt < 2; ++qt) { const int ql = qh * 32 + qt * 16 + fr; tq[qt] = i * 64 + ql; const float* gp = gates + (tokb + ql) * 48 + hd * 3; g0[qt] = gp[0]; g1[qt] = gp[1]; g2[qt] = gp[2]; }
        f32x4 outacc[4][2];
#pragma unroll
        for (int qt = 0; qt < 2; ++qt) {
            const int jmax = tq[qt] >= 31 ? ((tq[qt] - 31) >> 4) : -1;
            const float sl16 = slope2 * 16.f, jb = (float)(fq * 4);
            f32x4 S[8];
#pragma unroll
            for (int kt = 0; kt < 8; ++kt) { S[kt] = (f32x4){0.f, 0.f, 0.f, 0.f};
                if (kt < nkt) {
#pragma unroll
                    for (int ks = 0; ks < 2; ++ks) { const bf16x8 kf = *(const LAS bf16x8*)(Kc + (kt * 16 + fr) * 72 + ks * 32 + fq * 8); S[kt] = mfma16(kf, Qf[qt][ks], S[kt]); } } }
            float m = -1e30f;
#pragma unroll
            for (int kt = 0; kt < 8; ++kt) if (kt < nkt) {
#pragma unroll
                for (int j = 0; j < 4; ++j) { const int jc = kt * 16 + fq * 4 + j; const float s = fmaf(sl16, jb + (float)(kt * 16 + j), S[kt][j]); S[kt][j] = (jc <= jmax) ? s : -1e30f; m = fmaxf(m, S[kt][j]); } }
            m = fmaxf(m, __shfl_xor(m, 16)); m = fmaxf(m, __shfl_xor(m, 32));
            float l = 0.f;
#pragma unroll
            for (int kt = 0; kt < 8; ++kt) if (kt < nkt) {
#pragma unroll
                for (int j = 0; j < 4; ++j) { const float pv = (S[kt][j] > -1e29f) ? __builtin_amdgcn_exp2f(S[kt][j] - m) : 0.f; S[kt][j] = pv; l += pv; } }
            l += __shfl_xor(l, 16); l += __shfl_xor(l, 32);
            const float inv = l > 0.f ? 1.f / l : 0.f;
            float prev3 = 0.f;
#pragma unroll
            for (int kt = 0; kt < 8; ++kt) if (kt < nkt) {
#pragma unroll
                for (int j = 0; j < 4; ++j) S[kt][j] *= inv;
                const float p3 = S[kt][3];
                const float x1 = __shfl(p3, (lane + 48) & 63), x2 = __shfl(prev3, (lane + 48) & 63);
                const float carry = (fq > 0) ? x1 : x2;
                imp4[(r * 64 + qh * 32 + qt * 16 + fr) * 33 + kt * 4 + fq] = S[kt][0] + S[kt][1] + S[kt][2] + 0.5f * p3 + 0.5f * carry;
                prev3 = p3; }
#pragma unroll
            for (int dt = 0; dt < 4; ++dt) outacc[dt][qt] = (f32x4){0.f, 0.f, 0.f, 0.f};
#pragma unroll
            for (int s = 0; s < 4; ++s) if (2 * s < nkt) {
                u32x4 t; t.x = pk2(S[2 * s][0], S[2 * s][1]); t.y = pk2(S[2 * s][2], S[2 * s][3]); t.z = pk2(S[2 * s + 1][0], S[2 * s + 1][1]); t.w = pk2(S[2 * s + 1][2], S[2 * s + 1][3]);
                const bf16x8 pf = __builtin_bit_cast(bf16x8, t);
#pragma unroll
                for (int dt = 0; dt < 4; ++dt) { u32x4 tv; const u32x2 v0 = *(const LAS u32x2*)(VcT + (dt * 16 + fr) * 136 + s * 32 + fq * 4), v1 = *(const LAS u32x2*)(VcT + (dt * 16 + fr) * 136 + s * 32 + 16 + fq * 4);
                    tv.x = v0.x; tv.y = v0.y; tv.z = v1.x; tv.w = v1.y; outacc[dt][qt] = mfma16(__builtin_bit_cast(bf16x8, tv), pf, outacc[dt][qt]); } }
#pragma unroll
            for (int dt = 0; dt < 4; ++dt) outacc[dt][qt] = outacc[dt][qt] * g0[qt];
        }
        __syncthreads();
        if (tid < 64) { unsigned mask;
            if (i <= 3) mask = (1u << (i + 1)) - 1u;
            else { float v1 = -1.f, v2 = -1.f; int n1 = 0, n2 = 0;
                for (int n = 1; n < i; ++n) { const float v = ((imp4[(0 * 64 + tid) * 33 + n] + imp4[(1 * 64 + tid) * 33 + n]) + imp4[(2 * 64 + tid) * 33 + n]) + imp4[(3 * 64 + tid) * 33 + n];
                    if (v > v1) { v2 = v1; n2 = n1; v1 = v; n1 = n; } else if (v > v2) { v2 = v; n2 = n; } }
                mask = 1u | (1u << i) | (1u << n1) | (1u << n2); }
            selm[tid] = mask; }
        __syncthreads();
        unsigned sm[2];
#pragma unroll
        for (int qt = 0; qt < 2; ++qt) sm[qt] = selm[qh * 32 + qt * 16 + fr];
#pragma unroll
        for (int br = 0; br < 2; ++br) {
            const bf16_t* Kg = (br == 0 ? KS : KW) + (size_t)bg * 131072; const bf16_t* Vg = (br == 0 ? VST : VWT) + (size_t)bg * 131072;
            const int n0 = (br == 0) ? 0 : (i >= 4 ? i - 4 : 0), npair = (i - n0 + 2) >> 1;
            f32x4 O[4][2]; float lrun[2] = {0.f, 0.f};
#pragma unroll
            for (int dt = 0; dt < 4; ++dt)
#pragma unroll
                for (int qt = 0; qt < 2; ++qt) O[dt][qt] = (f32x4){0.f, 0.f, 0.f, 0.f};
            const int lrow = tid >> 3, lcc = tid & 7;
            u32x4 kx[2], vx[2];
#pragma unroll
            for (int h = 0; h < 2; ++h) { const int nn = (n0 + h <= i) ? n0 + h : i; kx[h] = *(const u32x4*)(Kg + ((size_t)nn * 64 + lrow) * 64 + lcc * 8); vx[h] = *(const u32x4*)(Vg + (size_t)lrow * 2048 + nn * 64 + lcc * 8); }
            __syncthreads();
#pragma unroll
            for (int h = 0; h < 2; ++h) { *(LAS u32x4*)(KV0 + h * 9216 + lrow * 72 + lcc * 8) = kx[h]; *(LAS u32x4*)(KV0 + h * 9216 + 4608 + lrow * 72 + lcc * 8) = vx[h]; }
            __syncthreads();
#pragma unroll 1
            for (int pi = 0; pi < npair; ++pi) {
                LAS bf16_t* Tc = (pi & 1) ? Qs : KV0; LAS bf16_t* Tn = (pi & 1) ? KV0 : Qs;
                const int na = n0 + 2 * pi;
                if (pi + 1 < npair) {
#pragma unroll
                    for (int h = 0; h < 2; ++h) { const int nn = (na + 2 + h <= i) ? na + 2 + h : i; kx[h] = *(const u32x4*)(Kg + ((size_t)nn * 64 + lrow) * 64 + lcc * 8); vx[h] = *(const u32x4*)(Vg + (size_t)lrow * 2048 + nn * 64 + lcc * 8); } }
                bf16x8 pf[2][2][2]; bool act[2][2];
#pragma unroll
                for (int h = 0; h < 2; ++h) {
                    const int n = na + h; const bool nvalid = (n <= i);
                    const bool edge = (n == i) || (br == 1 && n == i - 4);
                    LAS bf16_t* Kt = Tc + h * 9216;
#pragma unroll
                    for (int qt = 0; qt < 2; ++qt) {
                        const bool bsel = nvalid && ((br == 1) || ((sm[qt] >> n) & 1u));
                        act[h][qt] = nvalid && ((br == 1) || (__ballot(bsel) != 0ull));
                        pf[h][0][qt] = (bf16x8){0, 0, 0, 0, 0, 0, 0, 0}; pf[h][1][qt] = pf[h][0][qt];
                        if (act[h][qt]) {
                            const float sb = bsel ? slope2 * (float)(n * 64 + fq * 4 - tq[qt]) : -1e9f;
                            f32x4 S[4];
#pragma unroll
                            for (int kt = 0; kt < 4; ++kt) { S[kt] = (f32x4){sb + sc16[kt * 4], sb + sc16[kt * 4 + 1], sb + sc16[kt * 4 + 2], sb + sc16[kt * 4 + 3]};
#pragma unroll
                                for (int ks = 0; ks < 2; ++ks) { const bf16x8 kf = *(const LAS bf16x8*)(Kt + (kt * 16 + fr) * 72 + ks * 32 + fq * 8); S[kt] = mfma16(kf, Qf[qt][ks], S[kt]); } }
                            float ls = 0.f;
                            if (edge) {
#pragma unroll
                                for (int kt = 0; kt < 4; ++kt)
#pragma unroll
                                    for (int j = 0; j < 4; ++j) { const int pos = n * 64 + kt * 16 + fq * 4 + j; const bool valid = (pos <= tq[qt]) && (br == 0 || pos > tq[qt] - 256);
                                        const float pv = valid ? __builtin_amdgcn_exp2f(S[kt][j]) : 0.f; S[kt][j] = pv; ls += pv; }
                            } else {
#pragma unroll
                                for (int kt = 0; kt < 4; ++kt)
#pragma unroll
                                    for (int j = 0; j < 4; ++j) { const float pv = __builtin_amdgcn_exp2f(S[kt][j]); S[kt][j] = pv; ls += pv; }
                            }
                            lrun[qt] += ls;
#pragma unroll
                            for (int s = 0; s < 2; ++s) { u32x4 t; t.x = pk2(S[2 * s][0], S[2 * s][1]); t.y = pk2(S[2 * s][2], S[2 * s][3]); t.z = pk2(S[2 * s + 1][0], S[2 * s + 1][1]); t.w = pk2(S[2 * s + 1][2], S[2 * s + 1][3]); pf[h][s][qt] = __builtin_bit_cast(bf16x8, t); }
                        }
                    }
                }
#pragma unroll
                for (int h = 0; h < 2; ++h) {
                    LAS bf16_t* VtT = Tc + h * 9216 + 4608;
                    if (act[h][0] || act[h][1]) {
#pragma unroll
                        for (int s = 0; s < 2; ++s)
#pragma unroll
                            for (int dt = 0; dt < 4; ++dt) { u32x4 t; const u32x2 v0 = *(const LAS u32x2*)(VtT + (dt * 16 + fr) * 72 + s * 32 + fq * 4), v1 = *(const LAS u32x2*)(VtT + (dt * 16 + fr) * 72 + s * 32 + 16 + fq * 4);
                                t.x = v0.x; t.y = v0.y; t.z = v1.x; t.w = v1.y; const bf16x8 vf = __builtin_bit_cast(bf16x8, t);
#pragma unroll
                                for (int qt = 0; qt < 2; ++qt) if (act[h][qt]) O[dt][qt] = mfma16(vf, pf[h][s][qt], O[dt][qt]); } }
                }
                if (pi + 1 < npair) {
#pragma unroll
                    for (int h = 0; h < 2; ++h) { *(LAS u32x4*)(Tn + h * 9216 + lrow * 72 + lcc * 8) = kx[h]; *(LAS u32x4*)(Tn + h * 9216 + 4608 + lrow * 72 + lcc * 8) = vx[h]; } }
                __syncthreads();
            }
#pragma unroll
            for (int qt = 0; qt < 2; ++qt) { float l = lrun[qt]; l += __shfl_xor(l, 16); l += __shfl_xor(l, 32); const float sc = (br == 0 ? g1[qt] : g2[qt]) / l;
#pragma unroll
                for (int dt = 0; dt < 4; ++dt) outacc[dt][qt] = outacc[dt][qt] + O[dt][qt] * sc; }
        }
#pragma unroll
        for (int qt = 0; qt < 2; ++qt)
#pragma unroll
            for (int dt = 0; dt < 4; ++dt) { u32x2 o; o.x = pk2(outacc[dt][qt][0], outacc[dt][qt][1]); o.y = pk2(outacc[dt][qt][2], outacc[dt][qt][3]);
                *(u32x2*)(AO + (tokb + qh * 32 + qt * 16 + fr) * 1024 + hd * 64 + dt * 16 + fq * 4) = o; }
        __syncthreads();
    }
}

DI void weight_prep(const int tid, LAS unsigned char* lds, const P& p, int G, int c, bool late) {
    unsigned char* ws = p.ws;
    {
        const int nu[13] = {224, 64, 4, 176, 64, 32, 32, 4, 4, 352, 352, 176, 176};
        int total = 0;
#pragma unroll
        for (int m = 0; m < 13; ++m) total += nu[m];
        const int u_lo = late ? nu[0] : 0, u_hi = late ? total : nu[0];
        for (int gu = u_lo + c; gu < u_hi; gu += G) {
            int m = 0, u = gu;
#pragma unroll
            for (int q = 0; q < 12; ++q) if (m == q && u >= nu[q]) { u -= nu[q]; m = q + 1; }
            const float* s; bf16_t* d; int K, N; bool perm = false;
            switch (m) {
            case 0: s = p.in[1]; d = (bf16_t*)(ws + W_AB_IN); K = 1024; N = AB_IN; break;
            case 1: s = p.in[2]; d = (bf16_t*)(ws + W_AB_OUT); K = 1024; N = 1024; break;
            case 2: s = p.in[11]; d = (bf16_t*)(ws + W_GLU); K = 256; N = 256; break;
            case 3: s = p.in[17]; d = (bf16_t*)(ws + W_NSA_IN); K = 1024; N = NSA_IN; break;
            case 4: s = p.in[18]; d = (bf16_t*)(ws + W_NSA_OUT); K = 1024; N = 1024; break;
            case 5: s = p.in[21]; d = (bf16_t*)(ws + W_KW1); K = 2048; N = 256; break;
            case 6: s = p.in[24]; d = (bf16_t*)(ws + W_VW1); K = 2048; N = 256; break;
            case 7: s = p.in[23]; d = (bf16_t*)(ws + W_KW2); K = 256; N = 64; break;
            case 8: s = p.in[26]; d = (bf16_t*)(ws + W_VW2); K = 256; N = 64; break;
            case 9: s = p.in[27]; d = (bf16_t*)(ws + W_FFN_IN); K = 1024; N = FF2; perm = true; break;
            case 10: s = p.in[27] + (size_t)1024 * FF2; d = (bf16_t*)(ws + W_FFN_IN) + (size_t)FF2 * 1024; K = 1024; N = FF2; perm = true; break;
            case 11: s = p.in[30]; d = (bf16_t*)(ws + W_FFN_OUT); K = FFH; N = 1024; break;
            default: s = p.in[30] + (size_t)FFH * 1024; d = (bf16_t*)(ws + W_FFN_OUT) + (size_t)1024 * FFH; K = FFH; N = 1024; break;
            }
            prep_unit(tid, lds, s, d, K, N, u, perm);
        }
    }
}
DI void prologue_phase(const int tid, LAS unsigned char* lds, const P& p, int G, int c) {
    unsigned char* ws = p.ws;
    weight_prep(tid, lds, p, G, c, false);
    if (c == G - 1) {
        float* abar = (float*)(ws + W_S5AB); float* bbar = (float*)(ws + W_S5BB); bf16_t* ccat = (bf16_t*)(ws + W_S5CC);
        for (int idx = tid; idx < 1024; idx += 512) { const int g = idx >> 6;
            const float step = expf(p.in[5][g]), lr = p.in[3][idx], li = p.in[4][idx];
            const float mag = expf(lr * step), are = mag * cosf(li * step), aim = mag * sinf(li * step);
            const float den = lr * lr + li * li, nre = are - 1.f, nim = aim;
            const float zre = (nre * lr + nim * li) / den, zim = (nim * lr - nre * li) / den;
            abar[idx * 2] = are; abar[idx * 2 + 1] = aim;
            for (int h = 0; h < 16; ++h) { const float br = p.in[6][idx * 16 + h], bi = p.in[7][idx * 16 + h]; bbar[idx * 32 + h] = zre * br - zim * bi; bbar[idx * 32 + 16 + h] = zre * bi + zim * br; } }
        for (int idx = tid; idx < 16 * 16 * 128; idx += 512) { const int k = idx & 127, gh = idx >> 7;
            ccat[idx] = f2bf(k < 64 ? p.in[8][gh * 64 + k] : p.in[9][gh * 64 + k - 64]); }
        if (tid < 64) ((unsigned*)(ws + W_CTR))[tid] = 0u;
    }
    if (c < 32) {
        const int kv = c >> 4, sl = c & 15, n = tid & 255, hf = tid >> 8; const float* pe = p.in[kv ? 20 : 19]; const float* w1 = p.in[kv ? 24 : 21];
        float wv[64];
#pragma unroll
        for (int k = 0; k < 64; ++k) wv[k] = w1[(size_t)(sl * 128 + hf * 64 + k) * 256 + n];
        float acc = 0.f;
#pragma unroll
        for (int k = 0; k < 64; ++k) acc += pe[sl * 128 + hf * 64 + k] * wv[k];
        ((float*)(ws + W_B1PART))[((kv * 16 + sl) * 2 + hf) * 256 + n] = acc;
    }
    rms_phase(tid, p.in[0], p.in[31], (bf16_t*)(ws + A_HN), G, c);
}

#define XB_TMO      128
#define XB_XCNT(j)  (256  + 64 * (j))
#define XB_XSUB(j)  (1280 + 64 * (j))
#define XB_XGEN(j)  (2304 + 64 * (j))
#define XB_TOP      3328
#define XB_TOPGEN   3392
#define XCD_BAR_WORDS 3456
#define XB_SPIN_CAP (1u << 20)
DI unsigned xb_ld(unsigned* p)              { return __hip_atomic_load(p, __ATOMIC_RELAXED, __HIP_MEMORY_SCOPE_AGENT); }
DI unsigned xb_add(unsigned* p, unsigned v) { return __hip_atomic_fetch_add(p, v, __ATOMIC_RELAXED, __HIP_MEMORY_SCOPE_AGENT); }
DI unsigned xb_xcc_id() { return (unsigned)__builtin_amdgcn_s_getreg((3 << 11) | 20) & 0xFu; }
#define XB_SPIN(cond, bar) do { unsigned _sp = 0; while (cond) { __builtin_amdgcn_s_sleep(1); \
    if ((++_sp & 255u) == 0u) { if (xb_ld(&(bar)[XB_TMO])) break; if (_sp > XB_SPIN_CAP) { atomicAdd(&(bar)[XB_TMO], 1u); break; } } } } while (0)
struct XcdBarrier { unsigned* bar; unsigned x; volatile LAS unsigned* st; };
DI XcdBarrier xcd_barrier_post(unsigned* bar, volatile LAS unsigned* st) {
    XcdBarrier b; b.bar = bar; b.x = xb_xcc_id(); b.st = st;
    if (threadIdx.x == 0) (void)xb_add(&bar[XB_XCNT(b.x)], 1u);
    return b;
}
DI void xcd_barrier_complete(unsigned* bar, unsigned x, unsigned& nloc, unsigned& nx) {
    const unsigned G = gridDim.x * gridDim.y * gridDim.z;
    unsigned sum, cnt, mine, sp = 0u;
    for (;;) {
        sum = 0u; cnt = 0u; mine = 0u;
#pragma unroll
        for (unsigned j = 0; j < 16; ++j) { const unsigned c = xb_ld(&bar[XB_XCNT(j)]); sum += c; cnt += (c > 0u) ? 1u : 0u; mine = (j == x) ? c : mine; }
        if (sum == G) break;
        __builtin_amdgcn_s_sleep(1);
        if ((++sp & 255u) == 0u) { if (xb_ld(&bar[XB_TMO])) break; if (sp > XB_SPIN_CAP) { atomicAdd(&bar[XB_TMO], 1u); break; } }
    }
    nloc = mine > 0u ? mine : 1u; nx = cnt > 0u ? cnt : 1u;
}
DI void xcd_barrier(const XcdBarrier& b) {
    asm volatile("s_waitcnt vmcnt(0)" ::: "memory");
    __syncthreads();
    if (threadIdx.x == 0) {
        unsigned* bar = b.bar;
        __builtin_amdgcn_s_waitcnt(0);
        unsigned nloc = b.st[0], nx = b.st[1];
        if (nloc == 0u) { xcd_barrier_complete(bar, b.x, nloc, nx); b.st[0] = nloc; b.st[1] = nx; }
        const unsigned old = xb_add(&bar[XB_XSUB(b.x)], 1u);
        const unsigned gen = old / nloc;
        if (old + 1u == (gen + 1u) * nloc) {
            __builtin_amdgcn_fence(__ATOMIC_RELEASE, "agent");
            asm volatile("s_waitcnt vmcnt(0)" ::: "memory");
            const unsigned og = xb_add(&bar[XB_TOP], 1u);
            const unsigned tg = og / nx;
            if (og + 1u == (tg + 1u) * nx) xb_add(&bar[XB_TOPGEN], 1u);
            else XB_SPIN(xb_ld(&bar[XB_TOPGEN]) == tg, bar);
            __builtin_amdgcn_fence(__ATOMIC_ACQUIRE, "agent");
            xb_add(&bar[XB_XGEN(b.x)], 1u);
            asm volatile("s_waitcnt vmcnt(0)" ::: "memory");
        } else {
            XB_SPIN(xb_ld(&bar[XB_XGEN(b.x)]) == gen, bar);
            __builtin_amdgcn_fence(__ATOMIC_ACQUIRE, "agent");
            asm volatile("s_waitcnt vmcnt(0)" ::: "memory");
        }
    }
    __syncthreads();
}

constexpr int EXTRA_SEAMS = 0;
constexpr bool DUP_BARRIER = false;
constexpr bool FUSE_RMS_TAIL = false;
constexpr int SUBDUP = 0;
constexpr unsigned DUP_MASK = 0u;
__global__ void __launch_bounds__(512, 2) mega(P p, int ph_lo, int ph_hi, unsigned ph_mask) {
    extern __shared__ __attribute__((aligned(16))) unsigned char lds_raw[];
    LAS unsigned char* lds = (LAS unsigned char*)lds_raw;
    cg::grid_group grid = cg::this_grid();
    const int G = gridDim.x, c = blockIdx.x;
    unsigned char* ws = p.ws;
    volatile LAS unsigned* xbst = (volatile LAS unsigned*)(lds + LDS_BYTES - 16);
    if (threadIdx.x < 4) xbst[threadIdx.x] = 0u;
    __syncthreads();
    const XcdBarrier xbar = xcd_barrier_post((unsigned*)(ws + W_BAR), xbst);
    if (ph_lo > 1000) grid.sync();
#pragma unroll 1
    for (int ph2 = ph_lo * 2; ph2 < ph_hi * 2; ++ph2) {
        const int ph = ph2 >> 1;
        if (ph == 9 || ph == 10 || ph == 21 || ph == 22) continue;
        if (FUSE_RMS_TAIL && (ph == 6 || ph == 12 || ph == 18 || ph == 24)) continue;
        if ((ph2 & 1) && !((DUP_MASK >> ph) & 1u)) continue;
        if (ph2 & 1) __syncthreads();
        int tid = threadIdx.x; asm volatile("" : "+v"(tid));
        int kind = ph, layer = 0, sub = 0;
        if (ph >= 6 && ph <= 11) { kind = 100; layer = 0; sub = ph - 6; }
        if (ph >= 18 && ph <= 23) { kind = 100; layer = 1; sub = ph - 18; }
        if (kind == 100) kind = (sub == 0) ? 100 : (sub == 5) ? 103 : (sub & 1) ? 101 : 102;
        const int half = (sub - 1) >> 1;
        bool gdirect = false; const float* tail_g = nullptr; bf16_t* tail_dst = nullptr; bool tail = false;
        bool is_gemm = false; const bf16_t* gA = nullptr; const bf16_t* gB = nullptr; int lda = 0, ldb = 0, gM = 0, gN = 0, gK = 0, gG = G, gc = c;
        Epi E{};
        if (!((ph_mask >> ph) & 1u)) kind = -1;
        switch (kind) {
        case 0: prologue_phase(tid, lds, p, G, c); break;
        case 1: {
            is_gemm = true; E.kind = EK_ABIN; E.d0 = (bf16_t*)(ws + A_US5); E.d1 = (bf16_t*)(ws + A_QKV); E.d2 = (bf16_t*)(ws + A_Z); E.f0 = (float*)(ws + A_BLAL);
            gA = (const bf16_t*)(ws + A_HN); lda = 1024; gB = (const bf16_t*)(ws + W_AB_IN); ldb = 1024; gM = MTOK; gN = AB_IN_P; gK = 1024; } break;
        case 2: for (int rp = 0; rp < ((SUBDUP & 1) ? 2 : 1); ++rp) { s5_pass<false>(tid, lds, p, G, c); __syncthreads(); }
                for (int rp = 0; rp < ((SUBDUP & 2) ? 2 : 1); ++rp) { gdn_prep_phase(tid, lds, p, G, c); __syncthreads(); } break;
        case 3: if (c == G - 1) { const int t = tid; const int kv = t >> 8, n = t & 255; float a = p.in[kv ? 25 : 22][n];
                    for (int s = 0; s < 32; ++s) a += ((const float*)(ws + W_B1PART))[(kv * 32 + s) * 256 + n];
                    ((float*)(ws + W_B1P))[kv * 256 + n] = a; }
                if (G > 192) { if (c >= 192) weight_prep(tid, lds, p, G - 192, c - 192, true); } else weight_prep(tid, lds, p, G, c, true);
                __syncthreads();
                for (int rp = 0; rp < ((SUBDUP & 4) ? 2 : 1); ++rp) { gdn_seq_phase(tid, lds, p, G, c); __syncthreads(); }
                for (int rp = 0; rp < ((SUBDUP & 8) ? 2 : 1); ++rp) { s5_pass<true>(tid, lds, p, G, (c + G - 192 % G) % G); __syncthreads(); } break;
        case 4: is_gemm = true; E.kind = EK_GLU; E.cb0 = (const bf16_t*)(ws + A_ZS5); E.cf0 = p.in[12]; E.d0 = (bf16_t*)(ws + A_YCAT);
            gA = (const bf16_t*)(ws + A_ZS5); lda = 256; gB = (const bf16_t*)(ws + W_GLU); ldb = 256; gM = MTOK; gN = 256; gK = 256; break;
        case 5: is_gemm = true; E.kind = EK_RESID; E.cf0 = p.in[0]; E.f0 = p.out; gdirect = FUSE_RMS_TAIL; tail = FUSE_RMS_TAIL; tail_g = p.in[32]; tail_dst = (bf16_t*)(ws + F_HN);
            gA = (const bf16_t*)(ws + A_YCAT); lda = 1024; gB = (const bf16_t*)(ws + W_AB_OUT); ldb = 1024; gM = MTOK; gN = 1024; gK = 1024; break;
        case 12: rms_phase(tid, p.out, p.in[31] + 1024, (bf16_t*)(ws + N_HN), G, c); break;
        case 13: is_gemm = true; E.kind = EK_NSAIN; E.d0 = (bf16_t*)(ws + N_Q); E.d1 = (bf16_t*)(ws + N_KC); E.f0 = (float*)(ws + N_GATES);
            gA = (const bf16_t*)(ws + N_HN); lda = 1024; gB = (const bf16_t*)(ws + W_NSA_IN); ldb = 1024; gM = MTOK; gN = NSA_IN_P; gK = 1024; break;
        case 14: { const int kv = (c >= G / 2); is_gemm = true; E.kind = EK_CMP1; E.d0 = (bf16_t*)(ws + (kv ? N_H1V : N_H1K)); E.cf0 = (const float*)(ws + W_B1P) + kv * 256;
            gA = (const bf16_t*)(ws + (kv ? N_VC : N_KC)); lda = 1024; gB = (const bf16_t*)(ws + (kv ? W_VW1 : W_KW1)); ldb = 2048; gM = 16384; gN = 256; gK = 2048; gG = G / 2; gc = kv ? c - G / 2 : c; } break;
        case 15: { const int kv = (c >= G / 2); is_gemm = true; E.kind = EK_CMP2; E.flag = kv; E.d0 = (bf16_t*)(ws + (kv ? N_VCMPT : N_KCMP));
            gA = (const bf16_t*)(ws + (kv ? N_H1V : N_H1K)); lda = 256; gB = (const bf16_t*)(ws + (kv ? W_VW2 : W_KW2)); ldb = 256; gM = 16384; gN = 256; gK = 256; gG = G / 2; gc = kv ? c - G / 2 : c; } break;
        case 16: nsa_attn_phase(tid, lds, p, G, c); break;
        case 17: is_gemm = true; E.kind = EK_RESID; E.cf0 = p.out; E.f0 = p.out; gdirect = FUSE_RMS_TAIL; tail = FUSE_RMS_TAIL; tail_g = p.in[32] + 1024; tail_dst = (bf16_t*)(ws + F_HN);
            gA = (const bf16_t*)(ws + N_AO); lda = 1024; gB = (const bf16_t*)(ws + W_NSA_OUT); ldb = 1024; gM = MTOK; gN = 1024; gK = 1024; break;
        case 100: rms_phase(tid, p.out, p.in[32] + layer * 1024, (bf16_t*)(ws + F_HN), G, c); break;
        case 101: is_gemm = true; E.kind = EK_FFNUP; E.d0 = (bf16_t*)(ws + F_ACT); E.f0 = (float*)(ws + F_HB); E.cf0 = p.in[28] + (size_t)layer * 3 * FF2; E.cf1 = p.in[29] + (size_t)layer * FF2;
            gA = (const bf16_t*)(ws + F_HN); lda = 1024; gB = (const bf16_t*)(ws + W_FFN_IN) + (size_t)layer * FF2 * 1024; ldb = 1024; gM = MTOK; gN = FF2; gK = 1024; break;
        case 102: ffn_fix_phase(tid, p, layer, G, c); break;
        case 103: is_gemm = true; E.kind = EK_RESID; E.cf0 = p.out; E.f0 = p.out; gdirect = FUSE_RMS_TAIL; tail = FUSE_RMS_TAIL; if (layer == 0) { tail_g = p.in[31] + 1024; tail_dst = (bf16_t*)(ws + N_HN); } else { tail_g = p.in[33]; tail_dst = nullptr; }
            gA = (const bf16_t*)(ws + F_ACT); lda = FFH; gB = (const bf16_t*)(ws + W_FFN_OUT) + (size_t)layer * 1024 * FFH; ldb = FFH; gM = MTOK; gN = 1024; gK = FFH; break;
        case 24: rms_final(tid, p.out, p.in[33], G, c); break;
        default: break;
        }
        if (is_gemm) pg8::gemm_phase(tid, lds, gA, lda, gB, ldb, gM, gN, gK, gG, gc, gdirect, E);
        if (tail) {
            asm volatile("s_waitcnt vmcnt(0)" ::: "memory"); __syncthreads();
            __builtin_amdgcn_fence(__ATOMIC_ACQUIRE, "agent"); asm volatile("s_waitcnt vmcnt(0)" ::: "memory");
            rms_owned(tid, p.out, tail_g, tail_dst, G, c);
        }
        if (!(ph2 & 1) && ((DUP_MASK >> ph) & 1u)) { if (DUP_BARRIER) xcd_barrier(xbar); continue; }
        for (int xs = 0; xs < ((ph == 0) ? EXTRA_SEAMS : 0); ++xs) xcd_barrier(xbar);
        if (ph + 1 < ph_hi) xcd_barrier(xbar);
    }
}
constexpr int N_PHASES = 25;

extern "C" void kernel_launch(void* const* d_in, const int* in_sizes, int n_in, void* d_out, int out_size, void* d_ws, size_t ws_size, hipStream_t stream) {
    static int grid = 0;
    if (grid == 0) {
        int dev = 0, cus = 0, per_cu = 0;
        hipGetDevice(&dev); hipDeviceGetAttribute(&cus, hipDeviceAttributeMultiprocessorCount, dev);
        if (hipFuncSetAttribute((const void*)mega, hipFuncAttributeMaxDynamicSharedMemorySize, LDS_BYTES) != hipSuccess) fprintf(stderr, "hipFuncSetAttribute failed\n");
        if (hipOccupancyMaxActiveBlocksPerMultiprocessor(&per_cu, (const void*)mega, 512, LDS_BYTES) != hipSuccess || per_cu < 1) { fprintf(stderr, "occupancy query: %d\n", per_cu); per_cu = 1; }
        (void)hipGetLastError();
        grid = cus;
        if (ws_size < 1024 * MiB) fprintf(stderr, "workspace too small: %zu\n", ws_size);
    }
    P p{};
    for (int i = 0; i < 34; ++i) p.in[i] = (const float*)d_in[i];
    p.out = (float*)d_out; p.ws = (unsigned char*)d_ws;
    int lo = 0, hi = N_PHASES; unsigned mask = 0xFFFFFFFFu;
    void* args[] = {&p, &lo, &hi, &mask};
    if (hipMemsetAsync((unsigned char*)d_ws + W_BAR, 0, XCD_BAR_WORDS * 4, stream) != hipSuccess) fprintf(stderr, "memset of barrier words failed\n");
    hipError_t e = hipLaunchCooperativeKernel((const void*)mega, dim3(grid), dim3(512), args, LDS_BYTES, stream);
    if (e != hipSuccess) fprintf(stderr, "cooperative launch failed: %s (grid %d)\n", hipGetErrorString(e), grid);
}
```

```cpp
#include <hip/hip_runtime.h>
#include <hip/hip_cooperative_groups.h>
#include <cstdio>
namespace cg = cooperative_groups;

#define LAS __attribute__((address_space(3)))
#define DI __device__ __forceinline__
typedef unsigned short bf16_t;
typedef short bf16x8 __attribute__((ext_vector_type(8)));
typedef short bf16x4 __attribute__((ext_vector_type(4)));
typedef float f32x4 __attribute__((ext_vector_type(4)));
typedef float f32x2 __attribute__((ext_vector_type(2)));
typedef unsigned u32x4 __attribute__((ext_vector_type(4)));
typedef unsigned u32x2 __attribute__((ext_vector_type(2)));

constexpr int MTOK = 65536, DM = 1024, SEQ = 2048, NB = 32;
constexpr int AB_IN = 3340, AB_IN_P = 3584, NSA_IN = 2608, NSA_IN_P = 2816, FF2 = 5632, FFH = 2816;
constexpr int LDS_BYTES = 147456;

constexpr size_t MiB = 1048576;
constexpr size_t W_AB_IN = 0;
constexpr size_t W_AB_OUT = W_AB_IN + (size_t)AB_IN_P * 1024 * 2;
constexpr size_t W_GLU = W_AB_OUT + 2 * MiB;
constexpr size_t W_NSA_IN = W_GLU + 131072;
constexpr size_t W_NSA_OUT = W_NSA_IN + (size_t)NSA_IN_P * 1024 * 2;
constexpr size_t W_KW1 = W_NSA_OUT + 2 * MiB;
constexpr size_t W_VW1 = W_KW1 + MiB;
constexpr size_t W_KW2 = W_VW1 + MiB;
constexpr size_t W_VW2 = W_KW2 + 131072;
constexpr size_t W_FFN_IN = W_VW2 + 131072;
constexpr size_t W_FFN_OUT = W_FFN_IN + 2 * (size_t)FF2 * 1024 * 2;
constexpr size_t W_S5AB = W_FFN_OUT + 2 * (size_t)1024 * FFH * 2;
constexpr size_t W_S5BB = W_S5AB + 8192;
constexpr size_t W_S5CC = W_S5BB + 131072;
constexpr size_t W_B1P = W_S5CC + 65536;
constexpr size_t W_B1PART = W_B1P + 2048;
constexpr size_t W_CTR = W_B1PART + 65536;
constexpr size_t W_BAR = W_CTR + 4096;
constexpr size_t W_END = W_BAR + 16384;
static_assert(W_END <= 64 * MiB, "weights region");
constexpr size_t ACT = 64 * MiB;
constexpr size_t A_QKV = ACT;
constexpr size_t A_YCAT = ACT;
constexpr size_t A_Z = A_QKV + 288 * MiB;
constexpr size_t A_US5 = A_Z + 96 * MiB;
constexpr size_t A_ZS5 = A_US5 + 32 * MiB;
constexpr size_t A_BLAL = A_ZS5 + 32 * MiB;
constexpr size_t A_S5END = A_BLAL + 4 * MiB;
constexpr size_t A_CHUNK = A_S5END + 2 * MiB;
constexpr size_t A_HN = A_CHUNK;
constexpr size_t CH_U = A_CHUNK, CH_W = CH_U + 96 * MiB, CH_QD = CH_W + 96 * MiB, CH_KDT = CH_QD + 96 * MiB, CH_INTRA = CH_KDT + 96 * MiB, CH_GL = CH_INTRA + 48 * MiB;
static_assert(CH_GL + MiB <= 1024 * MiB, "ws");
constexpr size_t F_HN = ACT;
constexpr size_t F_UP = F_HN + 128 * MiB;
constexpr size_t F_HB = F_UP;
constexpr size_t F_ACT = F_UP + 352 * MiB;
static_assert(F_ACT + 352 * MiB <= 1024 * MiB, "ws");
constexpr size_t N_HN = ACT;
constexpr size_t N_Q = N_HN + 128 * MiB;
constexpr size_t N_KC = N_Q + 128 * MiB;
constexpr size_t N_VC = N_KC + 32 * MiB;
constexpr size_t N_KS = N_VC + 32 * MiB;
constexpr size_t N_VST = N_KS + 32 * MiB;
constexpr size_t N_KW = N_VST + 32 * MiB;
constexpr size_t N_VWT = N_KW + 32 * MiB;
constexpr size_t N_GATES = N_VWT + 32 * MiB;
constexpr size_t N_H1K = N_GATES + 12 * MiB;
constexpr size_t N_H1V = N_H1K + 8 * MiB;
constexpr size_t N_KCMP = N_H1V + 8 * MiB;
constexpr size_t N_VCMPT = N_KCMP + 2 * MiB;
constexpr size_t N_AO = N_VCMPT + 2 * MiB;

struct P { const float* in[34]; float* out; unsigned char* ws; };

DI float bf2f(bf16_t b) { return __uint_as_float(((unsigned)b) << 16); }
DI bf16_t f2bf(float f) { return __builtin_bit_cast(bf16_t, (__bf16)f); }
typedef __bf16 bf16v2_t __attribute__((ext_vector_type(2)));
DI unsigned pk2(float lo, float hi) { bf16v2_t v; v.x = (__bf16)lo; v.y = (__bf16)hi; return __builtin_bit_cast(unsigned, v); }
DI float lo16(unsigned u) { return __uint_as_float(u << 16); }
DI float hi16(unsigned u) { return __uint_as_float(u & 0xffff0000u); }
DI float sigmoidf_(float x) { return 1.f / (1.f + __expf(-x)); }
DI float siluf_(float x) { return x / (1.f + __expf(-x)); }
DI float silu_fast(float x) { return x * __builtin_amdgcn_rcpf(1.f + __expf(-x)); }
DI float gelu_tanh(float x) { float u = 0.7978845608028654f * (x + 0.044715f * x * x * x); float e = __expf(2.f * u); float th = 1.f - 2.f / (e + 1.f); return 0.5f * x * (1.f + th); }
DI float wave_sum(float v) { for (int o = 32; o > 0; o >>= 1) v += __shfl_xor(v, o); return v; }
DI f32x4 mfma16(bf16x8 a, bf16x8 b, f32x4 c) { return __builtin_amdgcn_mfma_f32_16x16x32_bf16(a, b, c, 0, 0, 0); }
DI void lds_wait() { asm volatile("s_waitcnt lgkmcnt(0)" ::: "memory"); }

DI void st8bf(bf16_t* dst, f32x4 v0, f32x4 v1);
namespace pg8 {
constexpr int BM = 256, BK = 64, HALF = 128, HTB = HALF * BK * 2, STAGE_BYTES = 8 * HTB, NXCD = 8, WGM = 8;
DI int lds_byte(int r, int c) { const int st = (r >> 4) * 2 + (c >> 5), rr = r & 15, cc = c & 31, ob = rr * 64 + cc * 2; return st * 1024 + (ob ^ (((ob >> 9) & 1) << 5)); }
DI void stage_rc(int b, int& R, int& C) { const int st = b / 1024, sb = b % 1024, swz = sb ^ (((sb >> 9) & 1) << 5); R = (st >> 1) * 16 + swz / 64; C = (st & 1) * 32 + (swz % 64) / 2; }
DI int perm32(int rho) { const int n = rho >> 4, i = rho & 15; return 8 * (i >> 2) + 4 * n + (i & 3); }
struct Unit { int pm, pn; };
struct Order {
    int nM, nN, nwg, G, c; bool direct;
    DI void init(int M, int N, int G_, int c_, bool d_) { nM = M / BM; nN = N / BM; nwg = nM * nN; G = G_; c = c_; direct = d_; }
    DI bool next(int i, Unit& u) const {
        if (direct) { const int pm = c + (i / nN) * G; if (pm >= nM) return false; u.pm = pm; u.pn = i % nN; return true; }
        const long L = (long)i * G + c; if (L >= nwg) return false;
        int wgid = (int)L; { const int q = nwg / NXCD, r = nwg % NXCD, xcd = wgid % NXCD, off = wgid / NXCD; wgid = (xcd < r ? xcd * (q + 1) : r * (q + 1) + (xcd - r) * q) + off; }
        const int nig = WGM * nN, gid = wgid / nig, fm = gid * WGM, gsz = (nM - fm) < WGM ? (nM - fm) : WGM;
        u.pm = fm + ((wgid % nig) % gsz); u.pn = (wgid % nig) / gsz; return true;
    }
};
template <class F>
DI void gemm_phase(const int tid, LAS unsigned char* lds, const bf16_t* Ap, int lda, const bf16_t* Bp, int ldb, int M, int N, int K, int G, int c, bool direct, const F& E) {
    const int wid = __builtin_amdgcn_readfirstlane(tid >> 6), lane = tid & 63, wr = wid >> 2, wc = wid & 3, fr = lane & 15, fq = lane >> 4;
    const int nt = K / BK;
    Order S; S.init(M, N, G, c, direct);
    unsigned voffA[2], voffB[2];
#pragma unroll
    for (int i = 0; i < 2; ++i) { int R, C; stage_rc(tid * 16 + i * 8192, R, C); const int Rb = (R & ~31) + perm32(R & 31);
        voffA[i] = (unsigned)(R * lda + C) * 2u; voffB[i] = (unsigned)(Rb * ldb + C) * 2u; }
    const size_t kstep = (size_t)(BK * 2);
    const size_t hsA = (size_t)HALF * lda * 2, hsB = (size_t)HALF * ldb * 2;
    const size_t tsA = 2 * hsA, tsB = 2 * hsB;
    const unsigned ldsw = (unsigned)wid * 1024u;
    const int aoff = lds_byte(wr * 64 + fr, fq * 8), boff = lds_byte(wc * 32 + fr, fq * 8);
#define PG8_SA(b, h) (((b) * 2 + (h)) * HTB)
#define PG8_SB(b, h) ((4 + (b) * 2 + (h)) * HTB)
#define PG8_STAGE(bufoff, gbase, voff) do { _Pragma("unroll") for (int _i = 0; _i < 2; ++_i) \
        __builtin_amdgcn_global_load_lds((const unsigned*)((const char*)(gbase) + (voff)[_i]), (LAS unsigned*)(lds + (bufoff) + ldsw + _i * 8192), 16, 0, 0); } while (0)
#define PG8_LDA(dst, b, h) do { _Pragma("unroll") for (int m = 0; m < 4; ++m) _Pragma("unroll") for (int k = 0; k < 2; ++k) dst[m][k] = *(const LAS bf16x8*)(lds + PG8_SA(b, h) + aoff + m * 2048 + k * 1024); } while (0)
#define PG8_LDB(dst, b, h) do { _Pragma("unroll") for (int n = 0; n < 2; ++n) _Pragma("unroll") for (int k = 0; k < 2; ++k) dst[n][k] = *(const LAS bf16x8*)(lds + PG8_SB(b, h) + boff + n * 2048 + k * 1024); } while (0)
#define PG8_MMA(ai, bj, At, Bt) do { __builtin_amdgcn_s_setprio(1); _Pragma("unroll") for (int m = 0; m < 4; ++m) _Pragma("unroll") for (int n = 0; n < 2; ++n) _Pragma("unroll") for (int k = 0; k < 2; ++k) \
        acc[ai][bj][m][n] = __builtin_amdgcn_mfma_f32_16x16x32_bf16(Bt[n][k], At[m][k], acc[ai][bj][m][n], 0, 0, 0); __builtin_amdgcn_s_setprio(0); } while (0)
#define PG8_WAIT_V(n) asm volatile("s_waitcnt vmcnt(" #n ")" ::: "memory")
#define PG8_WAIT_L(n) asm volatile("s_waitcnt lgkmcnt(" #n ")" ::: "memory")
#define PG8_BAR __builtin_amdgcn_s_barrier()
#define PG8_SCHED __builtin_amdgcn_sched_barrier(0)
    Unit cur, nxt; int ui = 0;
    if (!S.next(0, cur)) return;
    f32x4 acc[2][2][4][2];
#pragma unroll
    for (int a = 0; a < 2; ++a)
#pragma unroll
        for (int b = 0; b < 2; ++b)
#pragma unroll
            for (int m = 0; m < 4; ++m)
#pragma unroll
                for (int n = 0; n < 2; ++n) acc[a][b][m][n] = (f32x4){0.f, 0.f, 0.f, 0.f};
    bf16x8 At[4][2], B0[2][2], B1[2][2];
    const char* cA = (const char*)Ap + (size_t)cur.pm * tsA; const char* cB = (const char*)Bp + (size_t)cur.pn * tsB;
    PG8_STAGE(PG8_SB(0, 0), cB, voffB); PG8_STAGE(PG8_SA(0, 0), cA, voffA); PG8_STAGE(PG8_SB(0, 1), cB + hsB, voffB); PG8_STAGE(PG8_SA(0, 1), cA + hsA, voffA);
    if (wr == 1) PG8_BAR;
    PG8_WAIT_V(4); PG8_BAR;
    PG8_STAGE(PG8_SB(1, 0), cB + kstep, voffB); PG8_STAGE(PG8_SA(1, 0), cA + kstep, voffA); PG8_STAGE(PG8_SB(1, 1), cB + hsB + kstep, voffB);
    PG8_WAIT_V(6); PG8_BAR;
    for (;;) {
        const bool has_next = S.next(ui + 1, nxt);
        const char* nA = has_next ? (const char*)Ap + (size_t)nxt.pm * tsA : cA; const char* nB = has_next ? (const char*)Bp + (size_t)nxt.pn * tsB : cB;
        for (int t = 0; t < nt; t += 2) {
            const bool last = (t == nt - 2);
            const char* a1 = cA + (size_t)(t + 1) * kstep;
            const char* a2 = last ? nA : cA + (size_t)(t + 2) * kstep; const char* b2 = last ? nB : cB + (size_t)(t + 2) * kstep;
            const char* a3 = a2 + kstep; const char* b3 = b2 + kstep;
            PG8_LDB(B0, 0, 0); PG8_SCHED; PG8_LDA(At, 0, 0); PG8_STAGE(PG8_SA(1, 1), a1 + hsA, voffA);
            PG8_WAIT_L(8); PG8_BAR; PG8_WAIT_L(0); PG8_MMA(0, 0, At, B0); PG8_BAR; PG8_SCHED;
            PG8_LDB(B1, 0, 1); PG8_STAGE(PG8_SB(0, 0), b2, voffB);
            PG8_BAR; PG8_WAIT_L(0); PG8_MMA(0, 1, At, B1); PG8_BAR;
            PG8_LDA(At, 0, 1); PG8_STAGE(PG8_SA(0, 0), a2, voffA);
            PG8_BAR; PG8_WAIT_L(0); PG8_MMA(1, 0, At, B0); PG8_BAR; PG8_SCHED;
            PG8_STAGE(PG8_SB(0, 1), b2 + hsB, voffB);
            PG8_WAIT_V(6); PG8_BAR; PG8_MMA(1, 1, At, B1); PG8_BAR;
            PG8_LDB(B0, 1, 0); PG8_SCHED; PG8_LDA(At, 1, 0); PG8_STAGE(PG8_SA(0, 1), a2 + hsA, voffA);
            PG8_WAIT_L(8); PG8_BAR; PG8_WAIT_L(0); PG8_MMA(0, 0, At, B0); PG8_BAR; PG8_SCHED;
            PG8_LDB(B1, 1, 1); PG8_STAGE(PG8_SB(1, 0), b3, voffB);
            PG8_BAR; PG8_WAIT_L(0); PG8_MMA(0, 1, At, B1); PG8_BAR;
            PG8_LDA(At, 1, 1); PG8_STAGE(PG8_SA(1, 0), a3, voffA);
            PG8_BAR; PG8_WAIT_L(0); PG8_MMA(1, 0, At, B0); PG8_BAR; PG8_SCHED;
            PG8_STAGE(PG8_SB(1, 1), b3 + hsB, voffB);
            PG8_WAIT_V(6); PG8_BAR; PG8_MMA(1, 1, At, B1); PG8_BAR;
        }
        if (E.kind == 7  ) E.fused(acc, cur.pm, cur.pn, wr, wc, fr, fq);
        else if (E.kind == 3  ) {
            const int row0 = cur.pm * BM + wr * 64 + fr, col0 = cur.pn * BM + wc * 32 + 8 * fq;
            f32x4 b0[2], b1[2];
#pragma unroll
            for (int bj = 0; bj < 2; ++bj) { b0[bj] = *(const f32x4*)(E.cf0 + col0 + bj * HALF); b1[bj] = *(const f32x4*)(E.cf0 + col0 + bj * HALF + 4); }
#pragma unroll
            for (int ai = 0; ai < 2; ++ai) {
                u32x4 zz[4][2];
#pragma unroll
                for (int m = 0; m < 4; ++m)
#pragma unroll
                    for (int bj = 0; bj < 2; ++bj) zz[m][bj] = *(const u32x4*)(E.cb0 + (size_t)(row0 + ai * HALF + m * 16) * 256 + col0 + bj * HALF);
#pragma unroll
                for (int m = 0; m < 4; ++m)
#pragma unroll
                    for (int bj = 0; bj < 2; ++bj) { const f32x4 v0 = acc[ai][bj][m][0], v1 = acc[ai][bj][m][1]; const u32x4 z = zz[m][bj]; f32x4 o0, o1;
                        o0[0] = lo16(z.x) * sigmoidf_(v0[0] + b0[bj][0]); o0[1] = hi16(z.x) * sigmoidf_(v0[1] + b0[bj][1]); o0[2] = lo16(z.y) * sigmoidf_(v0[2] + b0[bj][2]); o0[3] = hi16(z.y) * sigmoidf_(v0[3] + b0[bj][3]);
                        o1[0] = lo16(z.z) * sigmoidf_(v1[0] + b1[bj][0]); o1[1] = hi16(z.z) * sigmoidf_(v1[1] + b1[bj][1]); o1[2] = lo16(z.w) * sigmoidf_(v1[2] + b1[bj][2]); o1[3] = hi16(z.w) * sigmoidf_(v1[3] + b1[bj][3]);
                        st8bf(E.d0 + (size_t)(row0 + ai * HALF + m * 16) * 1024 + col0 + bj * HALF, o0, o1); }
            }
        }
        else if (E.kind == 1  ) {
            const int row0 = cur.pm * BM + wr * 64 + fr, col0 = cur.pn * BM + wc * 32 + 8 * fq;
#pragma unroll
            for (int ai = 0; ai < 2; ++ai) {
                f32x4 r[4][2][2];
#pragma unroll
                for (int m = 0; m < 4; ++m)
#pragma unroll
                    for (int bj = 0; bj < 2; ++bj) { const size_t o = (size_t)(row0 + ai * HALF + m * 16) * 1024 + col0 + bj * HALF;
                        r[m][bj][0] = *(const f32x4*)(E.cf0 + o); r[m][bj][1] = *(const f32x4*)(E.cf0 + o + 4); }
#pragma unroll
                for (int m = 0; m < 4; ++m)
#pragma unroll
                    for (int bj = 0; bj < 2; ++bj) { const size_t o = (size_t)(row0 + ai * HALF + m * 16) * 1024 + col0 + bj * HALF;
                        *(f32x4*)(E.f0 + o) = r[m][bj][0] + acc[ai][bj][m][0]; *(f32x4*)(E.f0 + o + 4) = r[m][bj][1] + acc[ai][bj][m][1]; }
            }
        }
        else {
            const int row0 = cur.pm * BM + wr * 64 + fr, col0 = cur.pn * BM + wc * 32 + 8 * fq;
#pragma unroll
            for (int ai = 0; ai < 2; ++ai)
#pragma unroll
                for (int m = 0; m < 4; ++m)
#pragma unroll
                    for (int bj = 0; bj < 2; ++bj) E.st(row0 + ai * HALF + m * 16, col0 + bj * HALF, acc[ai][bj][m][0], acc[ai][bj][m][1]);
        }
        if (!has_next) break;
#pragma unroll
        for (int a = 0; a < 2; ++a)
#pragma unroll
            for (int b = 0; b < 2; ++b)
#pragma unroll
                for (int m = 0; m < 4; ++m)
#pragma unroll
                    for (int n = 0; n < 2; ++n) acc[a][b][m][n] = (f32x4){0.f, 0.f, 0.f, 0.f};
        cur = nxt; cA = nA; cB = nB; ++ui;
    }
    PG8_WAIT_V(0);
    if (wr == 0) PG8_BAR;
    PG8_BAR;
#undef PG8_SA
#undef PG8_SB
#undef PG8_STAGE
#undef PG8_LDA
#undef PG8_LDB
#undef PG8_MMA
#undef PG8_WAIT_V
#undef PG8_WAIT_L
#undef PG8_BAR
#undef PG8_SCHED
}
}

DI void st8bf(bf16_t* dst, f32x4 v0, f32x4 v1) { u32x4 w; w.x = pk2(v0[0], v0[1]); w.y = pk2(v0[2], v0[3]); w.z = pk2(v1[0], v1[1]); w.w = pk2(v1[2], v1[3]); *(u32x4*)dst = w; }

enum { EK_ABIN = 0, EK_RESID, EK_BF, EK_GLU, EK_NSAIN, EK_CMP1, EK_CMP2, EK_FFNUP };
struct Epi { int kind, ldc, flag, pad; bf16_t *d0, *d1, *d2; float* f0; const float* cf0; const float* cf1; const bf16_t* cb0;
    DI void st(int row, int col, f32x4 v0, f32x4 v1) const {
        switch (kind) {
        case EK_ABIN: {
            if (col < 256) st8bf(d0 + (size_t)row * 256 + col, v0, v1);
            else if (col < 2560) st8bf(d1 + (size_t)row * 2304 + (col - 256), v0, v1);
            else if (col < 3328) st8bf(d2 + (size_t)row * 768 + (col - 2560), v0, v1);
            else { const int cc = col - 3328; if (cc < 16) { float* d = f0 + (size_t)row * 16 + cc; *(f32x4*)d = v0; *(f32x4*)(d + 4) = v1; } } } break;
        case EK_RESID: {
            const size_t o = (size_t)row * 1024 + col; const f32x4 r0 = *(const f32x4*)(cf0 + o), r1 = *(const f32x4*)(cf0 + o + 4);
            *(f32x4*)(f0 + o) = r0 + v0; *(f32x4*)(f0 + o + 4) = r1 + v1; } break;
        case EK_BF: st8bf(d0 + (size_t)row * ldc + col, v0, v1); break;
        case EK_GLU: {
            const u32x4 zz = *(const u32x4*)(cb0 + (size_t)row * 256 + col); const f32x4 b0 = *(const f32x4*)(cf0 + col), b1 = *(const f32x4*)(cf0 + col + 4);
            f32x4 o0, o1;
            o0[0] = lo16(zz.x) * sigmoidf_(v0[0] + b0[0]); o0[1] = hi16(zz.x) * sigmoidf_(v0[1] + b0[1]); o0[2] = lo16(zz.y) * sigmoidf_(v0[2] + b0[2]); o0[3] = hi16(zz.y) * sigmoidf_(v0[3] + b0[3]);
            o1[0] = lo16(zz.z) * sigmoidf_(v1[0] + b1[0]); o1[1] = hi16(zz.z) * sigmoidf_(v1[1] + b1[1]); o1[2] = lo16(zz.w) * sigmoidf_(v1[2] + b1[2]); o1[3] = hi16(zz.w) * sigmoidf_(v1[3] + b1[3]);
            st8bf(d0 + (size_t)row * 1024 + col, o0, o1); } break;
        case EK_NSAIN: {
            if (col < 1024) { st8bf(d0 + (size_t)row * 1024 + col, v0 * 0.18033688011112042f, v1 * 0.18033688011112042f);   }
            else if (col < 2560) {
                const int cc0 = col - 1024, ts = cc0 >> 8, cc = cc0 & 255, g = cc >> 6, dd = cc & 63, b = row >> 11, t = row & 2047;
                bf16_t* base = d1 + (size_t)ts * (16 * MiB);
                if (ts == 3 || ts == 5) { bf16_t* d = base + ((size_t)(b * 4 + g) * 64 + dd) * 2048 + t;
#pragma unroll
                    for (int e = 0; e < 4; ++e) { d[(size_t)e * 2048] = f2bf(v0[e]); d[(size_t)(e + 4) * 2048] = f2bf(v1[e]); } }
                else st8bf(base + ((size_t)(b * 4 + g) * 2048 + t) * 64 + dd, v0, v1);
            } else { const int cc = col - 2560; if (cc < 48) { float* d = f0 + (size_t)row * 48 + cc;
#pragma unroll
                    for (int e = 0; e < 4; ++e) { d[e] = sigmoidf_(v0[e]); d[e + 4] = sigmoidf_(v1[e]); } } } } break;
        case EK_CMP1: {
            const f32x4 b0 = *(const f32x4*)(cf0 + col), b1 = *(const f32x4*)(cf0 + col + 4); f32x4 o0, o1;
#pragma unroll
            for (int e = 0; e < 4; ++e) { o0[e] = gelu_tanh(v0[e] + b0[e]); o1[e] = gelu_tanh(v1[e] + b1[e]); }
            st8bf(d0 + (size_t)row * 256 + col, o0, o1); } break;
        case EK_CMP2: {
            if (col < 64) {
                if (!flag) st8bf(d0 + (size_t)row * 64 + col, v0, v1);
                else { bf16_t* d = d0 + ((size_t)(row >> 7) * 64 + col) * 128 + (row & 127);
#pragma unroll
                    for (int e = 0; e < 4; ++e) { d[e * 128] = f2bf(v0[e]); d[(e + 4) * 128] = f2bf(v1[e]); } } } } break;
        default: break;
        }
    }
    DI void fused(const f32x4 (&acc)[2][2][4][2], int pm, int pn, int wr, int wc, int fr, int fq) const;
};

template <int CTRL> DI float dppf(float v) { return __builtin_bit_cast(float, __builtin_amdgcn_update_dpp(0, __builtin_bit_cast(int, v), CTRL, 0xf, 0xf, true)); }
DI void Epi::fused(const f32x4 (&acc)[2][2][4][2], int pm, int pn, int wr, int wc, int fr, int fq) const {
    const Epi& E = *this;
#pragma unroll
    for (int bj = 0; bj < 2; ++bj) {
        const int ncol = pn * 256 + bj * 128 + wc * 32 + 8 * fq, j0 = (ncol >> 3) * 4;
        const f32x4 wa0 = *(const f32x4*)(E.cf0 + j0), wa1 = *(const f32x4*)(E.cf0 + FF2 + j0), wa2 = *(const f32x4*)(E.cf0 + 2 * FF2 + j0);
        const f32x4 wb0 = *(const f32x4*)(E.cf0 + FFH + j0), wb1 = *(const f32x4*)(E.cf0 + FF2 + FFH + j0), wb2 = *(const f32x4*)(E.cf0 + 2 * FF2 + FFH + j0);
        const f32x4 ba = *(const f32x4*)(E.cf1 + j0), bb = *(const f32x4*)(E.cf1 + FFH + j0);
#pragma unroll
        for (int ai = 0; ai < 2; ++ai) {
            f32x4 pa = (f32x4){0.f, 0.f, 0.f, 0.f}, pb = pa;
#pragma unroll
            for (int m = 0; m < 4; ++m) {
                const f32x4 ca = acc[ai][bj][m][0], cb = acc[ai][bj][m][1];
                const int row = pm * 256 + ai * 128 + wr * 64 + m * 16 + fr;
                float o[4];
#pragma unroll
                for (int e = 0; e < 4; ++e) {
                    const float a1 = dppf<0x111>(ca[e]) + dppf<0x10F>(pa[e]), a2 = dppf<0x112>(ca[e]) + dppf<0x10E>(pa[e]);
                    const float b1 = dppf<0x111>(cb[e]) + dppf<0x10F>(pb[e]), b2 = dppf<0x112>(cb[e]) + dppf<0x10E>(pb[e]);
                    const float ya = fmaf(wa0[e], a2, fmaf(wa1[e], a1, fmaf(wa2[e], ca[e], ba[e])));
                    const float yb = fmaf(wb0[e], b2, fmaf(wb1[e], b1, fmaf(wb2[e], cb[e], bb[e])));
                    o[e] = silu_fast(ya) * yb; }
                if (m > 0 || fr >= 2) { u32x2 w; w.x = pk2(o[0], o[1]); w.y = pk2(o[2], o[3]); *(u32x2*)(E.d0 + (size_t)row * FFH + j0) = w; }
                if ((m == 0 && fr < 2) || (m == 3 && fr >= 14)) { float* hb = E.f0 + ((size_t)(row >> 6) * 4 + (m == 0 ? fr : fr - 12)) * FF2 + ncol; *(f32x4*)hb = ca; *(f32x4*)(hb + 4) = cb; }
                pa = ca; pb = cb;
            }
        }
    }
}
DI void ffn_fix_phase(const int tid, const P& p, int layer, int G, int c) {
    const float* hb = (const float*)(p.ws + F_HB); bf16_t* act = (bf16_t*)(p.ws + F_ACT);
    const float* cw = p.in[28] + (size_t)layer * 3 * FF2; const float* cbv = p.in[29] + (size_t)layer * FF2;
    const int nitems = 1024 * 2 * 704;
    for (int it = c * 512 + tid; it < nitems; it += G * 512) {
        const int q = it % 704, t = (it / 704) & 1, kb = it / 1408, j0 = q * 4, nc = q * 8;
        const bool first = (kb & 31) == 0;
        const float* r0 = hb + ((size_t)kb * 4 + t) * FF2 + nc;
        const float* r1 = (t == 1) ? hb + ((size_t)kb * 4 + 0) * FF2 + nc : hb + ((size_t)(kb - 1) * 4 + 3) * FF2 + nc;
        const float* r2 = (t == 1) ? hb + ((size_t)(kb - 1) * 4 + 3) * FF2 + nc : hb + ((size_t)(kb - 1) * 4 + 2) * FF2 + nc;
        const f32x4 z4 = (f32x4){0.f, 0.f, 0.f, 0.f};
        const f32x4 a0 = *(const f32x4*)r0, b0 = *(const f32x4*)(r0 + 4);
        const bool have1 = (t == 1) || !first, have2 = !first;
        const f32x4 a1 = have1 ? *(const f32x4*)r1 : z4, b1 = have1 ? *(const f32x4*)(r1 + 4) : z4;
        const f32x4 a2 = have2 ? *(const f32x4*)r2 : z4, b2 = have2 ? *(const f32x4*)(r2 + 4) : z4;
        const f32x4 wa0 = *(const f32x4*)(cw + j0), wa1 = *(const f32x4*)(cw + FF2 + j0), wa2 = *(const f32x4*)(cw + 2 * FF2 + j0);
        const f32x4 wb0 = *(const f32x4*)(cw + FFH + j0), wb1 = *(const f32x4*)(cw + FF2 + FFH + j0), wb2 = *(const f32x4*)(cw + 2 * FF2 + FFH + j0);
        const f32x4 ba = *(const f32x4*)(cbv + j0), bb = *(const f32x4*)(cbv + FFH + j0);
        float o[4];
#pragma unroll
        for (int e = 0; e < 4; ++e) { const float ya = fmaf(wa0[e], a2[e], fmaf(wa1[e], a1[e], fmaf(wa2[e], a0[e], ba[e]))), yb = fmaf(wb0[e], b2[e], fmaf(wb1[e], b1[e], fmaf(wb2[e], b0[e], bb[e]))); o[e] = silu_fast(ya) * yb; }
        u32x2 w; w.x = pk2(o[0], o[1]); w.y = pk2(o[2], o[3]);
        *(u32x2*)(act + ((size_t)kb * 64 + t) * FFH + j0) = w;
    }
}

DI void prep_unit(const int tid, LAS unsigned char* lds, const float* src, bf16_t* dst, int K, int N, int u, bool perm) {
    LAS float* tile = (LAS float*)lds;
    const int ntk = K / 64, tk = u % ntk, tn = u / ntk;
    { const int c4 = tid & 63, kb = tid >> 6, n = tn * 256 + c4 * 4, ns = perm ? (((n & 4) ? FFH : 0) + (n >> 3) * 4) : n;
      f32x4 v[8];
#pragma unroll
      for (int kk = 0; kk < 8; ++kk) { const int k = kb + kk * 8; v[kk] = (n < N) ? *(const f32x4*)(src + (size_t)(tk * 64 + k) * N + ns) : (f32x4){0.f, 0.f, 0.f, 0.f}; }
#pragma unroll
      for (int kk = 0; kk < 8; ++kk) *(LAS f32x4*)(tile + (kb + kk * 8) * 260 + c4 * 4) = v[kk]; }
    __syncthreads();
#pragma unroll
    for (int i = 0; i < 4; ++i) { const int pc = tid + i * 512, nl = pc & 255, k8 = pc >> 8;
        float t[8];
#pragma unroll
        for (int e = 0; e < 8; ++e) t[e] = tile[(k8 * 8 + e) * 260 + nl];
        u32x4 w; w.x = pk2(t[0], t[1]); w.y = pk2(t[2], t[3]); w.z = pk2(t[4], t[5]); w.w = pk2(t[6], t[7]);
        *(u32x4*)(dst + (size_t)(tn * 256 + nl) * K + tk * 64 + k8 * 8) = w; }
    __syncthreads();
}

template <bool TO_BF16>
DI void rms_rows(const int tid, const float* src, const float* gam, bf16_t* dst, float* fdst, int G, int c) {
    constexpr int NR = 8;
    const int wave = tid >> 6, lane = tid & 63;
    f32x4 g4[4];
#pragma unroll
    for (int k = 0; k < 4; ++k) g4[k] = *(const f32x4*)(gam + k * 256 + lane * 4);
    for (int r = (c * 8 + wave) * NR; r < MTOK; r += G * 8 * NR) {
        f32x4 v[NR][4]; float s[NR];
#pragma unroll
        for (int q = 0; q < NR; ++q)
#pragma unroll
            for (int k = 0; k < 4; ++k) v[q][k] = *(const f32x4*)(src + (size_t)(r + q) * 1024 + k * 256 + lane * 4);
#pragma unroll
        for (int q = 0; q < NR; ++q) { s[q] = 0.f;
#pragma unroll
            for (int k = 0; k < 4; ++k) s[q] += v[q][k][0] * v[q][k][0] + v[q][k][1] * v[q][k][1] + v[q][k][2] * v[q][k][2] + v[q][k][3] * v[q][k][3]; }
#pragma unroll
        for (int o = 32; o > 0; o >>= 1)
#pragma unroll
            for (int q = 0; q < NR; ++q) s[q] += __shfl_xor(s[q], o);
#pragma unroll
        for (int q = 0; q < NR; ++q) { const float sc = rsqrtf(s[q] * (1.f / 1024.f) + 1e-6f);
#pragma unroll
            for (int k = 0; k < 4; ++k) {
                if (TO_BF16) { u32x2 o; o.x = pk2(v[q][k][0] * sc * g4[k][0], v[q][k][1] * sc * g4[k][1]); o.y = pk2(v[q][k][2] * sc * g4[k][2], v[q][k][3] * sc * g4[k][3]);
                    *(u32x2*)(dst + (size_t)(r + q) * 1024 + k * 256 + lane * 4) = o; }
                else *(f32x4*)(fdst + (size_t)(r + q) * 1024 + k * 256 + lane * 4) = v[q][k] * sc * g4[k]; } }
    }
}
DI void rms_phase(const int tid, const float* src, const float* gam, bf16_t* dst, int G, int c) { rms_rows<true>(tid, src, gam, dst, nullptr, G, c); }
DI void rms_final(const int tid, float* io, const float* gam, int G, int c) { rms_rows<false>(tid, io, gam, nullptr, io, G, c); }
DI void rms_owned(const int tid, float* h, const float* gam, bf16_t* dst, int G, int c) {
    const int wave = tid >> 6, lane = tid & 63;
    for (int pm = c; pm < MTOK / 256; pm += G)
        for (int rr = 0; rr < 32; ++rr) {
            const int r = pm * 256 + wave * 32 + rr;
            float* p = h + (size_t)r * 1024; f32x4 v[4]; float ss = 0.f;
#pragma unroll
            for (int k = 0; k < 4; ++k) { v[k] = *(const f32x4*)(p + k * 256 + lane * 4); ss += v[k][0] * v[k][0] + v[k][1] * v[k][1] + v[k][2] * v[k][2] + v[k][3] * v[k][3]; }
            ss = wave_sum(ss); const float sc = rsqrtf(ss * (1.f / 1024.f) + 1e-6f);
#pragma unroll
            for (int k = 0; k < 4; ++k) { const f32x4 g4 = *(const f32x4*)(gam + k * 256 + lane * 4);
                if (dst) { u32x2 o; o.x = pk2(v[k][0] * sc * g4[0], v[k][1] * sc * g4[1]); o.y = pk2(v[k][2] * sc * g4[2], v[k][3] * sc * g4[3]); *(u32x2*)(dst + (size_t)r * 1024 + k * 256 + lane * 4) = o; }
                else *(f32x4*)(p + k * 256 + lane * 4) = v[k] * sc * g4; }
        }
}

template <bool PASSB>
DI void s5_pass(const int tid, LAS unsigned char* lds, const P& p, int G, int c0) {
    const int wave = tid >> 6, lane = tid & 63, fr = lane & 15, fq = lane >> 4;
    LAS float* ubuf = (LAS float*)(lds + wave * 8192);
    LAS bf16_t* hbuf = (LAS bf16_t*)(lds + wave * 8192 + 1024);
    const float* abar = (const float*)(p.ws + W_S5AB); const float* bbar = (const float*)(p.ws + W_S5BB); const bf16_t* ccat = (const bf16_t*)(p.ws + W_S5CC);
    const bf16_t* us5 = (const bf16_t*)(p.ws + A_US5); bf16_t* zs5 = (bf16_t*)(p.ws + A_ZS5); float* hend = (float*)(p.ws + A_S5END);
    const float* dskip = p.in[10];
    for (int bu = c0; bu < 512; bu += G) {
        const int g = bu >> 5, wu = (bu & 31) * 8 + wave, b = wu >> 3, seg = wu & 7;
        float bre[16], bim[16];
        { const f32x4* bp = (const f32x4*)(bbar + ((size_t)(g * 64 + lane)) * 32);
#pragma unroll
          for (int k = 0; k < 4; ++k) { f32x4 v = bp[k]; bre[4 * k] = v[0]; bre[4 * k + 1] = v[1]; bre[4 * k + 2] = v[2]; bre[4 * k + 3] = v[3]; }
#pragma unroll
          for (int k = 0; k < 4; ++k) { f32x4 v = bp[4 + k]; bim[4 * k] = v[0]; bim[4 * k + 1] = v[1]; bim[4 * k + 2] = v[2]; bim[4 * k + 3] = v[3]; } }
        const float are = abar[(g * 64 + lane) * 2], aim = abar[(g * 64 + lane) * 2 + 1];
        float hre = 0.f, him = 0.f;
        bf16x8 cf[4]; float dsk = 0.f;
        if (PASSB) {
#pragma unroll
            for (int ks = 0; ks < 4; ++ks) cf[ks] = *(const bf16x8*)(ccat + ((size_t)(g * 16 + fr)) * 128 + ks * 32 + fq * 8);
            dsk = dskip[g * 16 + fr];
            float pr = are, pi = aim;
#pragma unroll
            for (int s = 0; s < 8; ++s) { const float nr = pr * pr - pi * pi, ni = 2.f * pr * pi; pr = nr; pi = ni; }
            for (int s = 0; s < seg; ++s) { const float* he = hend + (((size_t)(b * 16 + g) * 8 + s) * 64 + lane) * 2; const float er = he[0], ei = he[1];
                const float nr = pr * hre - pi * him + er, ni = pr * him + pi * hre + ei; hre = nr; him = ni; }
        }
        const size_t tokbase = (size_t)b * SEQ + seg * 256;
        for (int tile = 0; tile < 16; ++tile) {
            if (lane < 32) { const int tk = lane >> 1, hf = lane & 1;
                const u32x4 raw = *(const u32x4*)(us5 + (tokbase + tile * 16 + tk) * 256 + g * 16 + hf * 8);
                LAS float* d = ubuf + tk * 16 + hf * 8;
                *(LAS f32x4*)d = (f32x4){lo16(raw.x), hi16(raw.x), lo16(raw.y), hi16(raw.y)}; *(LAS f32x4*)(d + 4) = (f32x4){lo16(raw.z), hi16(raw.z), lo16(raw.w), hi16(raw.w)}; }
            lds_wait();
#pragma unroll 4
            for (int t = 0; t < 16; ++t) {
                float bur = 0.f, bui = 0.f;
#pragma unroll
                for (int k = 0; k < 4; ++k) { const f32x4 u = *(const LAS f32x4*)(ubuf + t * 16 + k * 4);
#pragma unroll
                    for (int e = 0; e < 4; ++e) { bur += bre[4 * k + e] * u[e]; bui += bim[4 * k + e] * u[e]; } }
                const float nr = are * hre - aim * him + bur, ni = are * him + aim * hre + bui; hre = nr; him = ni;
                if (PASSB) { hbuf[t * 136 + lane] = f2bf(hre); hbuf[t * 136 + 64 + lane] = f2bf(-him); }
            }
            if (PASSB) {
                lds_wait();
                f32x4 acc = (f32x4){0.f, 0.f, 0.f, 0.f};
#pragma unroll
                for (int ks = 0; ks < 4; ++ks) { const bf16x8 a = *(const LAS bf16x8*)(hbuf + fr * 136 + ks * 32 + fq * 8); acc = mfma16(a, cf[ks], acc); }
#pragma unroll
                for (int j = 0; j < 4; ++j) { const int tk = fq * 4 + j; const float y = acc[j] + dsk * ubuf[tk * 16 + fr];
                    zs5[(tokbase + tile * 16 + tk) * 256 + g * 16 + fr] = f2bf(gelu_tanh(y)); }
            }
            lds_wait();
        }
        if (!PASSB) { float* he = hend + (((size_t)(b * 16 + g) * 8 + seg) * 64 + lane) * 2; he[0] = hre; he[1] = him; }
    }
}

DI void gdn_prep_phase(const int tid, LAS unsigned char* lds, const P& p, int G, int c) {
    const int hb = tid >> 8, ht = tid & 255, lane = tid & 63, wv = __builtin_amdgcn_readfirstlane(ht >> 6), fr = lane & 15, fq = lane >> 4;
    LAS unsigned char* base = lds + hb * 65536;
    LAS bf16_t* Qs = (LAS bf16_t*)base; LAS bf16_t* Ks = Qs + 64 * 136;
    LAS float* Ls = (LAS float*)(base + 2 * 17408); LAS float* tb = (LAS float*)(base + 3 * 17408);
    const bf16_t* qkv = (const bf16_t*)(p.ws + A_QKV); const float* blal = (const float*)(p.ws + A_BLAL);
    const float* convw = p.in[13]; const float* a_log = p.in[14]; const float* dt_bias = p.in[15];
    bf16_t* Uc = (bf16_t*)(p.ws + CH_U); bf16_t* Wc = (bf16_t*)(p.ws + CH_W); bf16_t* QDc = (bf16_t*)(p.ws + CH_QD); bf16_t* KDTc = (bf16_t*)(p.ws + CH_KDT); bf16_t* INc = (bf16_t*)(p.ws + CH_INTRA); float* GLc = (float*)(p.ws + CH_GL);
    for (int u = c * 2 + hb; u < 6144; u += 2 * G) {
        const int n = u & 31, bh = u >> 5, h = bh % 6, b = bh / 6; const size_t cid = (size_t)u;
        const long tok0 = (long)b * SEQ + n * 64;
        float xs[64];
        {
            const int ch = ht & 127, th = ht >> 7, isv = th, colq = h * 128 + ch, colkv = 768 + isv * 768 + h * 128 + ch, t0 = th * 32;
            bf16_t qraw[35], kvraw[67];
            const bool haloq = (n > 0) || (t0 > 0), halokv = (n > 0);
#pragma unroll
            for (int e = 0; e < 3; ++e) { qraw[e] = haloq ? qkv[(tok0 + t0 - 3 + e) * 2304 + colq] : (bf16_t)0; kvraw[e] = halokv ? qkv[(tok0 - 3 + e) * 2304 + colkv] : (bf16_t)0; }
#pragma unroll
            for (int e = 0; e < 32; ++e) qraw[3 + e] = qkv[(tok0 + t0 + e) * 2304 + colq];
#pragma unroll
            for (int e = 0; e < 64; ++e) kvraw[3 + e] = qkv[(tok0 + e) * 2304 + colkv];
            { const float w0 = convw[colq], w1 = convw[2304 + colq], w2 = convw[4608 + colq], w3 = convw[6912 + colq];
#pragma unroll
              for (int e = 0; e < 32; ++e) { const float y = w0 * bf2f(qraw[e]) + w1 * bf2f(qraw[e + 1]) + w2 * bf2f(qraw[e + 2]) + w3 * bf2f(qraw[e + 3]); Qs[(t0 + e) * 136 + ch] = f2bf(silu_fast(y)); } }
            { const float w0 = convw[colkv], w1 = convw[2304 + colkv], w2 = convw[4608 + colkv], w3 = convw[6912 + colkv];
#pragma unroll
              for (int e = 0; e < 64; ++e) { const float y = w0 * bf2f(kvraw[e]) + w1 * bf2f(kvraw[e + 1]) + w2 * bf2f(kvraw[e + 2]) + w3 * bf2f(kvraw[e + 3]); xs[e] = silu_fast(y); }
              if (!isv) {
#pragma unroll
                  for (int tt = 0; tt < 64; ++tt) Ks[tt * 136 + ch] = f2bf(xs[tt]); } }
        }
        if (ht < 64) { const float bl = blal[(tok0 + ht) * 16 + h], al = blal[(tok0 + ht) * 16 + 6 + h];
            const float x = al + dt_bias[h]; const float sp = fmaxf(x, 0.f) + log1pf(expf(-fabsf(x))); float gsum = -expf(a_log[h]) * sp;
#pragma unroll
            for (int off = 1; off < 64; off <<= 1) { const float v = __shfl_up(gsum, off); if (lane >= off) gsum += v; }
            tb[ht] = 1.f / (1.f + expf(-bl)); tb[64 + ht] = gsum; }
        __syncthreads();
        f32x4 kk[4], qk[4];
        { bf16x8 aK[4], aQ[4];
#pragma unroll
          for (int ks = 0; ks < 4; ++ks) { aK[ks] = *(const LAS bf16x8*)(Ks + (wv * 16 + fr) * 136 + ks * 32 + fq * 8); aQ[ks] = *(const LAS bf16x8*)(Qs + (wv * 16 + fr) * 136 + ks * 32 + fq * 8); }
          f32x4 qq = (f32x4){0.f, 0.f, 0.f, 0.f};
#pragma unroll
          for (int ks = 0; ks < 4; ++ks) qq = mfma16(aQ[ks], aQ[ks], qq);
#pragma unroll
          for (int ct = 0; ct < 4; ++ct) { kk[ct] = (f32x4){0.f, 0.f, 0.f, 0.f}; qk[ct] = (f32x4){0.f, 0.f, 0.f, 0.f};
              if (ct <= wv) {
#pragma unroll
                  for (int ks = 0; ks < 4; ++ks) { const bf16x8 bK = *(const LAS bf16x8*)(Ks + (ct * 16 + fr) * 136 + ks * 32 + fq * 8); kk[ct] = mfma16(aK[ks], bK, kk[ct]); qk[ct] = mfma16(aQ[ks], bK, qk[ct]); } }
              if (ct == wv && (fr >> 2) == fq) { const int j = fr & 3; const float dk = j == 0 ? kk[ct][0] : j == 1 ? kk[ct][1] : j == 2 ? kk[ct][2] : kk[ct][3];
                  const float dq = j == 0 ? qq[0] : j == 1 ? qq[1] : j == 2 ? qq[2] : qq[3]; tb[128 + wv * 16 + fr] = dq; tb[192 + wv * 16 + fr] = dk; } } }
        __syncthreads();
        {
            float rkc[4], rqc[4], gcc[4], btc[4], rks[4], gcs[4];
#pragma unroll
            for (int j = 0; j < 4; ++j) { const int cr = wv * 16 + fq * 4 + j; rkc[j] = rsqrtf(tb[192 + cr] + 1e-6f); rqc[j] = rsqrtf(tb[128 + cr] + 1e-6f) * 0.08838834764831845f; gcc[j] = tb[64 + cr]; btc[j] = tb[cr]; }
#pragma unroll
            for (int ct = 0; ct < 4; ++ct) { const int sc = ct * 16 + fr; rks[ct] = rsqrtf(tb[192 + sc] + 1e-6f); gcs[ct] = tb[64 + sc]; }
#pragma unroll
            for (int ct = 0; ct < 4; ++ct)
#pragma unroll
                for (int j = 0; j < 4; ++j) { const int cr = wv * 16 + fq * 4 + j, sc = ct * 16 + fr;
                    const float e = (sc <= cr) ? __expf(gcc[j] - gcs[ct]) : 0.f;
                    Ls[(cr >> 1) * 136 + sc * 2 + (cr & 1)] = (sc < cr) ? btc[j] * rkc[j] * rks[ct] * kk[ct][j] * e : 0.f;
                    INc[cid * 4096 + cr * 64 + sc] = f2bf(rqc[j] * rks[ct] * qk[ct][j] * e); }
            if (ht < 64) { const float rk = rsqrtf(tb[192 + ht] + 1e-6f), gch = tb[64 + ht];
                tb[256 + ht] = rk * __expf(tb[64 + 63] - gch); tb[320 + ht] = rk * tb[ht] * __expf(gch); }
        }
        __syncthreads();
        { const int ch = ht & 127, isv = ht >> 7; const float gl = tb[64 + 63];
          if (!isv) {
#pragma unroll
              for (int i8 = 0; i8 < 8; ++i8) { float kd[8];
#pragma unroll
                  for (int e = 0; e < 8; ++e) { const int tt = i8 * 8 + e; kd[e] = xs[tt] * tb[256 + tt]; xs[tt] = xs[tt] * tb[320 + tt]; }
                  u32x4 w; w.x = pk2(kd[0], kd[1]); w.y = pk2(kd[2], kd[3]); w.z = pk2(kd[4], kd[5]); w.w = pk2(kd[6], kd[7]);
                  *(u32x4*)(KDTc + cid * 8192 + ch * 64 + i8 * 8) = w; }
          } else {
#pragma unroll
              for (int tt = 0; tt < 64; ++tt) xs[tt] *= tb[tt]; }
#pragma unroll
          for (int kb = 0; kb < 8; ++kb) {
#pragma unroll
              for (int pp = 0; pp < 4; ++pp) { const int pr = 4 * kb + pp;
                  f32x2 s = (f32x2){xs[2 * pr], xs[2 * pr + 1]};
#pragma unroll
                  for (int j = 8 * kb; j < 2 * pr; j += 2) { const f32x4 l = *(const LAS f32x4*)(Ls + pr * 136 + j * 2);
                      s -= (f32x2){l[0], l[1]} * (f32x2){xs[j], xs[j]}; s -= (f32x2){l[2], l[3]} * (f32x2){xs[j + 1], xs[j + 1]}; }
                  xs[2 * pr] = s[0];
                  xs[2 * pr + 1] = s[1] - Ls[pr * 136 + 4 * pr + 1] * s[0]; }
#pragma unroll
              for (int pr = 4 * kb + 4; pr < 32; ++pr) {
                  f32x2 s0 = (f32x2){xs[2 * pr], xs[2 * pr + 1]}, s1 = (f32x2){0.f, 0.f};
#pragma unroll
                  for (int q = 0; q < 4; ++q) { const int j = 8 * kb + 2 * q; const f32x4 l = *(const LAS f32x4*)(Ls + pr * 136 + j * 2);
                      s0 -= (f32x2){l[0], l[1]} * (f32x2){xs[j], xs[j]}; s1 -= (f32x2){l[2], l[3]} * (f32x2){xs[j + 1], xs[j + 1]}; }
                  const f32x2 s = s0 + s1; xs[2 * pr] = s[0]; xs[2 * pr + 1] = s[1]; }
          }
          if (isv) {
#pragma unroll
              for (int i8 = 0; i8 < 8; ++i8) { u32x4 w; w.x = pk2(xs[i8 * 8], xs[i8 * 8 + 1]); w.y = pk2(xs[i8 * 8 + 2], xs[i8 * 8 + 3]); w.z = pk2(xs[i8 * 8 + 4], xs[i8 * 8 + 5]); w.w = pk2(xs[i8 * 8 + 6], xs[i8 * 8 + 7]);
                  *(u32x4*)(Uc + cid * 8192 + ch * 64 + i8 * 8) = w; }
          } else { bf16_t* dst = Wc + cid * 8192 + ch;
#pragma unroll
              for (int tt = 0; tt < 64; ++tt) dst[tt * 128] = f2bf(xs[tt]); }
          { const int tt = ht >> 2, d0 = (ht & 3) * 32; const float fac = rsqrtf(tb[128 + tt] + 1e-6f) * 0.08838834764831845f * __expf(tb[64 + tt]);
#pragma unroll
            for (int i = 0; i < 4; ++i) { const u32x4 r = *(const LAS u32x4*)(Qs + tt * 136 + d0 + i * 8); u32x4 w;
                w.x = pk2(lo16(r.x) * fac, hi16(r.x) * fac); w.y = pk2(lo16(r.y) * fac, hi16(r.y) * fac); w.z = pk2(lo16(r.z) * fac, hi16(r.z) * fac); w.w = pk2(lo16(r.w) * fac, hi16(r.w) * fac);
                *(u32x4*)(QDc + cid * 8192 + tt * 128 + d0 + i * 8) = w; } }
          if (ht == 0) GLc[cid] = __expf(gl); }
        __syncthreads();
    }
}

DI void gdn_seq_phase(const int tid, LAS unsigned char* lds, const P& p, int G, int c) {
    const int w = __builtin_amdgcn_readfirstlane(tid >> 6), lane = tid & 63, fr = lane & 15, fq = lane >> 4, ct = w & 3, eh = w >> 2;
    LAS bf16_t* ST = (LAS bf16_t*)lds;
    LAS bf16_t* VT = (LAS bf16_t*)(lds + 34816);
    LAS float* OT = (LAS float*)(lds + 34816 + 18432);
    const bf16_t* Uc = (const bf16_t*)(p.ws + CH_U); const bf16_t* Wc = (const bf16_t*)(p.ws + CH_W); const bf16_t* QDc = (const bf16_t*)(p.ws + CH_QD); const bf16_t* KDTc = (const bf16_t*)(p.ws + CH_KDT); const bf16_t* INc = (const bf16_t*)(p.ws + CH_INTRA); const float* GLc = (const float*)(p.ws + CH_GL);
    const bf16_t* Z = (const bf16_t*)(p.ws + A_Z); bf16_t* ycat = (bf16_t*)(p.ws + A_YCAT); const float* normw = p.in[16];
    for (int u = c; u < 192; u += G) {
        const int h = u % 6, b = u / 6;
        for (int i = tid; i < 128 * 136 / 2; i += 512) ((LAS unsigned*)ST)[i] = 0u;
        f32x4 Sacc[8];
#pragma unroll
        for (int e = 0; e < 8; ++e) Sacc[e] = (f32x4){0.f, 0.f, 0.f, 0.f};
        __syncthreads();
        bf16x8 Wf[4], Qf[4], If[2], Kf[2]; u32x2 uvr[4]; float gl;
        const int wrow = (ct * 16 + fr) * 128 + fq * 8, irow = (ct * 16 + fr) * 64 + fq * 8, krow = (w * 16 + fr) * 64 + fq * 8;
        { const size_t cid = (size_t)u * 32;
#pragma unroll
          for (int ks = 0; ks < 4; ++ks) { Wf[ks] = *(const bf16x8*)(Wc + cid * 8192 + wrow + ks * 32); Qf[ks] = *(const bf16x8*)(QDc + cid * 8192 + wrow + ks * 32); }
#pragma unroll
          for (int ks = 0; ks < 2; ++ks) { If[ks] = *(const bf16x8*)(INc + cid * 4096 + irow + ks * 32); Kf[ks] = *(const bf16x8*)(KDTc + cid * 8192 + krow + ks * 32); }
#pragma unroll
          for (int et = 0; et < 4; ++et) uvr[et] = *(const u32x2*)(Uc + cid * 8192 + (eh * 64 + et * 16 + fr) * 64 + ct * 16 + fq * 4);
          gl = GLc[cid]; }
        for (int n = 0; n < 32; ++n) {
            const size_t cid = (size_t)u * 32 + n, cnx = (cid + 1 < 6144) ? cid + 1 : cid;
            const int tt = tid >> 3, e0 = (tid & 7) * 16; const size_t tok = (size_t)b * SEQ + n * 64 + tt;
            const u32x4 z0 = *(const u32x4*)(Z + tok * 768 + h * 128 + e0), z1 = *(const u32x4*)(Z + tok * 768 + h * 128 + e0 + 8);
            f32x4 T1[4], O1[4];
#pragma unroll
            for (int et = 0; et < 4; ++et) { T1[et] = (f32x4){0.f, 0.f, 0.f, 0.f}; O1[et] = (f32x4){0.f, 0.f, 0.f, 0.f};
#pragma unroll
                for (int ks = 0; ks < 4; ++ks) { const bf16x8 bb = *(const LAS bf16x8*)(ST + (eh * 64 + et * 16 + fr) * 136 + ks * 32 + fq * 8); T1[et] = mfma16(Wf[ks], bb, T1[et]); O1[et] = mfma16(Qf[ks], bb, O1[et]); } }
#pragma unroll
            for (int ks = 0; ks < 4; ++ks) { Wf[ks] = *(const bf16x8*)(Wc + cnx * 8192 + wrow + ks * 32); Qf[ks] = *(const bf16x8*)(QDc + cnx * 8192 + wrow + ks * 32); }
#pragma unroll
            for (int et = 0; et < 4; ++et) { u32x2 pk; pk.x = pk2(lo16(uvr[et].x) - T1[et][0], hi16(uvr[et].x) - T1[et][1]); pk.y = pk2(lo16(uvr[et].y) - T1[et][2], hi16(uvr[et].y) - T1[et][3]);
                *(LAS u32x2*)(VT + (eh * 64 + et * 16 + fr) * 72 + ct * 16 + fq * 4) = pk; }
#pragma unroll
            for (int et = 0; et < 4; ++et) uvr[et] = *(const u32x2*)(Uc + cnx * 8192 + (eh * 64 + et * 16 + fr) * 64 + ct * 16 + fq * 4);
            __syncthreads();
#pragma unroll
            for (int et = 0; et < 4; ++et) {
#pragma unroll
                for (int ks = 0; ks < 2; ++ks) { const bf16x8 bb = *(const LAS bf16x8*)(VT + (eh * 64 + et * 16 + fr) * 72 + ks * 32 + fq * 8); O1[et] = mfma16(If[ks], bb, O1[et]); }
#pragma unroll
                for (int j = 0; j < 4; ++j) OT[(ct * 16 + fq * 4 + j) * 132 + eh * 64 + et * 16 + fr] = O1[et][j]; }
#pragma unroll
            for (int ks = 0; ks < 2; ++ks) If[ks] = *(const bf16x8*)(INc + cnx * 4096 + irow + ks * 32);
#pragma unroll
            for (int e8 = 0; e8 < 8; ++e8) { Sacc[e8] = Sacc[e8] * gl;
#pragma unroll
                for (int ks = 0; ks < 2; ++ks) { const bf16x8 aa = *(const LAS bf16x8*)(VT + (e8 * 16 + fr) * 72 + ks * 32 + fq * 8); Sacc[e8] = mfma16(aa, Kf[ks], Sacc[e8]); } }
#pragma unroll
            for (int ks = 0; ks < 2; ++ks) Kf[ks] = *(const bf16x8*)(KDTc + cnx * 8192 + krow + ks * 32);
            gl = GLc[cnx];
#pragma unroll
            for (int e8 = 0; e8 < 8; ++e8)
#pragma unroll
                for (int j = 0; j < 4; ++j) ST[(e8 * 16 + fq * 4 + j) * 136 + w * 16 + fr] = f2bf(Sacc[e8][j]);
            __syncthreads();
            { float o[16]; float ss = 0.f;
#pragma unroll
              for (int i = 0; i < 4; ++i) { const f32x4 v = *(const LAS f32x4*)(OT + tt * 132 + e0 + i * 4); o[4 * i] = v[0]; o[4 * i + 1] = v[1]; o[4 * i + 2] = v[2]; o[4 * i + 3] = v[3]; ss += v[0] * v[0] + v[1] * v[1] + v[2] * v[2] + v[3] * v[3]; }
              ss += __shfl_xor(ss, 1); ss += __shfl_xor(ss, 2); ss += __shfl_xor(ss, 4);
              const float sc = rsqrtf(ss * (1.f / 128.f) + 1e-6f);
              float zz[16] = {lo16(z0.x), hi16(z0.x), lo16(z0.y), hi16(z0.y), lo16(z0.z), hi16(z0.z), lo16(z0.w), hi16(z0.w), lo16(z1.x), hi16(z1.x), lo16(z1.y), hi16(z1.y), lo16(z1.z), hi16(z1.z), lo16(z1.w), hi16(z1.w)};
              float r[16];
#pragma unroll
              for (int i = 0; i < 16; ++i) r[i] = o[i] * sc * normw[e0 + i] * silu_fast(zz[i]);
              u32x4 w0, w1; w0.x = pk2(r[0], r[1]); w0.y = pk2(r[2], r[3]); w0.z = pk2(r[4], r[5]); w0.w = pk2(r[6], r[7]); w1.x = pk2(r[8], r[9]); w1.y = pk2(r[10], r[11]); w1.z = pk2(r[12], r[13]); w1.w = pk2(r[14], r[15]);
              *(u32x4*)(ycat + tok * 1024 + 256 + h * 128 + e0) = w0; *(u32x4*)(ycat + tok * 1024 + 256 + h * 128 + e0 + 8) = w1; }
        }
        __syncthreads();
    }
}

DI void convact_phase(const int tid, const P& p, int layer, int half, int G, int c) {
    const bf16_t* up = (const bf16_t*)(p.ws + F_UP); bf16_t* act = (bf16_t*)(p.ws + F_ACT);
    const float* cw = p.in[28] + (size_t)layer * 3 * FF2; const float* cb = p.in[29] + (size_t)layer * FF2;
    const int nitems = (32768 / 8) * 352;
    for (int it = c * 512 + tid; it < nitems; it += G * 512) {
        const int ck = it % 352, run = it / 352, ch = ck * 8, r0 = run * 8, sp0 = r0 & 2047;
        float wa[3][8], wb[3][8], ba[8], bb[8];
#pragma unroll
        for (int k = 0; k < 3; ++k)
#pragma unroll
            for (int e = 0; e < 8; ++e) { wa[k][e] = cw[k * FF2 + ch + e]; wb[k][e] = cw[k * FF2 + FFH + ch + e]; }
#pragma unroll
        for (int e = 0; e < 8; ++e) { ba[e] = cb[ch + e]; bb[e] = cb[FFH + ch + e]; }
        u32x4 a0 = (u32x4){0, 0, 0, 0}, a1 = a0, b0 = a0, b1 = a0;
        if (sp0 > 0) { a0 = *(const u32x4*)(up + (size_t)(r0 - 2) * FF2 + ch); a1 = *(const u32x4*)(up + (size_t)(r0 - 1) * FF2 + ch); b0 = *(const u32x4*)(up + (size_t)(r0 - 2) * FF2 + FFH + ch); b1 = *(const u32x4*)(up + (size_t)(r0 - 1) * FF2 + FFH + ch); }
#pragma unroll
        for (int r = 0; r < 8; ++r) {
            const u32x4 a2 = *(const u32x4*)(up + (size_t)(r0 + r) * FF2 + ch), b2 = *(const u32x4*)(up + (size_t)(r0 + r) * FF2 + FFH + ch);
            const unsigned A0[4] = {a0.x, a0.y, a0.z, a0.w}, A1[4] = {a1.x, a1.y, a1.z, a1.w}, A2[4] = {a2.x, a2.y, a2.z, a2.w}, B0[4] = {b0.x, b0.y, b0.z, b0.w}, B1[4] = {b1.x, b1.y, b1.z, b1.w}, B2[4] = {b2.x, b2.y, b2.z, b2.w};
            float o[8];
#pragma unroll
            for (int q = 0; q < 4; ++q) {
                const float al = wa[0][2 * q] * lo16(A0[q]) + wa[1][2 * q] * lo16(A1[q]) + wa[2][2 * q] * lo16(A2[q]) + ba[2 * q];
                const float ah = wa[0][2 * q + 1] * hi16(A0[q]) + wa[1][2 * q + 1] * hi16(A1[q]) + wa[2][2 * q + 1] * hi16(A2[q]) + ba[2 * q + 1];
                const float bl = wb[0][2 * q] * lo16(B0[q]) + wb[1][2 * q] * lo16(B1[q]) + wb[2][2 * q] * lo16(B2[q]) + bb[2 * q];
                const float bh = wb[0][2 * q + 1] * hi16(B0[q]) + wb[1][2 * q + 1] * hi16(B1[q]) + wb[2][2 * q + 1] * hi16(B2[q]) + bb[2 * q + 1];
                o[2 * q] = siluf_(al) * bl; o[2 * q + 1] = siluf_(ah) * bh; }
            u32x4 w; w.x = pk2(o[0], o[1]); w.y = pk2(o[2], o[3]); w.z = pk2(o[4], o[5]); w.w = pk2(o[6], o[7]);
            *(u32x4*)(act + ((size_t)half * 32768 + r0 + r) * FFH + ch) = w;
            a0 = a1; a1 = a2; b0 = b1; b1 = b2; }
    }
}

DI void nsa_attn_phase(const int tid0, LAS unsigned char* lds, const P& p, int G, int c) {
    const int w = __builtin_amdgcn_readfirstlane(tid0 >> 6), r = w & 3, qh = w >> 2;
    LAS bf16_t* Qs = (LAS bf16_t*)lds;
    LAS bf16_t* Kc = (LAS bf16_t*)(lds + 36864);
    LAS bf16_t* VcT = (LAS bf16_t*)(lds + 36864 + 18432);
    LAS bf16_t* KV0 = (LAS bf16_t*)(lds + 72704);
    LAS float* imp4 = (LAS float*)(lds + 109568);
    LAS unsigned* selm = (LAS unsigned*)(lds + 109568 + 33792);
    const bf16_t* Q = (const bf16_t*)(p.ws + N_Q); const bf16_t* KS = (const bf16_t*)(p.ws + N_KS); const bf16_t* VST = (const bf16_t*)(p.ws + N_VST); const bf16_t* KW = (const bf16_t*)(p.ws + N_KW); const bf16_t* VWT = (const bf16_t*)(p.ws + N_VWT);
    const bf16_t* KCMP = (const bf16_t*)(p.ws + N_KCMP); const bf16_t* VCMPT = (const bf16_t*)(p.ws + N_VCMPT); const float* gates = (const float*)(p.ws + N_GATES); bf16_t* AO = (bf16_t*)(p.ws + N_AO);
    for (int idx = c; idx < 4096; idx += G) {
        int tid = tid0; asm volatile("" : "+v"(tid));
        const int lane = tid & 63, fr = lane & 15, fq = lane >> 4;
        const int rnd = idx >> 8, hi_half = (idx >> 7) & 1, i = 31 - 2 * rnd - (hi_half ^ (rnd & 1)), bg = idx & 127, b = bg >> 2, g = bg & 3, hd = g * 4 + r;
        const size_t tokb = (size_t)b * SEQ + i * 64;
        const int nkt = (i >> 2) + 1;
#pragma unroll
        for (int k = 0; k < 4; ++k) { const int pc = tid + k * 512, row = pc >> 3, cc = pc & 7, rr = row >> 6, ql = row & 63;
            *(LAS u32x4*)(Qs + row * 72 + cc * 8) = *(const u32x4*)(Q + (tokb + ql) * 1024 + (g * 4 + rr) * 64 + cc * 8); }
#pragma unroll
        for (int k = 0; k < 2; ++k) { const int pc = tid + k * 512; { const int row = pc >> 3, cc = pc & 7; if (row < nkt * 16) *(LAS u32x4*)(Kc + row * 72 + cc * 8) = *(const u32x4*)(KCMP + (size_t)bg * 8192 + row * 64 + cc * 8); }
            { const int row = pc >> 4, cc = pc & 15; *(LAS u32x4*)(VcT + row * 136 + cc * 8) = *(const u32x4*)(VCMPT + (size_t)bg * 8192 + row * 128 + cc * 8); } }
        __syncthreads();
        bf16x8 Qf[2][2];
#pragma unroll
        for (int qt = 0; qt < 2; ++qt)
#pragma unroll
            for (int ks = 0; ks < 2; ++ks) Qf[qt][ks] = *(const LAS bf16x8*)(Qs + (r * 64 + qh * 32 + qt * 16 + fr) * 72 + ks * 32 + fq * 8);
        const float slope2 = exp2f(-0.5f * (float)(hd + 1)) * 1.4426950408889634f;
        float sc16[16];
#pragma unroll
        for (int e = 0; e < 16; ++e) sc16[e] = slope2 * (float)((e >> 2) * 16 + (e & 3));
        int tq[2]; float g0[2], g1[2], g2[2];
#pragma unroll
        for (int qt = 0; qt < 2; ++qt) { const int ql = qh * 32 + qt * 16 + fr; tq[qt] = i * 64 + ql; const float* gp = gates + (tokb + ql) * 48 + hd * 3; g0[qt] = gp[0]; g1[qt] = gp[1]; g2[qt] = gp[2]; }
        f32x4 outacc[4][2];
#pragma unroll
        for (int qt = 0; qt < 2; ++qt) {
            const int jmax = tq[qt] >= 31 ? ((tq[qt] - 31) >> 4) : -1;
            const float sl16 = slope2 * 16.f, jb = (float)(fq * 4);
            f32x4 S[8];
#pragma unroll
            for (int kt = 0; kt < 8; ++kt) { S[kt] = (f32x4){0.f, 0.f, 0.f, 0.f};
                if (kt < nkt) {
#pragma unroll
                    for (int ks = 0; ks < 2; ++ks) { const bf16x8 kf = *(const LAS bf16x8*)(Kc + (kt * 16 + fr) * 72 + ks * 32 + fq * 8); S[kt] = mfma16(kf, Qf[qt][ks], S[kt]); } } }
            float m = -1e30f;
#pragma unroll
            for (int kt = 0; kt < 8; ++kt) if (kt < nkt) {
#pragma unroll
                for (int j = 0; j < 4; ++j) { const int jc = kt * 16 + fq * 4 + j; const float s = fmaf(sl16, jb + (float)(kt * 16 + j), S[kt][j]); S[kt][j] = (jc <= jmax) ? s : -1e30f; m = fmaxf(m, S[kt][j]); } }
            m = fmaxf(m, __shfl_xor(m, 16)); m = fmaxf(m, __shfl_xor(m, 32));
            float l = 0.f;
#pragma unroll
            for (int kt = 0; kt < 8; ++kt) if (kt < nkt) {
#pragma unroll
                for (int j = 0; j < 4; ++j) { const float pv = (S[kt][j] > -1e29f) ? __builtin_amdgcn_exp2f(S[kt][j] - m) : 0.f; S[kt][j] = pv; l += pv; } }
            l += __shfl_xor(l, 16); l += __shfl_xor(l, 32);
            const float inv = l > 0.f ? 1.f / l : 0.f;
            float prev3 = 0.f;
#pragma unroll
            for (int kt = 0; kt < 8; ++kt) if (kt < nkt) {
#pragma unroll
                for (int j = 0; j < 4; ++j) S[kt][j] *= inv;
                const float p3 = S[kt][3];
                const float x1 = __shfl(p3, (lane + 48) & 63), x2 = __shfl(prev3, (lane + 48) & 63);
                const float carry = (fq > 0) ? x1 : x2;
                imp4[(r * 64 + qh * 32 + qt * 16 + fr) * 33 + kt * 4 + fq] = S[kt][0] + S[kt][1] + S[kt][2] + 0.5f * p3 + 0.5f * carry;
                prev3 = p3; }
#pragma unroll
            for (int dt = 0; dt < 4; ++dt) outacc[dt][qt] = (f32x4){0.f, 0.f, 0.f, 0.f};
#pragma unroll
            for (int s = 0; s < 4; ++s) if (2 * s < nkt) {
                u32x4 t; t.x = pk2(S[2 * s][0], S[2 * s][1]); t.y = pk2(S[2 * s][2], S[2 * s][3]); t.z = pk2(S[2 * s + 1][0], S[2 * s + 1][1]); t.w = pk2(S[2 * s + 1][2], S[2 * s + 1][3]);
                const bf16x8 pf = __builtin_bit_cast(bf16x8, t);
#pragma unroll
                for (int dt = 0; dt < 4; ++dt) { u32x4 tv; const u32x2 v0 = *(const LAS u32x2*)(VcT + (dt * 16 + fr) * 136 + s * 32 + fq * 4), v1 = *(const LAS u32x2*)(VcT + (dt * 16 + fr) * 136 + s * 32 + 16 + fq * 4);
                    tv.x = v0.x; tv.y = v0.y; tv.z = v1.x; tv.w = v1.y; outacc[dt][qt] = mfma16(__builtin_bit_cast(bf16x8, tv), pf, outacc[dt][qt]); } }
#pragma unroll
            for (int dt = 0; dt < 4; ++dt) outacc[dt][qt] = outacc[dt][qt] * g0[qt];
        }
        __syncthreads();
        if (tid < 64) { unsigned mask;
            if (i <= 3) mask = (1u << (i + 1)) - 1u;
            else { float v1 = -1.f, v2 = -1.f; int n1 = 0, n2 = 0;
                for (int n = 1; n < i; ++n) { const float v = ((imp4[(0 * 64 + tid) * 33 + n] + imp4[(1 * 64 + tid) * 33 + n]) + imp4[(2 * 64 + tid) * 33 + n]) + imp4[(3 * 64 + tid) * 33 + n];
                    if (v > v1) { v2 = v1; n2 = n1; v1 = v; n1 = n; } else if (v > v2) { v2 = v; n2 = n; } }
                mask = 1u | (1u << i) | (1u << n1) | (1u << n2); }
            selm[tid] = mask; }
        __syncthreads();
        unsigned sm[2];
#pragma unroll
        for (int qt = 0; qt < 2; ++qt) sm[qt] = selm[qh * 32 + qt * 16 + fr];
#pragma unroll
        for (int br = 0; br < 2; ++br) {
            const bf16_t* Kg = (br == 0 ? KS : KW) + (size_t)bg * 131072; const bf16_t* Vg = (br == 0 ? VST : VWT) + (size_t)bg * 131072;
            const int n0 = (br == 0) ? 0 : (i >= 4 ? i - 4 : 0), npair = (i - n0 + 2) >> 1;
            f32x4 O[4][2]; float lrun[2] = {0.f, 0.f};
#pragma unroll
            for (int dt = 0; dt < 4; ++dt)
#pragma unroll
                for (int qt = 0; qt < 2; ++qt) O[dt][qt] = (f32x4){0.f, 0.f, 0.f, 0.f};
            const int lrow = tid >> 3, lcc = tid & 7;
            u32x4 kx[2], vx[2];
#pragma unroll
            for (int h = 0; h < 2; ++h) { const int nn = (n0 + h <= i) ? n0 + h : i; kx[h] = *(const u32x4*)(Kg + ((size_t)nn * 64 + lrow) * 64 + lcc * 8); vx[h] = *(const u32x4*)(Vg + (size_t)lrow * 2048 + nn * 64 + lcc * 8); }
            __syncthreads();
#pragma unroll
            for (int h = 0; h < 2; ++h) { *(LAS u32x4*)(KV0 + h * 9216 + lrow * 72 + lcc * 8) = kx[h]; *(LAS u32x4*)(KV0 + h * 9216 + 4608 + lrow * 72 + lcc * 8) = vx[h]; }
            __syncthreads();
#pragma unroll 2
            for (int pi = 0; pi < npair; ++pi) {
                LAS bf16_t* Tc = (pi & 1) ? Qs : KV0; LAS bf16_t* Tn = (pi & 1) ? KV0 : Qs;
                const int na = n0 + 2 * pi;
                if (pi + 1 < npair) {
#pragma unroll
                    for (int h = 0; h < 2; ++h) { const int nn = (na + 2 + h <= i) ? na + 2 + h : i; kx[h] = *(const u32x4*)(Kg + ((size_t)nn * 64 + lrow) * 64 + lcc * 8); vx[h] = *(const u32x4*)(Vg + (size_t)lrow * 2048 + nn * 64 + lcc * 8); } }
                bf16x8 pf[2][2][2]; bool act[2][2];
#pragma unroll
                for (int h = 0; h < 2; ++h) {
                    const int n = na + h; const bool nvalid = (n <= i);
                    const bool edge = (n == i) || (br == 1 && n == i - 4);
                    LAS bf16_t* Kt = Tc + h * 9216;
#pragma unroll
                    for (int qt = 0; qt < 2; ++qt) {
                        const bool bsel = nvalid && ((br == 1) || ((sm[qt] >> n) & 1u));
                        act[h][qt] = nvalid && ((br == 1) || (__ballot(bsel) != 0ull));
                        pf[h][0][qt] = (bf16x8){0, 0, 0, 0, 0, 0, 0, 0}; pf[h][1][qt] = pf[h][0][qt];
                        if (act[h][qt]) {
                            const float sb = bsel ? slope2 * (float)(n * 64 + fq * 4 - tq[qt]) : -1e9f;
                            f32x4 S[4];
#pragma unroll
                            for (int kt = 0; kt < 4; ++kt) { S[kt] = (f32x4){sb + sc16[kt * 4], sb + sc16[kt * 4 + 1], sb + sc16[kt * 4 + 2], sb + sc16[kt * 4 + 3]};
#pragma unroll
                                for (int ks = 0; ks < 2; ++ks) { const bf16x8 kf = *(const LAS bf16x8*)(Kt + (kt * 16 + fr) * 72 + ks * 32 + fq * 8); S[kt] = mfma16(kf, Qf[qt][ks], S[kt]); } }
                            float ls = 0.f;
                            if (edge) {
#pragma unroll
                                for (int kt = 0; kt < 4; ++kt)
#pragma unroll
                                    for (int j = 0; j < 4; ++j) { const int pos = n * 64 + kt * 16 + fq * 4 + j; const bool valid = (pos <= tq[qt]) && (br == 0 || pos > tq[qt] - 256);
                                        const float pv = valid ? __builtin_amdgcn_exp2f(S[kt][j]) : 0.f; S[kt][j] = pv; ls += pv; }
                            } else {
#pragma unroll
                                for (int kt = 0; kt < 4; ++kt)
#pragma unroll
                                    for (int j = 0; j < 4; ++j) { const float pv = __builtin_amdgcn_exp2f(S[kt][j]); S[kt][j] = pv; ls += pv; }
                            }
                            lrun[qt] += ls;
#pragma unroll
                            for (int s = 0; s < 2; ++s) { u32x4 t; t.x = pk2(S[2 * s][0], S[2 * s][1]); t.y = pk2(S[2 * s][2], S[2 * s][3]); t.z = pk2(S[2 * s + 1][0], S[2 * s + 1][1]); t.w = pk2(S[2 * s + 1][2], S[2 * s + 1][3]); pf[h][s][qt] = __builtin_bit_cast(bf16x8, t); }
                        }
                    }
                }
#pragma unroll
                for (int h = 0; h < 2; ++h) {
                    LAS bf16_t* VtT = Tc + h * 9216 + 4608;
                    if (act[h][0] || act[h][1]) {
#pragma unroll
                        for (int s = 0; s < 2; ++s)
#pragma unroll
                            for (int dt = 0; dt < 4; ++dt) { u32x4 t; const u32x2 v0 = *(const LAS u32x2*)(VtT + (dt * 16 + fr) * 72 + s * 32 + fq * 4), v1 = *(const LAS u32x2*)(VtT + (dt * 16 + fr) * 72 + s * 32 + 16 + fq * 4);
                                t.x = v0.x; t.y = v0.y; t.z = v1.x; t.w = v1.y; const bf16x8 vf = __builtin_bit_cast(bf16x8, t);
#pragma unroll
                                for (int qt = 0; qt < 2; ++qt) if (act[h][qt]) O[dt][qt] = mfma16(vf, pf[h][s][qt], O[dt][qt]); } }
                }
                if (pi + 1 < npair) {
#pragma unroll
                    for (int h = 0; h < 2; ++h) { *(LAS u32x4*)(Tn + h * 9216 + lrow * 72 + lcc * 8) = kx[h]; *(LAS u32x4*)(Tn + h * 9216 + 4608 + lrow * 72 + lcc * 8) = vx[h]; } }
                __syncthreads();
            }
#pragma unroll
            for (int qt = 0; qt < 2; ++qt) { float l = lrun[qt]; l += __shfl_xor(l, 16); l += __shfl_xor(l, 32); const float sc = (br == 0 ? g1[qt] : g2[qt]) / l;
#pragma unroll
                for (int dt = 0; dt < 4; ++dt) outacc[dt][qt] = outacc[dt][qt] + O[dt][qt] * sc; }
        }
#pragma unroll
        for (int qt = 0; qt < 2; ++qt)
#pragma unroll
            for (int dt = 0; dt < 4; ++dt) { u32x2 o; o.x = pk2(outacc[dt][qt][0], outacc[dt][qt][1]); o.y = pk2(outacc[dt][qt][2], outacc[dt][qt][3]);
                *(u32x2*)(AO + (tokb + qh * 32 + qt * 16 + fr) * 1024 + hd * 64 + dt * 16 + fq * 4) = o; }
        __syncthreads();
    }
}

DI void weight_prep(const int tid, LAS unsigned char* lds, const P& p, int G, int c, bool late) {
    unsigned char* ws = p.ws;
    {
        const int nu[13] = {224, 64, 4, 176, 64, 32, 32, 4, 4, 352, 352, 176, 176};
        int total = 0;
#pragma unroll
        for (int m = 0; m < 13; ++m) total += nu[m];
        const int u_lo = late ? nu[0] : 0, u_hi = late ? total : nu[0];
        for (int gu = u_lo + c; gu < u_hi; gu += G) {
            int m = 0, u = gu;
#pragma unroll
            for (int q = 0; q < 12; ++q) if (m == q && u >= nu[q]) { u -= nu[q]; m = q + 1; }
            const float* s; bf16_t* d; int K, N; bool perm = false;
            switch (m) {
            case 0: s = p.in[1]; d = (bf16_t*)(ws + W_AB_IN); K = 1024; N = AB_IN; break;
            case 1: s = p.in[2]; d = (bf16_t*)(ws + W_AB_OUT); K = 1024; N = 1024; break;
            case 2: s = p.in[11]; d = (bf16_t*)(ws + W_GLU); K = 256; N = 256; break;
            case 3: s = p.in[17]; d = (bf16_t*)(ws + W_NSA_IN); K = 1024; N = NSA_IN; break;
            case 4: s = p.in[18]; d = (bf16_t*)(ws + W_NSA_OUT); K = 1024; N = 1024; break;
            case 5: s = p.in[21]; d = (bf16_t*)(ws + W_KW1); K = 2048; N = 256; break;
            case 6: s = p.in[24]; d = (bf16_t*)(ws + W_VW1); K = 2048; N = 256; break;
            case 7: s = p.in[23]; d = (bf16_t*)(ws + W_KW2); K = 256; N = 64; break;
            case 8: s = p.in[26]; d = (bf16_t*)(ws + W_VW2); K = 256; N = 64; break;
            case 9: s = p.in[27]; d = (bf16_t*)(ws + W_FFN_IN); K = 1024; N = FF2; perm = true; break;
            case 10: s = p.in[27] + (size_t)1024 * FF2; d = (bf16_t*)(ws + W_FFN_IN) + (size_t)FF2 * 1024; K = 1024; N = FF2; perm = true; break;
            case 11: s = p.in[30]; d = (bf16_t*)(ws + W_FFN_OUT); K = FFH; N = 1024; break;
            default: s = p.in[30] + (size_t)FFH * 1024; d = (bf16_t*)(ws + W_FFN_OUT) + (size_t)1024 * FFH; K = FFH; N = 1024; break;
            }
            prep_unit(tid, lds, s, d, K, N, u, perm);
        }
    }
}
DI void prologue_phase(const int tid, LAS unsigned char* lds, const P& p, int G, int c) {
    unsigned char* ws = p.ws;
    weight_prep(tid, lds, p, G, c, false);
    if (c == G - 1) {
        float* abar = (float*)(ws + W_S5AB); float* bbar = (float*)(ws + W_S5BB); bf16_t* ccat = (bf16_t*)(ws + W_S5CC);
        for (int idx = tid; idx < 1024; idx += 512) { const int g = idx >> 6;
            const float step = expf(p.in[5][g]), lr = p.in[3][idx], li = p.in[4][idx];
            const float mag = expf(lr * step), are = mag * cosf(li * step), aim = mag * sinf(li * step);
            const float den = lr * lr + li * li, nre = are - 1.f, nim = aim;
            const float zre = (nre * lr + nim * li) / den, zim = (nim * lr - nre * li) / den;
            abar[idx * 2] = are; abar[idx * 2 + 1] = aim;
            for (int h = 0; h < 16; ++h) { const float br = p.in[6][idx * 16 + h], bi = p.in[7][idx * 16 + h]; bbar[idx * 32 + h] = zre * br - zim * bi; bbar[idx * 32 + 16 + h] = zre * bi + zim * br; } }
        for (int idx = tid; idx < 16 * 16 * 128; idx += 512) { const int k = idx & 127, gh = idx >> 7;
            ccat[idx] = f2bf(k < 64 ? p.in[8][gh * 64 + k] : p.in[9][gh * 64 + k - 64]); }
        if (tid < 64) ((unsigned*)(ws + W_CTR))[tid] = 0u;
    }
    if (c < 32) {
        const int kv = c >> 4, sl = c & 15, n = tid & 255, hf = tid >> 8; const float* pe = p.in[kv ? 20 : 19]; const float* w1 = p.in[kv ? 24 : 21];
        float wv[64];
#pragma unroll
        for (int k = 0; k < 64; ++k) wv[k] = w1[(size_t)(sl * 128 + hf * 64 + k) * 256 + n];
        float acc = 0.f;
#pragma unroll
        for (int k = 0; k < 64; ++k) acc += pe[sl * 128 + hf * 64 + k] * wv[k];
        ((float*)(ws + W_B1PART))[((kv * 16 + sl) * 2 + hf) * 256 + n] = acc;
    }
    rms_phase(tid, p.in[0], p.in[31], (bf16_t*)(ws + A_HN), G, c);
}

#define XB_TMO      128
#define XB_XCNT(j)  (256  + 64 * (j))
#define XB_XSUB(j)  (1280 + 64 * (j))
#define XB_XGEN(j)  (2304 + 64 * (j))
#define XB_TOP      3328
#define XB_TOPGEN   3392
#define XCD_BAR_WORDS 3456
#define XB_SPIN_CAP (1u << 20)
DI unsigned xb_ld(unsigned* p)              { return __hip_atomic_load(p, __ATOMIC_RELAXED, __HIP_MEMORY_SCOPE_AGENT); }
DI unsigned xb_add(unsigned* p, unsigned v) { return __hip_atomic_fetch_add(p, v, __ATOMIC_RELAXED, __HIP_MEMORY_SCOPE_AGENT); }
DI unsigned xb_xcc_id() { return (unsigned)__builtin_amdgcn_s_getreg((3 << 11) | 20) & 0xFu; }
#define XB_SPIN(cond, bar) do { unsigned _sp = 0; while (cond) { __builtin_amdgcn_s_sleep(1); \
    if ((++_sp & 255u) == 0u) { if (xb_ld(&(bar)[XB_TMO])) break; if (_sp > XB_SPIN_CAP) { atomicAdd(&(bar)[XB_TMO], 1u); break; } } } } while (0)
struct XcdBarrier { unsigned* bar; unsigned x; volatile LAS unsigned* st; };
DI XcdBarrier xcd_barrier_post(unsigned* bar, volatile LAS unsigned* st) {
    XcdBarrier b; b.bar = bar; b.x = xb_xcc_id(); b.st = st;
    if (threadIdx.x == 0) (void)xb_add(&bar[XB_XCNT(b.x)], 1u);
    return b;
}
DI void xcd_barrier_complete(unsigned* bar, unsigned x, unsigned& nloc, unsigned& nx) {
    const unsigned G = gridDim.x * gridDim.y * gridDim.z;
    unsigned sum, cnt, mine, sp = 0u;
    for (;;) {
        sum = 0u; cnt = 0u; mine = 0u;
#pragma unroll
        for (unsigned j = 0; j < 16; ++j) { const unsigned c = xb_ld(&bar[XB_XCNT(j)]); sum += c; cnt += (c > 0u) ? 1u : 0u; mine = (j == x) ? c : mine; }
        if (sum == G) break;
        __builtin_amdgcn_s_sleep(1);
        if ((++sp & 255u) == 0u) { if (xb_ld(&bar[XB_TMO])) break; if (sp > XB_SPIN_CAP) { atomicAdd(&bar[XB_TMO], 1u); break; } }
    }
    nloc = mine > 0u ? mine : 1u; nx = cnt > 0u ? cnt : 1u;
}
DI void xcd_barrier(const XcdBarrier& b) {
    asm volatile("s_waitcnt vmcnt(0)" ::: "memory");
    __syncthreads();
    if (threadIdx.x == 0) {
        unsigned* bar = b.bar;
        __builtin_amdgcn_s_waitcnt(0);
        unsigned nloc = b.st[0], nx = b.st[1];
        if (nloc == 0u) { xcd_barrier_complete(bar, b.x, nloc, nx); b.st[0] = nloc; b.st[1] = nx; }
        const unsigned old = xb_add(&bar[XB_XSUB(b.x)], 1u);
        const unsigned gen = old / nloc;
        if (old + 1u == (gen + 1u) * nloc) {
            __builtin_amdgcn_fence(__ATOMIC_RELEASE, "agent");
            asm volatile("s_waitcnt vmcnt(0)" ::: "memory");
            const unsigned og = xb_add(&bar[XB_TOP], 1u);
            const unsigned tg = og / nx;
            if (og + 1u == (tg + 1u) * nx) xb_add(&bar[XB_TOPGEN], 1u);
            else XB_SPIN(xb_ld(&bar[XB_TOPGEN]) == tg, bar);
            __builtin_amdgcn_fence(__ATOMIC_ACQUIRE, "agent");
            xb_add(&bar[XB_XGEN(b.x)], 1u);
            asm volatile("s_waitcnt vmcnt(0)" ::: "memory");
        } else {
            XB_SPIN(xb_ld(&bar[XB_XGEN(b.x)]) == gen, bar);
            __builtin_amdgcn_fence(__ATOMIC_ACQUIRE, "agent");
            asm volatile("s_waitcnt vmcnt(0)" ::: "memory");
        }
    }
    __syncthreads();
}

constexpr int EXTRA_SEAMS = 0;
constexpr bool DUP_BARRIER = false;
constexpr bool FUSE_RMS_TAIL = false;
constexpr int SUBDUP = 0;
constexpr unsigned DUP_MASK = 0u;
__global__ void __launch_bounds__(512, 2) mega(P p, int ph_lo, int ph_hi, unsigned ph_mask) {
    extern __shared__ __attribute__((aligned(16))) unsigned char lds_raw[];
    LAS unsigned char* lds = (LAS unsigned char*)lds_raw;
    cg::grid_group grid = cg::this_grid();
    const int G = gridDim.x, c = blockIdx.x;
    unsigned char* ws = p.ws;
    volatile LAS unsigned* xbst = (volatile LAS unsigned*)(lds + LDS_BYTES - 16);
    if (threadIdx.x < 4) xbst[threadIdx.x] = 0u;
    __syncthreads();
    const XcdBarrier xbar = xcd_barrier_post((unsigned*)(ws + W_BAR), xbst);
    if (ph_lo > 1000) grid.sync();
#pragma unroll 1
    for (int ph2 = ph_lo * 2; ph2 < ph_hi * 2; ++ph2) {
        const int ph = ph2 >> 1;
        if (ph == 9 || ph == 10 || ph == 21 || ph == 22) continue;
        if (FUSE_RMS_TAIL && (ph == 6 || ph == 12 || ph == 18 || ph == 24)) continue;
        if ((ph2 & 1) && !((DUP_MASK >> ph) & 1u)) continue;
        if (ph2 & 1) __syncthreads();
        int tid = threadIdx.x; asm volatile("" : "+v"(tid));
        int kind = ph, layer = 0, sub = 0;
        if (ph >= 6 && ph <= 11) { kind = 100; layer = 0; sub = ph - 6; }
        if (ph >= 18 && ph <= 23) { kind = 100; layer = 1; sub = ph - 18; }
        if (kind == 100) kind = (sub == 0) ? 100 : (sub == 5) ? 103 : (sub & 1) ? 101 : 102;
        const int half = (sub - 1) >> 1;
        bool gdirect = false; const float* tail_g = nullptr; bf16_t* tail_dst = nullptr; bool tail = false;
        bool is_gemm = false; const bf16_t* gA = nullptr; const bf16_t* gB = nullptr; int lda = 0, ldb = 0, gM = 0, gN = 0, gK = 0, gG = G, gc = c;
        Epi E{};
        if (!((ph_mask >> ph) & 1u)) kind = -1;
        switch (kind) {
        case 0: prologue_phase(tid, lds, p, G, c); break;
        case 1: {
            is_gemm = true; E.kind = EK_ABIN; E.d0 = (bf16_t*)(ws + A_US5); E.d1 = (bf16_t*)(ws + A_QKV); E.d2 = (bf16_t*)(ws + A_Z); E.f0 = (float*)(ws + A_BLAL);
            gA = (const bf16_t*)(ws + A_HN); lda = 1024; gB = (const bf16_t*)(ws + W_AB_IN); ldb = 1024; gM = MTOK; gN = AB_IN_P; gK = 1024; } break;
        case 2: for (int rp = 0; rp < ((SUBDUP & 1) ? 2 : 1); ++rp) { s5_pass<false>(tid, lds, p, G, c); __syncthreads(); }
                for (int rp = 0; rp < ((SUBDUP & 2) ? 2 : 1); ++rp) { gdn_prep_phase(tid, lds, p, G, c); __syncthreads(); } break;
        case 3: if (c == G - 1) { const int t = tid; const int kv = t >> 8, n = t & 255; float a = p.in[kv ? 25 : 22][n];
                    for (int s = 0; s < 32; ++s) a += ((const float*)(ws + W_B1PART))[(kv * 32 + s) * 256 + n];
                    ((float*)(ws + W_B1P))[kv * 256 + n] = a; }
                if (G > 192) { if (c >= 192) weight_prep(tid, lds, p, G - 192, c - 192, true); } else weight_prep(tid, lds, p, G, c, true);
                __syncthreads();
                for (int rp = 0; rp < ((SUBDUP & 4) ? 2 : 1); ++rp) { gdn_seq_phase(tid, lds, p, G, c); __syncthreads(); }
                for (int rp = 0; rp < ((SUBDUP & 8) ? 2 : 1); ++rp) { s5_pass<true>(tid, lds, p, G, (c + G - 192 % G) % G); __syncthreads(); } break;
        case 4: is_gemm = true; E.kind = EK_GLU; E.cb0 = (const bf16_t*)(ws + A_ZS5); E.cf0 = p.in[12]; E.d0 = (bf16_t*)(ws + A_YCAT);
            gA = (const bf16_t*)(ws + A_ZS5); lda = 256; gB = (const bf16_t*)(ws + W_GLU); ldb = 256; gM = MTOK; gN = 256; gK = 256; break;
        case 5: is_gemm = true; E.kind = EK_RESID; E.cf0 = p.in[0]; E.f0 = p.out; gdirect = FUSE_RMS_TAIL; tail = FUSE_RMS_TAIL; tail_g = p.in[32]; tail_dst = (bf16_t*)(ws + F_HN);
            gA = (const bf16_t*)(ws + A_YCAT); lda = 1024; gB = (const bf16_t*)(ws + W_AB_OUT); ldb = 1024; gM = MTOK; gN = 1024; gK = 1024; break;
        case 12: rms_phase(tid, p.out, p.in[31] + 1024, (bf16_t*)(ws + N_HN), G, c); break;
        case 13: is_gemm = true; E.kind = EK_NSAIN; E.d0 = (bf16_t*)(ws + N_Q); E.d1 = (bf16_t*)(ws + N_KC); E.f0 = (float*)(ws + N_GATES);
            gA = (const bf16_t*)(ws + N_HN); lda = 1024; gB = (const bf16_t*)(ws + W_NSA_IN); ldb = 1024; gM = MTOK; gN = NSA_IN_P; gK = 1024; break;
        case 14: { const int kv = (c >= G / 2); is_gemm = true; E.kind = EK_CMP1; E.d0 = (bf16_t*)(ws + (kv ? N_H1V : N_H1K)); E.cf0 = (const float*)(ws + W_B1P) + kv * 256;
            gA = (const bf16_t*)(ws + (kv ? N_VC : N_KC)); lda = 1024; gB = (const bf16_t*)(ws + (kv ? W_VW1 : W_KW1)); ldb = 2048; gM = 16384; gN = 256; gK = 2048; gG = G / 2; gc = kv ? c - G / 2 : c; } break;
        case 15: { const int kv = (c >= G / 2); is_gemm = true; E.kind = EK_CMP2; E.flag = kv; E.d0 = (bf16_t*)(ws + (kv ? N_VCMPT : N_KCMP));
            gA = (const bf16_t*)(ws + (kv ? N_H1V : N_H1K)); lda = 256; gB = (const bf16_t*)(ws + (kv ? W_VW2 : W_KW2)); ldb = 256; gM = 16384; gN = 256; gK = 256; gG = G / 2; gc = kv ? c - G / 2 : c; } break;
        case 16: nsa_attn_phase(tid, lds, p, G, c); break;
        case 17: is_gemm = true; E.kind = EK_RESID; E.cf0 = p.out; E.f0 = p.out; gdirect = FUSE_RMS_TAIL; tail = FUSE_RMS_TAIL; tail_g = p.in[32] + 1024; tail_dst = (bf16_t*)(ws + F_HN);
            gA = (const bf16_t*)(ws + N_AO); lda = 1024; gB = (const bf16_t*)(ws + W_NSA_OUT); ldb = 1024; gM = MTOK; gN = 1024; gK = 1024; break;
        case 100: rms_phase(tid, p.out, p.in[32] + layer * 1024, (bf16_t*)(ws + F_HN), G, c); break;
        case 101: is_gemm = true; E.kind = EK_FFNUP; E.d0 = (bf16_t*)(ws + F_ACT); E.f0 = (float*)(ws + F_HB); E.cf0 = p.in[28] + (size_t)layer * 3 * FF2; E.cf1 = p.in[29] + (size_t)layer * FF2;
            gA = (const bf16_t*)(ws + F_HN); lda = 1024; gB = (const bf16_t*)(ws + W_FFN_IN) + (size_t)layer * FF2 * 1024; ldb = 1024; gM = MTOK; gN = FF2; gK = 1024; break;
        case 102: ffn_fix_phase(tid, p, layer, G, c); break;
        case 103: is_gemm = true; E.kind = EK_RESID; E.cf0 = p.out; E.f0 = p.out; gdirect = FUSE_RMS_TAIL; tail = FUSE_RMS_TAIL; if (layer == 0) { tail_g = p.in[31] + 1024; tail_dst = (bf16_t*)(ws + N_HN); } else { tail_g = p.in[33]; tail_dst = nullptr; }
            gA = (const bf16_t*)(ws + F_ACT); lda = FFH; gB = (const bf16_t*)(ws + W_FFN_OUT) + (size_t)layer * 1024 * FFH; ldb = FFH; gM = MTOK; gN = 1024; gK = FFH; break;
        case 24: rms_final(tid, p.out, p.in[33], G, c); break;
        default: break;
        }
        if (is_gemm) pg8::gemm_phase(tid, lds, gA, lda, gB, ldb, gM, gN, gK, gG, gc, gdirect, E);
        if (tail) {
            asm volatile("s_waitcnt vmcnt(0)" ::: "memory"); __syncthreads();
            __builtin_amdgcn_fence(__ATOMIC_ACQUIRE, "agent"); asm volatile("s_waitcnt vmcnt(0)" ::: "memory");
            rms_owned(tid, p.out, tail_g, tail_dst, G, c);
        }
        if (!(ph2 & 1) && ((DUP_MASK >> ph) & 1u)) { if (DUP_BARRIER) xcd_barrier(xbar); continue; }
        for (int xs = 0; xs < ((ph == 0) ? EXTRA_SEAMS : 0); ++xs) xcd_barrier(xbar);
        if (ph + 1 < ph_hi) xcd_barrier(xbar);
    }
}
constexpr int N_PHASES = 25;

extern "C" void kernel_launch(void* const* d_in, const int* in_sizes, int n_in, void* d_out, int out_size, void* d_ws, size_t ws_size, hipStream_t stream) {
    static int grid = 0;
    if (grid == 0) {
        int dev = 0, cus = 0, per_cu = 0;
        hipGetDevice(&dev); hipDeviceGetAttribute(&cus, hipDeviceAttributeMultiprocessorCount, dev);
        if (hipFuncSetAttribute((const void*)mega, hipFuncAttributeMaxDynamicSharedMemorySize, LDS_BYTES) != hipSuccess) fprintf(stderr, "hipFuncSetAttribute failed\n");
        if (hipOccupancyMaxActiveBlocksPerMultiprocessor(&per_cu, (const void*)mega, 512, LDS_BYTES) != hipSuccess || per_cu < 1) { fprintf(stderr, "occupancy query: %d\n", per_cu); per_cu = 1; }
        (void)hipGetLastError();
        grid = cus;
        if (ws_size < 1024 * MiB) fprintf(stderr, "workspace too small: %zu\n", ws_size);
    }
    P p{};
    for (int i = 0; i < 34; ++i) p.in[i] = (const float*)d_in[i];
    p.out = (float*)d_out; p.ws = (unsigned char*)d_ws;
    int lo = 0, hi = N_PHASES; unsigned mask = 0xFFFFFFFFu;
    void* args[] = {&p, &lo, &hi, &mask};
    if (hipMemsetAsync((unsigned char*)d_ws + W_BAR, 0, XCD_BAR_WORDS * 4, stream) != hipSuccess) fprintf(stderr, "memset of barrier words failed\n");
    hipError_t e = hipLaunchCooperativeKernel((const void*)mega, dim3(grid), dim3(512), args, LDS_BYTES, stream);
    if (e != hipSuccess) fprintf(stderr, "cooperative launch failed: %s (grid %d)\n", hipGetErrorString(e), grid);
}
```
